# Optimizing an MI355X kernel written in HIP

```python
import jax, jax.numpy as jnp
from jax import lax
import numpy as np

D_MODEL = 1024
BATCH = 4
SEQ = 8192
DEPTH = 2

PLE_DIM = 256
NORM_EPS = 1e-6
NEG_INF = -1e30

MOBA_HEADS = 8
MOBA_HEAD_DIM = 64
MOBA_BLOCK = 256
MOBA_TOPK = 3
MOBA_Q_CHUNK = 32
POOL_GROUPS = 4
POOL_GROUP_DIM = 128
POOL_WINDOWS = (2, 4, 8, 16)
MLSTM_HEADS = 4
MLSTM_HEAD_DIM = 128
MLSTM_CHUNK = 64
CONV_WIDTH = 4
MLA_HEADS = 4
MLA_Q_RANK = 256
MLA_KV_RANK = 128
MLA_NOPE_DIM = 64
MLA_ROPE_DIM = 32
MLA_V_DIM = 128
ROPE_BASE = 10000.0
ATTN_Q_BLOCK = 128
FFN_DIM = 2816
N_EXPERTS = 8
MOE_TOPK = 2
EXPERT_DIM = 3584

A_WIDTH = MOBA_HEADS * MOBA_HEAD_DIM
B_WIDTH = POOL_GROUPS * POOL_GROUP_DIM
C_WIDTH = MLSTM_HEADS * MLSTM_HEAD_DIM
D_WIDTH = MLA_HEADS * MLA_V_DIM
EVEN_IN = 3 * A_WIDTH + B_WIDTH
ODD_IN = 4 * C_WIDTH + 2 * MLSTM_HEADS + MLA_Q_RANK + MLA_KV_RANK + MLA_ROPE_DIM
EVEN_MIX = A_WIDTH + B_WIDTH
ODD_MIX = C_WIDTH + D_WIDTH

kernel_name = "hybrid_moba_pool_mlstm_mla_moe"


def rmsnorm(x, g):
    xf = x.astype(jnp.float32)
    y = xf * lax.rsqrt(jnp.mean(xf * xf, axis=-1, keepdims=True) + NORM_EPS)
    return (y * g.astype(jnp.float32)).astype(x.dtype)


def swiglu(x, wg, wu, wd):
    return (jax.nn.silu(x @ wg) * (x @ wu)) @ wd


def alibi_slopes(n):
    return jnp.asarray(2.0 ** (-8.0 * np.arange(1, n + 1) / n), dtype=jnp.float32)


def moba_attention(q, k, v):
    B, H, S, dh = q.shape
    n_blk = -(-S // MOBA_BLOCK)
    s_pad = n_blk * MOBA_BLOCK
    pad = ((0, 0), (0, 0), (0, s_pad - S), (0, 0))
    q = jnp.pad(q, pad).astype(jnp.float32)
    k = jnp.pad(k, pad).astype(jnp.float32)
    v = jnp.pad(v, pad).astype(jnp.float32)
    k_blocks = k.reshape(B, H, n_blk, MOBA_BLOCK, dh)
    v_blocks = v.reshape(B, H, n_blk, MOBA_BLOCK, dh)
    k_mean = jnp.mean(k_blocks, axis=3)
    gate = jnp.einsum('bhsd,bhnd->bhsn', q, k_mean)
    q_blk = jnp.arange(s_pad) // MOBA_BLOCK
    past = jnp.arange(n_blk)[None, :] < q_blk[:, None]
    gate = jnp.where(past, gate, NEG_INF)
    n_sel = min(MOBA_TOPK, n_blk)
    _, sel_idx = lax.top_k(gate, n_sel)
    sel_valid = sel_idx < q_blk[:, None]
    slopes = alibi_slopes(H)[None, :, None, None]
    scale = dh ** -0.5
    b_ix = jnp.arange(B)[:, None, None, None]
    h_ix = jnp.arange(H)[None, :, None, None]
    key_off = jnp.arange(MOBA_BLOCK)

    def chunk(c):
        t0 = c * MOBA_Q_CHUNK
        qc = lax.dynamic_slice_in_dim(q, t0, MOBA_Q_CHUNK, axis=2)
        idx = lax.dynamic_slice_in_dim(sel_idx, t0, MOBA_Q_CHUNK, axis=2)
        ok = lax.dynamic_slice_in_dim(sel_valid, t0, MOBA_Q_CHUNK, axis=2)
        own0 = (t0 // MOBA_BLOCK) * MOBA_BLOCK
        k_own = lax.dynamic_slice_in_dim(k, own0, MOBA_BLOCK, axis=2)
        v_own = lax.dynamic_slice_in_dim(v, own0, MOBA_BLOCK, axis=2)
        k_sel = k_blocks[b_ix, h_ix, idx]
        v_sel = v_blocks[b_ix, h_ix, idx]
        t_pos = t0 + jnp.arange(MOBA_Q_CHUNK)
        d_own = t_pos[:, None] - (own0 + key_off)[None, :]
        s_own = jnp.einsum('bhqd,bhkd->bhqk', qc, k_own) * scale - slopes * d_own.astype(jnp.float32)
        s_own = jnp.where(d_own >= 0, s_own, NEG_INF)
        d_sel = t_pos[:, None, None] - (idx[..., None] * MOBA_BLOCK + key_off)
        s_sel = jnp.einsum('bhqd,bhqnkd->bhqnk', qc, k_sel) * scale - slopes[..., None] * d_sel.astype(jnp.float32)
        s_sel = jnp.where(ok[..., None], s_sel, NEG_INF)
        scores = jnp.concatenate([s_sel.reshape(B, H, MOBA_Q_CHUNK, n_sel * MOBA_BLOCK), s_own], axis=-1)
        probs = jax.nn.softmax(scores, axis=-1)
        p_sel = probs[..., :n_sel * MOBA_BLOCK].reshape(B, H, MOBA_Q_CHUNK, n_sel, MOBA_BLOCK)
        p_own = probs[..., n_sel * MOBA_BLOCK:]
        return (jnp.einsum('bhqnk,bhqnkd->bhqd', p_sel, v_sel)
                + jnp.einsum('bhqk,bhkd->bhqd', p_own, v_own))

    out = lax.map(chunk, jnp.arange(s_pad // MOBA_Q_CHUNK))
    out = jnp.moveaxis(out, 0, 2).reshape(B, H, s_pad, dh)
    return out[:, :, :S]


def multiscale_pool(x, w_group, scale):
    B, S, _ = x.shape
    xg = x.reshape(B, S, POOL_GROUPS, POOL_GROUP_DIM).astype(jnp.float32)
    csum = jnp.concatenate([jnp.zeros_like(xg[:, :1]), jnp.cumsum(xg, axis=1)], axis=1)
    t = jnp.arange(S)[:, None]
    win = jnp.asarray(POOL_WINDOWS, dtype=jnp.int32)[None, :]
    lo = jnp.maximum(t + 1 - win, 0)
    count = (t + 1 - lo).astype(jnp.float32)
    lagged = csum[:, lo, jnp.arange(POOL_GROUPS)[None, :]]
    pooled = (csum[:, 1:] - lagged) / count[None, :, :, None]
    mixed = jnp.einsum('bsgc,gcd->bsgd', pooled - xg, w_group.astype(jnp.float32))
    return (mixed.reshape(B, S, B_WIDTH) * scale).astype(x.dtype)


def causal_conv(x, w):
    K, C = w.shape
    return lax.conv_general_dilated(
        x, w[:, None, :].astype(x.dtype), window_strides=(1,), padding=[(K - 1, 0)],
        dimension_numbers=('NWC', 'WIO', 'NWC'), feature_group_count=C)


def mlstm(q, k, v, i_pre, f_pre):
    B, H, S, d = q.shape
    L = MLSTM_CHUNK
    nc = S // L

    def to_chunks(t):
        return jnp.moveaxis(t.reshape((B, H, nc, L) + t.shape[3:]), 2, 0)

    logf = jax.nn.log_sigmoid(f_pre)
    tril = jnp.tril(jnp.ones((L, L), dtype=bool))

    def step(carry, xs):
        C, n, m = carry
        qc, kc, vc, ic, fc = xs
        b = jnp.cumsum(fc, axis=-1)
        intra = jnp.where(tril, b[..., :, None] - b[..., None, :] + ic[..., None, :], NEG_INF)
        m_inter = b + m[..., None]
        m_t = jnp.maximum(m_inter, jnp.max(intra, axis=-1))
        w_inter = jnp.exp(m_inter - m_t)
        a = jnp.exp(intra - m_t[..., None]) * jnp.einsum('bhtd,bhsd->bhts', qc, kc)
        num = (w_inter[..., None] * jnp.einsum('bhvk,bhtk->bhtv', C, qc)
               + jnp.einsum('bhts,bhsv->bhtv', a, vc))
        den = w_inter * jnp.einsum('bhk,bhtk->bht', n, qc) + jnp.sum(a, axis=-1)
        h = num / jnp.maximum(jnp.abs(den), jnp.exp(-m_t))[..., None]
        b_end = b[..., -1]
        g = b_end[..., None] - b + ic
        m_new = jnp.maximum(b_end + m, jnp.max(g, axis=-1))
        decay = jnp.exp(b_end + m - m_new)
        w_s = jnp.exp(g - m_new[..., None])
        C_new = decay[..., None, None] * C + jnp.einsum('bhs,bhsv,bhsk->bhvk', w_s, vc, kc)
        n_new = decay[..., None] * n + jnp.einsum('bhs,bhsk->bhk', w_s, kc)
        return (C_new, n_new, m_new), h

    init = (jnp.zeros((B, H, d, d), jnp.float32), jnp.zeros((B, H, d), jnp.float32),
            jnp.zeros((B, H), jnp.float32))
    _, hs = lax.scan(step, init, (to_chunks(q), to_chunks(k), to_chunks(v),
                                  to_chunks(i_pre), to_chunks(logf)))
    return jnp.moveaxis(hs, 0, 2).reshape(B, H, S, d)


def rope(x, ang):
    x1, x2 = jnp.split(x, 2, axis=-1)
    cos = jnp.cos(ang).astype(x.dtype)
    sin = jnp.sin(ang).astype(x.dtype)
    return jnp.concatenate([x1 * cos - x2 * sin, x1 * sin + x2 * cos], axis=-1)


def causal_attention(q, k, v, scale):
    B, H, S, _ = q.shape
    k_pos = jnp.arange(S)

    def block(i):
        t0 = i * ATTN_Q_BLOCK
        qb = lax.dynamic_slice_in_dim(q, t0, ATTN_Q_BLOCK, axis=2)
        s = jnp.einsum('bhqd,bhkd->bhqk', qb, k).astype(jnp.float32) * scale
        q_pos = t0 + jnp.arange(ATTN_Q_BLOCK)
        s = jnp.where(k_pos[None, :] <= q_pos[:, None], s, NEG_INF)
        p = jax.nn.softmax(s, axis=-1)
        return jnp.einsum('bhqk,bhkd->bhqd', p.astype(v.dtype), v)

    out = lax.map(block, jnp.arange(S // ATTN_Q_BLOCK))
    return jnp.moveaxis(out, 0, 2).reshape(B, H, S, v.shape[-1])


def mla(c_q, c_kv, k_rope_in, q_norm, w_uq, kv_norm, w_ukv):
    B, S, _ = c_q.shape
    q = (rmsnorm(c_q, q_norm) @ w_uq).reshape(B, S, MLA_HEADS, MLA_NOPE_DIM + MLA_ROPE_DIM)
    kv = (rmsnorm(c_kv, kv_norm) @ w_ukv).reshape(B, S, MLA_HEADS, MLA_NOPE_DIM + MLA_V_DIM)
    half = MLA_ROPE_DIM // 2
    inv_freq = ROPE_BASE ** (-jnp.arange(half, dtype=jnp.float32) / half)
    ang = jnp.arange(S, dtype=jnp.float32)[:, None] * inv_freq[None, :]
    q_rot = rope(q[..., MLA_NOPE_DIM:], ang[:, None, :])
    k_rot = rope(k_rope_in, ang)
    q_full = jnp.concatenate([q[..., :MLA_NOPE_DIM], q_rot], axis=-1)
    k_full = jnp.concatenate(
        [kv[..., :MLA_NOPE_DIM], jnp.broadcast_to(k_rot[:, :, None, :], (B, S, MLA_HEADS, MLA_ROPE_DIM))], axis=-1)
    v = kv[..., MLA_NOPE_DIM:]
    out = causal_attention(q_full.transpose(0, 2, 1, 3), k_full.transpose(0, 2, 1, 3),
                           v.transpose(0, 2, 1, 3), (MLA_NOPE_DIM + MLA_ROPE_DIM) ** -0.5)
    return out.transpose(0, 2, 1, 3).reshape(B, S, D_WIDTH)


def moe_swiglu(x, router_w, router_b, wg, wu, wd):
    B, S, D = x.shape
    xt = x.reshape(B * S, D)
    logits = (xt @ router_w).astype(jnp.float32) + router_b.astype(jnp.float32)
    top_val, top_idx = lax.top_k(logits, MOE_TOPK)
    top_w = jax.nn.softmax(top_val, axis=-1)
    gates = jnp.einsum('tk,tke->te', top_w, jax.nn.one_hot(top_idx, N_EXPERTS, dtype=jnp.float32))
    y = jnp.zeros_like(xt)
    for e in range(N_EXPERTS):
        y = y + gates[:, e:e + 1].astype(x.dtype) * swiglu(xt, wg[e], wu[e], wd[e])
    return y.reshape(B, S, D)


def per_layer_embedding(h, p_i, g, w_gate, w_proj):
    gate = jax.nn.sigmoid(rmsnorm(h, g) @ w_gate)
    return h + gate * (p_i @ w_proj)


def even_layer(h, norm_mix, w_in, pool_w, pool_scale, w_out, norm_ffn, wg, wu, wd):
    B, S, _ = h.shape
    u = rmsnorm(h, norm_mix) @ w_in
    qa, ka, va, ub = jnp.split(u, [A_WIDTH, 2 * A_WIDTH, 3 * A_WIDTH], axis=-1)

    def heads(t):
        return t.reshape(B, S, MOBA_HEADS, MOBA_HEAD_DIM).transpose(0, 2, 1, 3)

    a_out = moba_attention(heads(qa), heads(ka), heads(va))
    a_out = a_out.transpose(0, 2, 1, 3).reshape(B, S, A_WIDTH).astype(h.dtype)
    b_out = multiscale_pool(ub, pool_w, pool_scale)
    h = h + jnp.concatenate([a_out, b_out], axis=-1) @ w_out
    return h + swiglu(rmsnorm(h, norm_ffn), wg, wu, wd)


def odd_layer(h, norm_mix, w_in, conv_w, b_i, b_f, head_norm, q_norm, w_uq, kv_norm, w_ukv,
              w_out, norm_ffn, router_w, router_b, wg, wu, wd):
    B, S, _ = h.shape
    u = rmsnorm(h, norm_mix) @ w_in
    cuts = np.cumsum([C_WIDTH, C_WIDTH, C_WIDTH, C_WIDTH, MLSTM_HEADS, MLSTM_HEADS,
                      MLA_Q_RANK, MLA_KV_RANK]).tolist()
    q_raw, k_raw, v_c, o_pre, i_pre, f_pre, c_q, c_kv, k_rope_in = jnp.split(u, cuts, axis=-1)
    qk = jax.nn.silu(causal_conv(jnp.concatenate([q_raw, k_raw], axis=-1), conv_w))
    q_c, k_c = jnp.split(qk, 2, axis=-1)

    def heads(t):
        return t.reshape(B, S, MLSTM_HEADS, MLSTM_HEAD_DIM).transpose(0, 2, 1, 3).astype(jnp.float32)

    i_g = (i_pre + b_i).astype(jnp.float32).transpose(0, 2, 1)
    f_g = (f_pre + b_f).astype(jnp.float32).transpose(0, 2, 1)
    hc = mlstm(heads(q_c), heads(k_c) * (MLSTM_HEAD_DIM ** -0.5), heads(v_c), i_g, f_g)
    hc = rmsnorm(hc.transpose(0, 2, 1, 3), head_norm.reshape(MLSTM_HEADS, MLSTM_HEAD_DIM))
    c_out = hc.reshape(B, S, C_WIDTH).astype(h.dtype) * jax.nn.sigmoid(o_pre)
    d_out = mla(c_q, c_kv, k_rope_in, q_norm, w_uq, kv_norm, w_ukv)
    h = h + jnp.concatenate([c_out, d_out], axis=-1) @ w_out
    return h + moe_swiglu(rmsnorm(h, norm_ffn), router_w, router_b, wg, wu, wd)


def setup_inputs(seed: int = 0) -> dict:
    key = jax.random.key(seed)
    ks = iter(jax.random.split(key, 40))
    ne = (DEPTH + 1) // 2
    no = DEPTH // 2
    f32 = jnp.float32

    def w(shape, fan_in):
        return jax.random.normal(next(ks), shape, f32) * fan_in ** -0.5

    def gain(shape):
        return 1.0 + 0.1 * jax.random.normal(next(ks), shape, f32)

    return {
        "x": jax.random.normal(next(ks), (BATCH, SEQ, D_MODEL), f32),
        "p": jax.random.normal(next(ks), (DEPTH, BATCH, SEQ, PLE_DIM), f32),
        "ev_norm_mix": gain((ne, D_MODEL)),
        "ev_w_in": w((ne, D_MODEL, EVEN_IN), D_MODEL),
        "pool_w": w((ne, POOL_GROUPS, POOL_GROUP_DIM, POOL_GROUP_DIM), POOL_GROUP_DIM),
        "pool_scale": gain((ne, B_WIDTH)),
        "ev_w_out": w((ne, EVEN_MIX, D_MODEL), EVEN_MIX),
        "ev_norm_ffn": gain((ne, D_MODEL)),
        "ffn_w_gate": w((ne, D_MODEL, FFN_DIM), D_MODEL),
        "ffn_w_up": w((ne, D_MODEL, FFN_DIM), D_MODEL),
        "ffn_w_down": w((ne, FFN_DIM, D_MODEL), FFN_DIM),
        "od_norm_mix": gain((no, D_MODEL)),
        "od_w_in": w((no, D_MODEL, ODD_IN), D_MODEL),
        "conv_w": w((no, CONV_WIDTH, 2 * C_WIDTH), CONV_WIDTH),
        "gate_b_i": 0.1 * jax.random.normal(next(ks), (no, MLSTM_HEADS), f32),
        "gate_b_f": 3.0 + 0.5 * jax.random.normal(next(ks), (no, MLSTM_HEADS), f32),
        "mlstm_norm": gain((no, C_WIDTH)),
        "mla_q_norm": gain((no, MLA_Q_RANK)),
        "mla_w_uq": w((no, MLA_Q_RANK, MLA_HEADS * (MLA_NOPE_DIM + MLA_ROPE_DIM)), MLA_Q_RANK),
        "mla_kv_norm": gain((no, MLA_KV_RANK)),
        "mla_w_ukv": w((no, MLA_KV_RANK, MLA_HEADS * (MLA_NOPE_DIM + MLA_V_DIM)), MLA_KV_RANK),
        "od_w_out": w((no, ODD_MIX, D_MODEL), ODD_MIX),
        "od_norm_ffn": gain((no, D_MODEL)),
        "router_w": w((no, D_MODEL, N_EXPERTS), D_MODEL),
        "router_b": 0.01 * jax.random.normal(next(ks), (no, N_EXPERTS), f32),
        "moe_w_gate": w((no, N_EXPERTS, D_MODEL, EXPERT_DIM), D_MODEL),
        "moe_w_up": w((no, N_EXPERTS, D_MODEL, EXPERT_DIM), D_MODEL),
        "moe_w_down": w((no, N_EXPERTS, EXPERT_DIM, D_MODEL), EXPERT_DIM),
        "ple_norm": gain((DEPTH, D_MODEL)),
        "ple_w_gate": w((DEPTH, D_MODEL, D_MODEL), D_MODEL),
        "ple_w_proj": w((DEPTH, PLE_DIM, D_MODEL), PLE_DIM),
        "final_norm": gain((D_MODEL,)),
    }


def reference(x, p, ev_norm_mix, ev_w_in, pool_w, pool_scale, ev_w_out, ev_norm_ffn,
              ffn_w_gate, ffn_w_up, ffn_w_down, od_norm_mix, od_w_in, conv_w, gate_b_i, gate_b_f,
              mlstm_norm, mla_q_norm, mla_w_uq, mla_kv_norm, mla_w_ukv, od_w_out, od_norm_ffn,
              router_w, router_b, moe_w_gate, moe_w_up, moe_w_down, ple_norm, ple_w_gate,
              ple_w_proj, final_norm):
    h = x
    for layer in range(DEPTH):
        j = layer // 2
        if layer % 2 == 0:
            h = even_layer(h, ev_norm_mix[j], ev_w_in[j], pool_w[j], pool_scale[j], ev_w_out[j],
                           ev_norm_ffn[j], ffn_w_gate[j], ffn_w_up[j], ffn_w_down[j])
        else:
            h = odd_layer(h, od_norm_mix[j], od_w_in[j], conv_w[j], gate_b_i[j], gate_b_f[j],
                          mlstm_norm[j], mla_q_norm[j], mla_w_uq[j], mla_kv_norm[j], mla_w_ukv[j],
                          od_w_out[j], od_norm_ffn[j], router_w[j], router_b[j],
                          moe_w_gate[j], moe_w_up[j], moe_w_down[j])
        h = per_layer_embedding(h, p[layer], ple_norm[layer], ple_w_gate[layer], ple_w_proj[layer])
    return rmsnorm(h, final_norm)
```

```cpp
#include <hip/hip_runtime.h>
#include <cstdio>
#include <cstdint>
typedef float f32x2_cv __attribute__((ext_vector_type(2))); typedef __bf16 bf16x2_cv __attribute__((ext_vector_type(2)));
__device__ __forceinline__ unsigned cvt2(float lo, float hi) { f32x2_cv v = {lo, hi}; bf16x2_cv b = __builtin_convertvector(v, bf16x2_cv); return __builtin_bit_cast(unsigned, b); }
__device__ __forceinline__ int tid_fresh() { int t = threadIdx.x; asm volatile("" : "+v"(t)); return t; }

namespace pg8 {
#define PG8_LAS __attribute__((address_space(3)))
typedef unsigned short bf16_t;
typedef short bf16x8 __attribute__((ext_vector_type(8)));
typedef float f32x4 __attribute__((ext_vector_type(4)));
typedef unsigned u32x4 __attribute__((ext_vector_type(4)));
typedef unsigned u32x2 __attribute__((ext_vector_type(2)));
typedef int v4i_t __attribute__((ext_vector_type(4)));
constexpr int BM = 256, BK = 64, HALF = 128, HTB = HALF * BK * 2  , STAGE_BYTES = 8 * HTB, NXCD = 8, WGM = 8;

__host__ __device__ __forceinline__ int lds_byte(int r, int c) { const int st = (r >> 4) * 2 + (c >> 5), rr = r & 15, cc = c & 31, ob = rr * 64 + cc * 2; return st * 1024 + (ob ^ (((ob >> 9) & 1) << 5)); }
__host__ __device__ __forceinline__ void stage_rc(int b, int& R, int& C) { const int st = b / 1024, sb = b % 1024, swz = sb ^ (((sb >> 9) & 1) << 5); R = (st >> 1) * 16 + swz / 64; C = (st & 1) * 32 + (swz % 64) / 2; }
__host__ __device__ __forceinline__ int perm32(int rho) { const int n = rho >> 4, i = rho & 15; return 8 * (i >> 2) + 4 * n + (i & 3); }

struct Unit { int pm, pn, pb; };
struct Gemm { const bf16_t* A; const bf16_t* Bt; int M, N, K, lda; };

struct StaticOrder {
    int nM, nN, nwg, G, c;
    __host__ __device__ void init(int M, int N, int G_, int c_) { nM = M / BM; nN = N / BM; nwg = nM * nN; G = G_; c = c_; }
    __host__ __device__ bool next(int i, Unit& u) const {
        const long L = (long)i * G + c; if (L >= nwg) return false;
        int wgid = (int)L; { const int q = nwg / NXCD, r = nwg % NXCD, xcd = wgid % NXCD, off = wgid / NXCD; wgid = (xcd < r ? xcd * (q + 1) : r * (q + 1) + (xcd - r) * q) + off; }
        const int nig = WGM * nN, gid = wgid / nig, fm = gid * WGM, gsz = (nM - fm) < WGM ? (nM - fm) : WGM;
        u.pm = fm + ((wgid % nig) % gsz); u.pn = (wgid % nig) / gsz; u.pb = u.pn; return true;
    }
    __device__ __forceinline__ void a_ready(const Unit&) const {}
    __device__ __forceinline__ void done(const Unit&) const {}
};

__device__ __forceinline__ unsigned cvt_pk_bf16(float lo, float hi) { return cvt2(lo, hi); }

template <class Epi, class Sched, bool ALIGN_EPI = false, bool SP2 = false, bool FP8 = false>
__device__ __forceinline__ void gemm_phase(PG8_LAS unsigned char* lds, const Gemm g, const Sched& S, const Epi& E) {
    const int tid = tid_fresh(), wid = __builtin_amdgcn_readfirstlane(tid >> 6), lane = tid & 63, wr = wid >> 2, wc = wid & 3, fr = lane & 15, fq = lane >> 4;
    const int K = g.K, nt = K / BK;
    unsigned voffA[2], voffB[2];
#pragma unroll
    for (int i = 0; i < 2; ++i) { int R, C; stage_rc(tid * 16 + i * 8192, R, C); const int Rb = Epi::PERM ? ((R & ~31) + perm32(R & 31)) : R;
        voffA[i] = (unsigned)(R * g.lda + C) * 2u; voffB[i] = (unsigned)(Rb * K + C) * 2u; }
    const size_t kstep = (size_t)(BK * 2);
    const size_t hstepA = (size_t)HALF * g.lda * 2, hstepB = (size_t)HALF * K * 2;
    const size_t tstepA = 2 * hstepA, tstepB = 2 * hstepB;
    const unsigned ldsw = (unsigned)wid * 1024u;
    const int aoff = lds_byte(wr * 64 + fr, fq * 8), boff = lds_byte(wc * 32 + fr, fq * 8);
#define PG8_SA(b, h) (((b) * 2 + (h)) * HTB)
#define PG8_SB(b, h) ((4 + (b) * 2 + (h)) * HTB)
#define PG8_STAGE(bufoff, gbase, voff) do { _Pragma("unroll") for (int _i = 0; _i < 2; ++_i) \
        __builtin_amdgcn_global_load_lds((const unsigned*)((const char*)(gbase) + (voff)[_i]), (PG8_LAS unsigned*)(lds + (bufoff) + ldsw + _i * 8192), 16, 0, 0); } while (0)
#define PG8_LDA(dst, b, h) do { _Pragma("unroll") for (int m = 0; m < 4; ++m) _Pragma("unroll") for (int k = 0; k < 2; ++k) dst[m][k] = *(const PG8_LAS bf16x8*)(lds + PG8_SA(b, h) + aoff + m * 2048 + k * 1024); } while (0)
#define PG8_LDB(dst, b, h) do { _Pragma("unroll") for (int n = 0; n < 2; ++n) _Pragma("unroll") for (int k = 0; k < 2; ++k) dst[n][k] = *(const PG8_LAS bf16x8*)(lds + PG8_SB(b, h) + boff + n * 2048 + k * 1024); } while (0)
#define PG8_V8(x) __builtin_shufflevector(__builtin_bit_cast(v4i_t, (x)[0]), __builtin_bit_cast(v4i_t, (x)[1]), 0, 1, 2, 3, 4, 5, 6, 7)
#define PG8_MMA(ai, bj, At, Bt) do { __builtin_amdgcn_s_setprio(1); _Pragma("unroll") for (int m = 0; m < 4; ++m) _Pragma("unroll") for (int n = 0; n < 2; ++n) { \
        if constexpr (FP8) asm volatile("v_mfma_scale_f32_16x16x128_f8f6f4 %0, %1, %2, %0, %3, %3 op_sel_hi:[0,0,0]" : "+v"(acc[ai][bj][m][n]) : "v"(PG8_V8(Bt[n])), "v"(PG8_V8(At[m])), "v"(0x7f7f7f7f));     \
        else { _Pragma("unroll") for (int k = 0; k < 2; ++k) acc[ai][bj][m][n] = __builtin_amdgcn_mfma_f32_16x16x32_bf16(Bt[n][k], At[m][k], acc[ai][bj][m][n], 0, 0, 0); } } \
        __builtin_amdgcn_s_setprio(0); } while (0)
#define PG8_WAIT_V(n) asm volatile("s_waitcnt vmcnt(" #n ")" ::: "memory")
#define PG8_WAIT_L(n) asm volatile("s_waitcnt lgkmcnt(" #n ")" ::: "memory")
#define PG8_BAR __builtin_amdgcn_s_barrier()
#define PG8_SCHED __builtin_amdgcn_sched_barrier(0)
    Unit cur, nxt; int ui = 0;
    if (!S.next(0, cur)) return;
    f32x4 acc[2][2][4][2];
#pragma unroll
    for (int a = 0; a < 2; ++a)
#pragma unroll
        for (int b = 0; b < 2; ++b)
#pragma unroll
            for (int m = 0; m < 4; ++m)
#pragma unroll
                for (int n = 0; n < 2; ++n) acc[a][b][m][n] = (f32x4){0.f, 0.f, 0.f, 0.f};
    bf16x8 At[4][2], B0[2][2], B1[2][2];
    const char* cA = (const char*)g.A + (size_t)cur.pm * tstepA; const char* cB = (const char*)g.Bt + (size_t)cur.pb * tstepB;
    S.a_ready(cur);
    if constexpr (SP2) {
        PG8_STAGE(PG8_SB(0, 0), cB, voffB); PG8_STAGE(PG8_SB(0, 1), cB + hstepB, voffB); PG8_STAGE(PG8_SA(0, 0), cA, voffA); PG8_STAGE(PG8_SA(0, 1), cA + hstepA, voffA);
        if (wr == 1) PG8_BAR;
        PG8_WAIT_V(2); PG8_BAR;
        PG8_STAGE(PG8_SB(1, 0), cB + kstep, voffB); PG8_STAGE(PG8_SA(1, 0), cA + kstep, voffA); PG8_STAGE(PG8_SB(1, 1), cB + hstepB + kstep, voffB);
        PG8_WAIT_V(6); PG8_BAR;
    } else {
        PG8_STAGE(PG8_SB(0, 0), cB, voffB); PG8_STAGE(PG8_SA(0, 0), cA, voffA); PG8_STAGE(PG8_SB(0, 1), cB + hstepB, voffB); PG8_STAGE(PG8_SA(0, 1), cA + hstepA, voffA);
        if (wr == 1) PG8_BAR;
        PG8_WAIT_V(4); PG8_BAR;
        PG8_STAGE(PG8_SB(1, 0), cB + kstep, voffB); PG8_STAGE(PG8_SA(1, 0), cA + kstep, voffA); PG8_STAGE(PG8_SB(1, 1), cB + hstepB + kstep, voffB);
        PG8_WAIT_V(6); PG8_BAR;
    }
    for (;;) {
        const bool has_next = S.next(ui + 1, nxt);
        const char* nA = has_next ? (const char*)g.A + (size_t)nxt.pm * tstepA : cA; const char* nB = has_next ? (const char*)g.Bt + (size_t)nxt.pb * tstepB : cB;
        for (int t = 0; t < nt; t += 2) {
            const bool last = (t == nt - 2);
            const char* a1 = cA + (size_t)(t + 1) * kstep;
            const char* a2 = last ? nA : cA + (size_t)(t + 2) * kstep; const char* b2 = last ? nB : cB + (size_t)(t + 2) * kstep;
            const char* a3 = a2 + kstep; const char* b3 = b2 + kstep;
            if (last && has_next) S.a_ready(nxt);
            if constexpr (SP2) {
            PG8_LDB(B0, 0, 0); PG8_LDB(B1, 0, 1); PG8_SCHED; PG8_LDA(At, 0, 0); PG8_STAGE(PG8_SA(1, 1), a1 + hstepA, voffA);
            PG8_WAIT_V(8); PG8_WAIT_L(0); PG8_BAR; PG8_MMA(0, 0, At, B0); PG8_MMA(0, 1, At, B1); PG8_BAR; PG8_SCHED;
            PG8_LDA(At, 0, 1); PG8_STAGE(PG8_SB(0, 0), b2, voffB); PG8_STAGE(PG8_SB(0, 1), b2 + hstepB, voffB); PG8_STAGE(PG8_SA(0, 0), a2, voffA);
            PG8_WAIT_V(8); PG8_WAIT_L(0); PG8_BAR; PG8_MMA(1, 0, At, B0); PG8_MMA(1, 1, At, B1); PG8_BAR; PG8_SCHED;
            PG8_LDB(B0, 1, 0); PG8_LDB(B1, 1, 1); PG8_SCHED; PG8_LDA(At, 1, 0); PG8_STAGE(PG8_SA(0, 1), a2 + hstepA, voffA);
            PG8_WAIT_V(8); PG8_WAIT_L(0); PG8_BAR; PG8_MMA(0, 0, At, B0); PG8_MMA(0, 1, At, B1); PG8_BAR; PG8_SCHED;
            PG8_LDA(At, 1, 1); PG8_STAGE(PG8_SB(1, 0), b3, voffB); PG8_STAGE(PG8_SB(1, 1), b3 + hstepB, voffB); PG8_STAGE(PG8_SA(1, 0), a3, voffA);
            PG8_WAIT_V(8); PG8_WAIT_L(0); PG8_BAR; PG8_MMA(1, 0, At, B0); PG8_MMA(1, 1, At, B1); PG8_BAR; PG8_SCHED;
            } else {
            PG8_LDB(B0, 0, 0); PG8_SCHED; PG8_LDA(At, 0, 0); PG8_STAGE(PG8_SA(1, 1), a1 + hstepA, voffA);
            PG8_WAIT_L(8); PG8_BAR; PG8_WAIT_L(0); PG8_MMA(0, 0, At, B0); PG8_BAR; PG8_SCHED;
            PG8_LDB(B1, 0, 1); PG8_STAGE(PG8_SB(0, 0), b2, voffB);
            PG8_BAR; PG8_WAIT_L(0); PG8_MMA(0, 1, At, B1); PG8_BAR;
            PG8_LDA(At, 0, 1); PG8_STAGE(PG8_SA(0, 0), a2, voffA);
            PG8_BAR; PG8_WAIT_L(0); PG8_MMA(1, 0, At, B0); PG8_BAR; PG8_SCHED;
            PG8_STAGE(PG8_SB(0, 1), b2 + hstepB, voffB);
            PG8_WAIT_V(6); PG8_BAR; PG8_MMA(1, 1, At, B1); PG8_BAR;
            PG8_LDB(B0, 1, 0); PG8_SCHED; PG8_LDA(At, 1, 0); PG8_STAGE(PG8_SA(0, 1), a2 + hstepA, voffA);
            PG8_WAIT_L(8); PG8_BAR; PG8_WAIT_L(0); PG8_MMA(0, 0, At, B0); PG8_BAR; PG8_SCHED;
            PG8_LDB(B1, 1, 1); PG8_STAGE(PG8_SB(1, 0), b3, voffB);
            PG8_BAR; PG8_WAIT_L(0); PG8_MMA(0, 1, At, B1); PG8_BAR;
            PG8_LDA(At, 1, 1); PG8_STAGE(PG8_SA(1, 0), a3, voffA);
            PG8_BAR; PG8_WAIT_L(0); PG8_MMA(1, 0, At, B0); PG8_BAR; PG8_SCHED;
            PG8_STAGE(PG8_SB(1, 1), b3 + hstepB, voffB);
            PG8_WAIT_V(6); PG8_BAR; PG8_MMA(1, 1, At, B1); PG8_BAR;
            }
        }
        if constexpr (ALIGN_EPI) { if (wr == 0) PG8_BAR; }
        if constexpr (FP8) { __builtin_amdgcn_sched_barrier(0); asm volatile("s_nop 15\n\ts_nop 15" ::: "memory"); __builtin_amdgcn_sched_barrier(0); }
        if constexpr (!Epi::AFTER_DRAIN) { E(acc, cur, wr, wc, fr, fq); S.done(cur); }
        if (!has_next) break;
#pragma unroll
        for (int a = 0; a < 2; ++a)
#pragma unroll
            for (int b = 0; b < 2; ++b)
#pragma unroll
                for (int m = 0; m < 4; ++m)
#pragma unroll
                    for (int n = 0; n < 2; ++n) acc[a][b][m][n] = (f32x4){0.f, 0.f, 0.f, 0.f};
        cur = nxt; cA = nA; cB = nB; ++ui;
        if constexpr (ALIGN_EPI) { if (wr == 1) PG8_BAR; }
    }
    PG8_WAIT_V(0);
    if constexpr (!ALIGN_EPI) { if (wr == 0) PG8_BAR; }
    PG8_BAR;
    if constexpr (Epi::AFTER_DRAIN) { E.fused(acc, cur, wr, wc, fr, fq, lds, wid, lane); S.done(cur); }
#undef PG8_SA
#undef PG8_SB
#undef PG8_STAGE
#undef PG8_LDA
#undef PG8_LDB
#undef PG8_MMA
#undef PG8_V8
#undef PG8_WAIT_V
#undef PG8_WAIT_L
#undef PG8_BAR
#undef PG8_SCHED
}
}

#define GAS __attribute__((address_space(1)))
#define LAS __attribute__((address_space(3)))
typedef unsigned short bf16;
typedef unsigned v4u __attribute__((ext_vector_type(4)));
typedef unsigned v2u __attribute__((ext_vector_type(2)));
typedef float f32x4 __attribute__((ext_vector_type(4)));
typedef GAS unsigned gu32;
#define RLX_AGENT __ATOMIC_RELAXED, __HIP_MEMORY_SCOPE_AGENT

#define XB_TMO      128
#define XB_XCNT(j)  (256  + 64 * (j))
#define XB_XSUB(j)  (1280 + 64 * (j))
#define XB_XGEN(j)  (2304 + 64 * (j))
#define XB_TOP      3328
#define XB_TOPGEN   3392
#define XCD_BAR_WORDS 3456
#define XB_SPIN_CAP (1u << 18)

__device__ __forceinline__ unsigned xb_ld(unsigned* p)              { return __hip_atomic_load(p, __ATOMIC_RELAXED, __HIP_MEMORY_SCOPE_AGENT); }
__device__ __forceinline__ unsigned xb_add(unsigned* p, unsigned v) { return __hip_atomic_fetch_add(p, v, __ATOMIC_RELAXED, __HIP_MEMORY_SCOPE_AGENT); }
__device__ __forceinline__ unsigned xb_xcc_id() { return (unsigned)__builtin_amdgcn_s_getreg((3 << 11) | 20) & 0xFu; }
#define XB_SPIN(cond, bar) do { unsigned _sp = 0; while (cond) { __builtin_amdgcn_s_sleep(1); \
    if ((++_sp & 255u) == 0u) { if (xb_ld(&(bar)[XB_TMO])) break; if (_sp > XB_SPIN_CAP) { atomicAdd(&(bar)[XB_TMO], 1u); break; } } } } while (0)

struct XcdBarrier {
    unsigned* bar; unsigned x;
    volatile LAS unsigned* st;
};

__device__ __forceinline__ XcdBarrier xcd_barrier_post(unsigned* bar, volatile LAS unsigned* st) {
    XcdBarrier b; b.bar = bar; b.x = xb_xcc_id(); b.st = st;
    if (threadIdx.x == 0) (void)xb_add(&bar[XB_XCNT(b.x)], 1u);
    return b;
}
__device__ __forceinline__ void xcd_barrier_complete(unsigned* bar, unsigned x, unsigned& nloc, unsigned& nx) {
    const unsigned G = gridDim.x * gridDim.y * gridDim.z;
    unsigned sum, cnt, mine, sp = 0u;
    for (;;) {
        sum = 0u; cnt = 0u; mine = 0u;
#pragma unroll
        for (unsigned j = 0; j < 16; ++j) { const unsigned c = xb_ld(&bar[XB_XCNT(j)]); sum += c; cnt += (c > 0u) ? 1u : 0u; mine = (j == x) ? c : mine; }
        if (sum == G) break;
        __builtin_amdgcn_s_sleep(1);
        if ((++sp & 255u) == 0u) { if (xb_ld(&bar[XB_TMO])) break; if (sp > XB_SPIN_CAP) { atomicAdd(&bar[XB_TMO], 1u); break; } }
    }
    nloc = mine > 0u ? mine : 1u; nx = cnt > 0u ? cnt : 1u;
}

__device__ __forceinline__ void xcd_barrier(const XcdBarrier& b) {
    asm volatile("s_waitcnt vmcnt(0)" ::: "memory");
    __syncthreads();
    if (threadIdx.x == 0) {
        unsigned* bar = b.bar;
        __builtin_amdgcn_s_waitcnt(0);
        unsigned nloc = b.st[0], nx = b.st[1];
        if (nloc == 0u) { xcd_barrier_complete(bar, b.x, nloc, nx); b.st[0] = nloc; b.st[1] = nx; }
        const unsigned old = xb_add(&bar[XB_XSUB(b.x)], 1u);
        const unsigned gen = old / nloc;
        if (old + 1u == (gen + 1u) * nloc) {
            __builtin_amdgcn_fence(__ATOMIC_RELEASE, "agent");
            asm volatile("s_waitcnt vmcnt(0)" ::: "memory");
            const unsigned og = xb_add(&bar[XB_TOP], 1u);
            const unsigned tg = og / nx;
            if (og + 1u == (tg + 1u) * nx) xb_add(&bar[XB_TOPGEN], 1u);
            else XB_SPIN(xb_ld(&bar[XB_TOPGEN]) == tg, bar);
            __builtin_amdgcn_fence(__ATOMIC_ACQUIRE, "agent");
            xb_add(&bar[XB_XGEN(b.x)], 1u);
            asm volatile("s_waitcnt vmcnt(0)" ::: "memory");
        } else {
            XB_SPIN(xb_ld(&bar[XB_XGEN(b.x)]) == gen, bar);
            __builtin_amdgcn_fence(__ATOMIC_ACQUIRE, "agent");
            asm volatile("s_waitcnt vmcnt(0)" ::: "memory");
        }
    }
    __syncthreads();
}

constexpr int NB = 4, SEQ = 8192, D = 1024, M = NB * SEQ;
constexpr int FFN = 2816, EXD = 3584, NEXP = 8;
constexpr int U0W = 2048, U1W = 2560;
constexpr float EPS = 1e-6f;
constexpr int NWAVES = 8, NTHR = NWAVES * 64;
constexpr int SLOTCAP = 34816;
constexpr int NPHASE = 22;
constexpr float FFN_WSC_UP = 32.f, FFN_WSC_DN = 64.f, FFN_HSC = 4.f;
constexpr float MOE_WSC_UP = 32.f, MOE_WSC_DN = 64.f, MOE_HSC = 4.f;

constexpr size_t MiB = 1u << 20;
constexpr size_t WS_CTL = 0, CTL_ZERO_BYTES = 2 * MiB;
constexpr size_t WS_TAB = 2 * MiB;
constexpr size_t T_KMEAN = WS_TAB, T_ROPEC = WS_TAB + 256 * 1024, T_ROPES = WS_TAB + 768 * 1024, T_MD = WS_TAB + 1280 * 1024,
                 T_RSTD4 = WS_TAB + 1536 * 1024, T_TOKE = WS_TAB + 1792 * 1024, T_TOKP = WS_TAB + 2048 * 1024, T_TOKW = WS_TAB + 2304 * 1024,
                 T_SLOTT = WS_TAB + 2560 * 1024, T_SLOTW = WS_TAB + 3072 * 1024, T_SLOTR = WS_TAB + 3584 * 1024, T_TILEE = WS_TAB + 4096 * 1024, T_CNTJ = WS_TAB + 4608 * 1024, T_IDENT = WS_TAB + 4864 * 1024;
constexpr size_t WS_HB = 8 * MiB;
constexpr size_t W_IN0 = 72 * MiB, W_OUT0 = 76 * MiB, W_FFNGU = 78 * MiB, W_FFND = 89 * MiB, W_PLEG0 = 95 * MiB, W_PLEP0 = 97 * MiB,
                 W_IN1 = 98 * MiB, W_UQ = 103 * MiB, W_UKV = 103 * MiB + 512 * 1024, W_OUT1 = 104 * MiB;
constexpr size_t WS_PB0 = 110 * MiB, WS_XN0 = 126 * MiB, WS_P0G = 190 * MiB, WS_MIX0 = 254 * MiB, WS_HMID0 = 318 * MiB;
constexpr size_t WS_HB8 = 500 * MiB;
constexpr size_t WS_LISTS = 320 * MiB, WS_PO = 352 * MiB, WS_PM = 480 * MiB;
constexpr size_t WS_U1 = 126 * MiB, WS_MU = 286 * MiB, WS_MN = 350 * MiB, WS_QM = 352 * MiB, WS_KM = 384 * MiB, WS_VM = 416 * MiB, WS_MIX1 = 448 * MiB;
constexpr size_t W_MOEGU = 72 * MiB, W_MOED = 184 * MiB, WS_HMIDG = 240 * MiB, WS_XG = 478 * MiB, WS_PB1 = 546 * MiB, W_PLEG1 = 562 * MiB, W_PLEP1 = 564 * MiB, WS_P1G = 478 * MiB;
constexpr size_t WS_SSQ = 576 * MiB;
constexpr size_t WS_END = 586 * MiB;
constexpr int CW_TMO = 0, CW_CODE = 1, CW_BAR = 4096, CW_CNT = 32768, CW_SSQ = 65536, CW_MOBA = 131072;
constexpr size_t SSQ_H1 = 0, SSQ_H2 = (size_t)M * 16, SSQ_H3 = (size_t)M * 32, SSQ_H5 = (size_t)M * 48, SSQ_CQ = (size_t)M * 64, SSQ_CKV = (size_t)M * 68;
constexpr int RING_BYTES = 131072, MISC_OFF = RING_BYTES + 320, LDS_BYTES = 147456;

__device__ __forceinline__ float bf2f(unsigned short b) { return __uint_as_float(((unsigned)b) << 16); }
__device__ __forceinline__ float bflo(unsigned w) { return __uint_as_float(w << 16); }
__device__ __forceinline__ float bfhi(unsigned w) { return __uint_as_float(w & 0xffff0000u); }
__device__ __forceinline__ unsigned f2bf(float f) { unsigned u = __builtin_bit_cast(unsigned, f); return (u + 0x7fffu + ((u >> 16) & 1u)) >> 16; }
__device__ __forceinline__ unsigned pk2(float lo, float hi) { return f2bf(lo) | (f2bf(hi) << 16); }
__device__ __forceinline__ float wave_sum(float v) {
#pragma unroll
    for (int o = 1; o < 64; o <<= 1) v += __shfl_xor(v, o);
    return v;
}
__device__ __forceinline__ float silu_f(float x) { return x * __builtin_amdgcn_rcpf(1.f + __expf(-x)); }
__device__ __forceinline__ float sigmoid_f(float x) { return __builtin_amdgcn_rcpf(1.f + __expf(-x)); }
__device__ __forceinline__ float logsig_f(float x) { return fminf(x, 0.f) - log1pf(__expf(-fabsf(x))); }

template <int NP> __device__ __forceinline__ float ssq_row(const float* p, int row) {
    const f32x4* q = (const f32x4*)(p + (size_t)row * NP); float s = 0.f;
#pragma unroll
    for (int i = 0; i < NP / 4; ++i) { const f32x4 v = q[i]; s += (v[0] + v[1]) + (v[2] + v[3]); }
    return s;
}
namespace epi {
using pg8::Unit; using pg8::cvt_pk_bf16;
typedef pg8::f32x4 F4;
typedef pg8::u32x2 U2;
#define ACC_T const F4 (&acc)[2][2][4][2]

struct Store {
    static constexpr bool PERM = true, AFTER_DRAIN = false;
    bf16* O; int ldc; const float* ssq; float invn;
    __device__ __forceinline__ void operator()(ACC_T, const Unit& u, int wr, int wc, int fr, int fq) const {
        const int row0 = u.pm * 256 + wr * 64 + fr, cl0 = wc * 32 + 8 * fq;
#pragma unroll
        for (int ai = 0; ai < 2; ++ai)
#pragma unroll
            for (int m = 0; m < 4; ++m) { const int row = row0 + ai * 128 + m * 16; float rs = 1.f; if (ssq) rs = rsqrtf(ssq_row<16>(ssq, row) * invn + EPS);
                bf16* rp = O + (size_t)row * ldc + u.pn * 256 + cl0;
#pragma unroll
                for (int bj = 0; bj < 2; ++bj) { const F4 v0 = acc[ai][bj][m][0] * rs, v1 = acc[ai][bj][m][1] * rs; v4u w; w.x = cvt_pk_bf16(v0[0], v0[1]); w.y = cvt_pk_bf16(v0[2], v0[3]); w.z = cvt_pk_bf16(v1[0], v1[1]); w.w = cvt_pk_bf16(v1[2], v1[3]);
                    *(v4u*)(rp + bj * 128) = w; } }
    }
};
struct U1 {
    static constexpr bool PERM = true, AFTER_DRAIN = false;
    bf16* O; const float* ssq_in; float* ssq_cq; float* ssq_ckv; bf16* Km; const float* ropec; const float* ropes;
    __device__ __forceinline__ void operator()(ACC_T, const Unit& u, int wr, int wc, int fr, int fq) const {
        const int row0 = u.pm * 256 + wr * 64 + fr, cl0 = wc * 32 + 8 * fq;
#pragma unroll
        for (int ai = 0; ai < 2; ++ai)
#pragma unroll
            for (int m = 0; m < 4; ++m) { const int row = row0 + ai * 128 + m * 16; const float rs = rsqrtf(ssq_row<4>(ssq_in, row) * (1.f / 1024.f) + EPS);
                bf16* rp = O + (size_t)row * U1W + u.pn * 256 + cl0; float s0 = 0.f, s1 = 0.f;
#pragma unroll
                for (int bj = 0; bj < 2; ++bj) { const F4 v0 = acc[ai][bj][m][0] * rs, v1 = acc[ai][bj][m][1] * rs; v4u w; w.x = cvt_pk_bf16(v0[0], v0[1]); w.y = cvt_pk_bf16(v0[2], v0[3]); w.z = cvt_pk_bf16(v1[0], v1[1]); w.w = cvt_pk_bf16(v1[2], v1[3]);
                    *(v4u*)(rp + bj * 128) = w;
                    const float sq = ((v0[0] * v0[0] + v0[1] * v0[1]) + (v0[2] * v0[2] + v0[3] * v0[3])) + ((v1[0] * v1[0] + v1[1] * v1[1]) + (v1[2] * v1[2] + v1[3] * v1[3])); if (bj == 0) s0 += sq; else s1 += sq; }
                if (u.pn == 9 && wc == 0) {
                    const int t = row & (SEQ - 1), j0 = 8 * (fq & 1); const F4 c0 = *(const F4*)(ropec + t * 16 + j0), c1 = *(const F4*)(ropec + t * 16 + j0 + 4), n0 = *(const F4*)(ropes + t * 16 + j0), n1 = *(const F4*)(ropes + t * 16 + j0 + 4);
                    const F4 a0 = acc[ai][1][m][0] * rs, a1 = acc[ai][1][m][1] * rs; F4 p0, p1;
#pragma unroll
                    for (int i = 0; i < 4; ++i) { p0[i] = __shfl_xor(a0[i], 32); p1[i] = __shfl_xor(a1[i], 32); }
                    F4 r0, r1;
                    if (fq < 2) { r0 = a0 * c0 - p0 * n0; r1 = a1 * c1 - p1 * n1; }
                    else        { r0 = p0 * n0 + a0 * c0; r1 = p1 * n1 + a1 * c1; }
                    v4u w; w.x = cvt_pk_bf16(r0[0], r0[1]); w.y = cvt_pk_bf16(r0[2], r0[3]); w.z = cvt_pk_bf16(r1[0], r1[1]); w.w = cvt_pk_bf16(r1[2], r1[3]); const v4u z = (v4u){0u, 0u, 0u, 0u};
#pragma unroll
                    for (int h = 0; h < 4; ++h) { bf16* kr = Km + (size_t)row * 512 + h * 128; *(v4u*)(kr + 64 + 8 * fq) = w; *(v4u*)(kr + 96 + 8 * fq) = z; } }
                if (u.pn >= 8) { float s = (u.pn == 8) ? (s0 + s1) : s0; s += __shfl_xor(s, 16); s += __shfl_xor(s, 32);
                    if (fq == 0) ssq_cq[((u.pn == 8) ? 0l : (long)(ssq_ckv - ssq_cq)) + (size_t)row * 4 + wc] = s; } }
    }
};
template <bool RSTD_ARR> struct SwiGLU {
    static constexpr bool PERM = true, AFTER_DRAIN = false;
    bf16* O; int ldc; const float* rsrc; float invn;
    __device__ __forceinline__ void operator()(ACC_T, const Unit& u, int wr, int wc, int fr, int fq) const {
        const int row0 = u.pm * 256 + wr * 64 + fr, cl0 = wc * 32 + 8 * fq;
#pragma unroll
        for (int ai = 0; ai < 2; ++ai)
#pragma unroll
            for (int m = 0; m < 4; ++m) { const int row = row0 + ai * 128 + m * 16; const float rs = RSTD_ARR ? rsrc[row] : rsqrtf(ssq_row<16>(rsrc, row) * invn + EPS);
                float h[8];
#pragma unroll
                for (int n = 0; n < 2; ++n) { const F4 g = acc[ai][0][m][n] * rs, uu = acc[ai][1][m][n] * rs;
#pragma unroll
                    for (int j = 0; j < 4; ++j) h[4 * n + j] = g[j] * __builtin_amdgcn_rcpf(1.f + __expf(-g[j])) * uu[j]; }
                v4u w; w.x = cvt_pk_bf16(h[0], h[1]); w.y = cvt_pk_bf16(h[2], h[3]); w.z = cvt_pk_bf16(h[4], h[5]); w.w = cvt_pk_bf16(h[6], h[7]);
                *(v4u*)(O + (size_t)row * ldc + u.pn * 128 + cl0) = w; }
    }
};
template <int RSTD_ARR  > struct SwiGLU8 {
    static constexpr bool PERM = true, AFTER_DRAIN = false;
    unsigned char* O; int ldc; const float* rsrc; float iwsc, osc;
    __device__ __forceinline__ void operator()(ACC_T, const Unit& u, int wr, int wc, int fr, int fq) const {
        const int row0 = u.pm * 256 + wr * 64 + fr, cl0 = wc * 32 + 8 * fq;
#pragma unroll
        for (int ai = 0; ai < 2; ++ai)
#pragma unroll
            for (int m = 0; m < 4; ++m) { const int row = row0 + ai * 128 + m * 16; const float rs = (RSTD_ARR == 2 ? 1.f : RSTD_ARR == 1 ? rsrc[row] : rsqrtf(ssq_row<4>(rsrc, row) * (1.f / 1024.f) + EPS)) * iwsc;
                const float k1 = -1.4426950408889634f * rs, k2 = rs * rs * osc;
                F4 hv[2];
#pragma unroll
                for (int n = 0; n < 2; ++n) { const F4 ag = acc[ai][0][m][n], au = acc[ai][1][m][n]; F4 e = ag * k1;
#pragma unroll
                    for (int j = 0; j < 4; ++j) e[j] = __builtin_amdgcn_exp2f(e[j]);
                    e = e + 1.f;
#pragma unroll
                    for (int j = 0; j < 4; ++j) e[j] = __builtin_amdgcn_rcpf(e[j]);
                    hv[n] = (ag * au) * (e * k2); }
                int w0 = 0, w1 = 0; w0 = __builtin_amdgcn_cvt_pk_fp8_f32(hv[0][0], hv[0][1], w0, false); w0 = __builtin_amdgcn_cvt_pk_fp8_f32(hv[0][2], hv[0][3], w0, true);
                w1 = __builtin_amdgcn_cvt_pk_fp8_f32(hv[1][0], hv[1][1], w1, false); w1 = __builtin_amdgcn_cvt_pk_fp8_f32(hv[1][2], hv[1][3], w1, true);
                *(v2u*)(O + (size_t)row * ldc + u.pn * 128 + cl0) = (v2u){(unsigned)w0, (unsigned)w1}; }
    }
};
template <int MODE, bool BASEF32, bool SSQ> struct Res {
    static constexpr bool PERM = true, AFTER_DRAIN = false;
    const float* basef; const bf16* baseb; bf16* out; float* ssq_out; const float* ssq_in; const bf16* P; const int* tok; const float* sw; float oscale; unsigned char* out8; LAS float* red;
    __device__ __forceinline__ void operator()(ACC_T, const Unit& u, int wr, int wc, int fr, int fq) const {
        const int row0 = u.pm * 256 + wr * 64 + fr, cl0 = wc * 32 + 8 * fq;
#pragma unroll
        for (int ai = 0; ai < 2; ++ai)
#pragma unroll
            for (int m = 0; m < 4; ++m) { const int row = row0 + ai * 128 + m * 16; int orow = row; bool ok = true; float wgt = 1.f, rs = 0.f;
                if (MODE == 2) { orow = tok[row]; ok = orow >= 0; wgt = sw[row] * oscale; if (!ok) { orow = 0; wgt = 0.f; } }
                if (MODE == 1) rs = rsqrtf(ssq_row<4>(ssq_in, row) * (1.f / 1024.f) + EPS);
                const size_t off = (size_t)orow * D + u.pn * 256 + cl0; float s = 0.f;
#pragma unroll
                for (int bj = 0; bj < 2; ++bj) { const size_t o2 = off + bj * 128; const F4 a0 = acc[ai][bj][m][0], a1 = acc[ai][bj][m][1]; F4 b0, b1, h0, h1;
                    if (BASEF32) { b0 = *(const F4*)(basef + o2); b1 = *(const F4*)(basef + o2 + 4); }
                    else { const v4u w = *(const v4u*)(baseb + o2); b0 = (F4){bflo(w.x), bfhi(w.x), bflo(w.y), bfhi(w.y)}; b1 = (F4){bflo(w.z), bfhi(w.z), bflo(w.w), bfhi(w.w)}; }
                    if (MODE == 0) { h0 = b0 + a0 * oscale; h1 = b1 + a1 * oscale; }
                    if (MODE == 1) { const v4u pw = *(const v4u*)(P + o2);
                        h0[0] = b0[0] + bflo(pw.x) * __builtin_amdgcn_rcpf(1.f + __expf(-rs * a0[0])); h0[1] = b0[1] + bfhi(pw.x) * __builtin_amdgcn_rcpf(1.f + __expf(-rs * a0[1])); h0[2] = b0[2] + bflo(pw.y) * __builtin_amdgcn_rcpf(1.f + __expf(-rs * a0[2])); h0[3] = b0[3] + bfhi(pw.y) * __builtin_amdgcn_rcpf(1.f + __expf(-rs * a0[3]));
                        h1[0] = b1[0] + bflo(pw.z) * __builtin_amdgcn_rcpf(1.f + __expf(-rs * a1[0])); h1[1] = b1[1] + bfhi(pw.z) * __builtin_amdgcn_rcpf(1.f + __expf(-rs * a1[1])); h1[2] = b1[2] + bflo(pw.w) * __builtin_amdgcn_rcpf(1.f + __expf(-rs * a1[2])); h1[3] = b1[3] + bfhi(pw.w) * __builtin_amdgcn_rcpf(1.f + __expf(-rs * a1[3])); }
                    if (MODE == 2) { h0 = b0 + a0 * wgt; h1 = b1 + a1 * wgt; }
                    if (ok) { v4u w; w.x = cvt_pk_bf16(h0[0], h0[1]); w.y = cvt_pk_bf16(h0[2], h0[3]); w.z = cvt_pk_bf16(h1[0], h1[1]); w.w = cvt_pk_bf16(h1[2], h1[3]); *(v4u*)(out + o2) = w;
                        if (out8) { int q0 = 0, q1 = 0; q0 = __builtin_amdgcn_cvt_pk_fp8_f32(h0[0], h0[1], q0, false); q0 = __builtin_amdgcn_cvt_pk_fp8_f32(h0[2], h0[3], q0, true); q1 = __builtin_amdgcn_cvt_pk_fp8_f32(h1[0], h1[1], q1, false); q1 = __builtin_amdgcn_cvt_pk_fp8_f32(h1[2], h1[3], q1, true); *(v2u*)(out8 + o2) = (v2u){(unsigned)q0, (unsigned)q1}; } }
                    s += ((h0[0] * h0[0] + h0[1] * h0[1]) + (h0[2] * h0[2] + h0[3] * h0[3])) + ((h1[0] * h1[0] + h1[1] * h1[1]) + (h1[2] * h1[2] + h1[3] * h1[3])); }
                if (SSQ) { s += __shfl_xor(s, 16); s += __shfl_xor(s, 32); if (fq == 0) red[(row - u.pm * 256) * 4 + wc] = s; } }
        if (SSQ) {
            asm volatile("s_waitcnt lgkmcnt(0)" ::: "memory"); __builtin_amdgcn_s_barrier();
            if (wr == 0) { const int rl = wc * 64 + fq * 16 + fr; const F4 v = *(const LAS F4*)(red + rl * 4); int orow = u.pm * 256 + rl; if (MODE == 2) orow = tok[orow];
                if (orow >= 0) ssq_out[(size_t)orow * 4 + u.pn] = (v[0] + v[1]) + (v[2] + v[3]); } }
    }
};
struct MlaQ {
    static constexpr bool PERM = false, AFTER_DRAIN = false;
    bf16* Qm; const float* ssq_cq; const float* ropec; const float* ropes;
    __device__ __forceinline__ void operator()(ACC_T, const Unit& u, int wr, int wc, int fr, int fq) const {
        const int row0 = u.pm * 256 + wr * 64 + fr;
#pragma unroll
        for (int ai = 0; ai < 2; ++ai)
#pragma unroll
            for (int m = 0; m < 4; ++m) { const int row = row0 + ai * 128 + m * 16; const float rs = rsqrtf(ssq_row<4>(ssq_cq, row) * (1.f / 256.f) + EPS); bf16* qr = Qm + (size_t)row * 512;
                if (u.pn == 0) {
#pragma unroll
                    for (int bj = 0; bj < 2; ++bj)
#pragma unroll
                        for (int n = 0; n < 2; ++n) { const F4 v = acc[ai][bj][m][n] * rs; U2 w; w.x = cvt_pk_bf16(v[0], v[1]); w.y = cvt_pk_bf16(v[2], v[3]);
                            *(U2*)(qr + (2 * bj + (wc >> 1)) * 128 + (wc & 1) * 32 + n * 16 + 4 * fq) = w; }
                } else {
                    const int t = row & (SEQ - 1); const F4 cs = *(const F4*)(ropec + t * 16 + 4 * fq), sn = *(const F4*)(ropes + t * 16 + 4 * fq);
                    const F4 x1 = acc[ai][0][m][0] * rs, x2 = acc[ai][0][m][1] * rs; const F4 r1 = x1 * cs - x2 * sn, r2 = x1 * sn + x2 * cs;
                    U2 w; w.x = cvt_pk_bf16(r1[0], r1[1]); w.y = cvt_pk_bf16(r1[2], r1[3]); *(U2*)(qr + wc * 128 + 64 + 4 * fq) = w;
                    w.x = cvt_pk_bf16(r2[0], r2[1]); w.y = cvt_pk_bf16(r2[2], r2[3]); *(U2*)(qr + wc * 128 + 80 + 4 * fq) = w;
                    w.x = 0u; w.y = 0u; *(U2*)(qr + wc * 128 + 96 + 4 * fq) = w; *(U2*)(qr + wc * 128 + 112 + 4 * fq) = w;
                } }
    }
};
struct MlaKV {
    static constexpr bool PERM = false, AFTER_DRAIN = false;
    bf16* Km; bf16* Vm; const float* ssq_ckv;
    __device__ __forceinline__ void operator()(ACC_T, const Unit& u, int wr, int wc, int fr, int fq) const {
        const int row0 = u.pm * 256 + wr * 64 + fr; const long vdelta = Vm - Km;
#pragma unroll
        for (int ai = 0; ai < 2; ++ai)
#pragma unroll
            for (int m = 0; m < 4; ++m) { const int row = row0 + ai * 128 + m * 16; const float rs = rsqrtf(ssq_row<4>(ssq_ckv, row) * (1.f / 128.f) + EPS);
#pragma unroll
                for (int bj = 0; bj < 2; ++bj)
#pragma unroll
                    for (int n = 0; n < 2; ++n) { const F4 v = acc[ai][bj][m][n] * rs; U2 w; w.x = cvt_pk_bf16(v[0], v[1]); w.y = cvt_pk_bf16(v[2], v[3]);
                        const long offk = (2 * bj + (wc >> 1)) * 128 + (wc & 1) * 32 + n * 16 + 4 * fq, offv = vdelta + (u.pn - 1) * 256 + bj * 128 + wc * 32 + n * 16 + 4 * fq;
                        *(U2*)(Km + (size_t)row * 512 + ((u.pn == 0) ? offk : offv)) = w; } }
    }
};
#undef ACC_T
}

struct MoeOrder {
    const int* tile_e; int ntiles, NT, x, r, per;
    __device__ __forceinline__ void init(const int* te, int nt_, int NT_, int G, int c) { tile_e = te; ntiles = nt_; NT = NT_; if (G % 8 == 0) { x = c % 8; r = c / 8; per = G / 8; } else { x = -1; r = c; per = G; } }
    __device__ __forceinline__ bool next(int i, pg8::Unit& u) const {
        const int j = i * per + r; int T, pn;
        if (x >= 0) { T = x + 8 * (j / NT); pn = j % NT; } else { T = j / NT; pn = j % NT; }
        if (T >= ntiles) return false;
        u.pm = T; u.pn = pn; u.pb = tile_e[T] * NT + pn; return true;
    }
    __device__ __forceinline__ void a_ready(const pg8::Unit&) const {}
    __device__ __forceinline__ void done(const pg8::Unit&) const {}
};

struct MoeOrderC {
    const int* tab; int ntiles, NT, x, r, per;
    __device__ __forceinline__ void init(const int* tb, int nt_, int NT_, int G, int c) { tab = tb; ntiles = nt_; NT = NT_; if (G % 8 == 0) { x = c % 8; r = c / 8; per = G / 8; } else { x = -1; r = c; per = G; } }
    __device__ __forceinline__ bool next(int i, pg8::Unit& u) const {
        const int j = i * per + r; int T, pn;
        if (x >= 0) { T = x + 8 * (j / NT); pn = j % NT; } else { T = j / NT; pn = j % NT; }
        if (T >= ntiles) return false;
        const int v = tab[T]; u.pm = v & 0xffff; u.pn = pn; u.pb = (v >> 16) * NT + pn; return true;
    }
    __device__ __forceinline__ void a_ready(const pg8::Unit&) const {}
    __device__ __forceinline__ void done(const pg8::Unit&) const {}
};

struct LightDeal {
    int lr, nl; bool light;
    __device__ __forceinline__ void init(int ntiles, int G, int c) {
        if (G != 256) { lr = c; nl = G; light = true; return; }
        int hb = 0, ha = 0; bool heavy = false;
#pragma unroll
        for (int x = 0; x < 8; ++x) { const int cnt = (ntiles - x + 7) >> 3; int hx = 4 * cnt - 64; hx = hx < 0 ? 0 : (hx > 32 ? 32 : hx);
            const int ni = (c - x + 7) >> 3;
            hb += ni < hx ? ni : hx; ha += hx; if ((c & 7) == x && (c >> 3) < hx) heavy = true; }
        light = !heavy; lr = c - hb; nl = 256 - ha; }
};
struct LeftOrder {
    const int* tab; int nun, NT, lr, nl; bool on;
    __device__ __forceinline__ void init(const int* tb, int ntl, int NT_, const LightDeal& d) { tab = tb; NT = NT_; nun = ntl * NT_; lr = d.lr; nl = d.nl; on = d.light; }
    __device__ __forceinline__ bool next(int i, pg8::Unit& u) const {
        const int idx = i * nl + lr; if (!on || idx >= nun) return false;
        const int tl = idx / NT, pn = idx - tl * NT; const int v = tab[tl]; u.pm = v & 0xffff; u.pn = pn; u.pb = (v >> 16) * NT + pn; return true;
    }
    __device__ __forceinline__ void a_ready(const pg8::Unit&) const {}
    __device__ __forceinline__ void done(const pg8::Unit&) const {}
};
struct LightStatic {
    pg8::StaticOrder S; bool on;
    __device__ __forceinline__ void init(int M_, int N_, const LightDeal& d) { S.init(M_, N_, d.nl, d.lr); on = d.light; }
    __device__ __forceinline__ bool next(int i, pg8::Unit& u) const { return on && S.next(i, u); }
    __device__ __forceinline__ void a_ready(const pg8::Unit&) const {}
    __device__ __forceinline__ void done(const pg8::Unit&) const {}
};

enum { MAP_ID = 0, MAP_IL = 1, MAP_U1 = 2, MAP_UQ = 3, MAP_UKV = 4 };
template <int MAP> __device__ __forceinline__ int map_src(int r, int& which) {
    which = 0;
    if (MAP == MAP_ID) return r;
    if (MAP == MAP_IL) { const int blk = r >> 8, w = r & 255; which = (w >= 128) ? 1 : 0; return blk * 128 + (w & 127); }
    if (MAP == MAP_U1) { if (r < 2048) return r; if (r < 2304) return 2056 + (r - 2048); if (r < 2432) return 2312 + (r - 2304); if (r < 2464) return 2440 + (r - 2432);
                         if (r < 2468) return 2048 + (r - 2464); if (r < 2472) return 2052 + (r - 2468); return -1; }
    if (MAP == MAP_UQ) { if (r < 256) return (r >> 6) * 96 + (r & 63); if (r < 384) return ((r - 256) >> 5) * 96 + 64 + (r & 31); return -1; }
    { if (r < 256) return (r >> 6) * 192 + (r & 63); const int rr = r - 256; return (rr >> 7) * 192 + 64 + (rr & 127); }
}
template <int MAP, bool OUT8 = false> __device__ __forceinline__ void cvt_job(const float* s0, const float* s1, const float* gain, bf16* dst, int Ks, int Ns, int Nd, int Kd, int Kext, int koff,
                                                           LAS float* scr, int gw, int NGW, int& rot, int lane, float oscale = 1.f) {
    const int nkb = Kext / 64, nitems = (Nd / 32) * nkb;
    int first = gw - rot; if (first < 0) first += NGW;
    for (int it = first; it < nitems; it += NGW) {
        const int rb = it / nkb, kb = it - rb * nkb, r0 = rb * 32, k0 = kb * 64;
        if (MAP == MAP_ID || MAP == MAP_IL || (MAP == MAP_U1 && r0 < 2048)) {
            int which; const int sc0 = map_src<MAP>(r0, which); const float* src = (which ? s1 : s0) + sc0 + (lane & 7) * 4; const int kq = lane >> 3;
            f32x4 v[8];
#pragma unroll
            for (int i = 0; i < 8; ++i) v[i] = *(const f32x4*)(src + (size_t)(k0 + 8 * i + kq) * Ns);
#pragma unroll
            for (int i = 0; i < 8; ++i) { f32x4 t = v[i]; if (gain) t = t * gain[k0 + 8 * i + kq]; LAS float* sp = scr + (8 * i + kq) * 33 + (lane & 7) * 4; sp[0] = t[0]; sp[1] = t[1]; sp[2] = t[2]; sp[3] = t[3]; }
        } else {
        int which; const int sc = map_src<MAP>(r0 + (lane & 31), which); const float* src = which ? s1 : s0;
#pragma unroll
        for (int i = 0; i < 32; ++i) { const int kk = 2 * i + (lane >> 5), k = k0 + kk; float v = 0.f;
            if (sc >= 0 && k < Ks) { v = src[(size_t)k * Ns + sc]; if (gain) v *= gain[k]; }
            scr[kk * 33 + (lane & 31)] = v; }
        }
        asm volatile("s_waitcnt lgkmcnt(0)" ::: "memory");
        if (OUT8) {
#pragma unroll
            for (int j = 0; j < 2; ++j) { const int idx = lane + 64 * j, n = idx >> 2, cch = idx & 3; const LAS float* s = scr + (16 * cch) * 33 + n; int w[4];
#pragma unroll
                for (int q = 0; q < 4; ++q) { int t = 0; t = __builtin_amdgcn_cvt_pk_fp8_f32(s[(4 * q) * 33] * oscale, s[(4 * q + 1) * 33] * oscale, t, false); t = __builtin_amdgcn_cvt_pk_fp8_f32(s[(4 * q + 2) * 33] * oscale, s[(4 * q + 3) * 33] * oscale, t, true); w[q] = t; }
                *(v4u*)((unsigned char*)dst + (size_t)(r0 + n) * Kd + koff + k0 + 16 * cch) = (v4u){(unsigned)w[0], (unsigned)w[1], (unsigned)w[2], (unsigned)w[3]}; }
        } else {
        const int c = lane & 7;
#pragma unroll
        for (int j = 0; j < 4; ++j) { const int n = (lane >> 3) + 8 * j; const LAS float* s = scr + (8 * c) * 33 + n;
            v4u o; o.x = pk2(s[0 * 33], s[1 * 33]); o.y = pk2(s[2 * 33], s[3 * 33]); o.z = pk2(s[4 * 33], s[5 * 33]); o.w = pk2(s[6 * 33], s[7 * 33]);
            *(v4u*)(dst + (size_t)(r0 + n) * Kd + koff + k0 + 8 * c) = o; }
        }
        asm volatile("s_waitcnt lgkmcnt(0)" ::: "memory");
    }
    rot = (rot + nitems) % NGW;
}
template <int MAP, bool OUT8 = false> __device__ __forceinline__ void cvt_pipe(const float* s0, const float* s1, const float* gain, bf16* dst, int Ns, int Nd, int Kd, int Kext, int koff,
                                                            LAS float* scr, int gw, int NGW, int& rot, int lane, float oscale = 1.f) {
    static_assert(MAP == MAP_ID || MAP == MAP_IL, "16-byte-load maps only");
    const int nkb = Kext / 64, nitems = (Nd / 32) * nkb, kq = lane >> 3;
    int it = gw - rot; if (it < 0) it += NGW;
    f32x4 v[8];
#define CVP_LOAD(dst_, it_) do { const int rb_ = (it_) / nkb, kb_ = (it_) - rb_ * nkb; int wh_; const int sc_ = map_src<MAP>(rb_ * 32, wh_); const float* sp_ = (wh_ ? s1 : s0) + sc_ + (lane & 7) * 4 + (size_t)(kb_ * 64 + kq) * Ns; \
        _Pragma("unroll") for (int i = 0; i < 8; ++i) dst_[i] = *(const f32x4*)(sp_ + (size_t)(8 * i) * Ns); } while (0)
    if (it < nitems) CVP_LOAD(v, it);
    for (; it < nitems; it += NGW) {
        const int rb = it / nkb, kb = it - rb * nkb, r0 = rb * 32, k0 = kb * 64; const int itn = it + NGW;
        f32x4 vn[8];
#pragma unroll
        for (int i = 0; i < 8; ++i) vn[i] = v[i];
        if (itn < nitems) CVP_LOAD(vn, itn);
#pragma unroll
        for (int i = 0; i < 8; ++i) { f32x4 t = v[i]; if (gain) t = t * gain[k0 + 8 * i + kq]; LAS float* sp = scr + (8 * i + kq) * 33 + (lane & 7) * 4; sp[0] = t[0]; sp[1] = t[1]; sp[2] = t[2]; sp[3] = t[3]; }
        asm volatile("s_waitcnt lgkmcnt(0)" ::: "memory");
        if (OUT8) {
#pragma unroll
            for (int j = 0; j < 2; ++j) { const int idx = lane + 64 * j, n = idx >> 2, cch = idx & 3; const LAS float* sq = scr + (16 * cch) * 33 + n; int w[4];
#pragma unroll
                for (int q = 0; q < 4; ++q) { int t = 0; t = __builtin_amdgcn_cvt_pk_fp8_f32(sq[(4 * q) * 33] * oscale, sq[(4 * q + 1) * 33] * oscale, t, false); t = __builtin_amdgcn_cvt_pk_fp8_f32(sq[(4 * q + 2) * 33] * oscale, sq[(4 * q + 3) * 33] * oscale, t, true); w[q] = t; }
                *(v4u*)((unsigned char*)dst + (size_t)(r0 + n) * Kd + koff + k0 + 16 * cch) = (v4u){(unsigned)w[0], (unsigned)w[1], (unsigned)w[2], (unsigned)w[3]}; }
        } else {
            const int c = lane & 7;
#pragma unroll
            for (int j = 0; j < 4; ++j) { const int n = (lane >> 3) + 8 * j; const LAS float* sq = scr + (8 * c) * 33 + n;
                v4u o; o.x = pk2(sq[0 * 33], sq[1 * 33]); o.y = pk2(sq[2 * 33], sq[3 * 33]); o.z = pk2(sq[4 * 33], sq[5 * 33]); o.w = pk2(sq[6 * 33], sq[7 * 33]);
                *(v4u*)(dst + (size_t)(r0 + n) * Kd + koff + k0 + 8 * c) = o; }
        }
        asm volatile("s_waitcnt lgkmcnt(0)" ::: "memory");
#pragma unroll
        for (int i = 0; i < 8; ++i) v[i] = vn[i];
    }
#undef CVP_LOAD
    rot = (rot + nitems) % NGW;
}
__device__ __forceinline__ void cvt_fold(const float* pw, const float* ps, const float* wo, bf16* dst, LAS float* scr, int gw, int NGW, int& rot, int lane) {
    const int nitems = 32 * 64;
    int first = gw - rot; if (first < 0) first += NGW;
    for (int it = first; it < nitems; it += NGW) {
        const int rb = it >> 6, gc = it & 63, g = gc >> 4, c0 = (gc & 15) * 8, n = rb * 32 + (lane & 31), ch = lane >> 5;
        float acc[4];
#pragma unroll
        for (int i = 0; i < 4; ++i) acc[i] = 0.f;
#pragma unroll 8
        for (int d = 0; d < 128; ++d) { const float wv = wo[(size_t)(512 + g * 128 + d) * D + n] * ps[g * 128 + d]; const float* pr = pw + ((size_t)g * 128 + c0 + ch) * 128 + d;
#pragma unroll
            for (int i = 0; i < 4; ++i) acc[i] += pr[(size_t)(2 * i) * 128] * wv; }
#pragma unroll
        for (int i = 0; i < 4; ++i) scr[(2 * i + ch) * 33 + (lane & 31)] = acc[i];
        asm volatile("s_waitcnt lgkmcnt(0)" ::: "memory");
        if (lane < 32) { const LAS float* s = scr + lane;
            v4u o; o.x = pk2(s[0 * 33], s[1 * 33]); o.y = pk2(s[2 * 33], s[3 * 33]); o.z = pk2(s[4 * 33], s[5 * 33]); o.w = pk2(s[6 * 33], s[7 * 33]);
            *(v4u*)(dst + (size_t)(rb * 32 + lane) * D + 512 + g * 128 + c0) = o; }
        asm volatile("s_waitcnt lgkmcnt(0)" ::: "memory");
    }
    rot = (rot + nitems) % NGW;
}
__device__ __forceinline__ void cvt_flat(const float* src, bf16* dst, size_t n4, size_t gt, size_t GT) {
    for (size_t i = gt; i < n4; i += GT) { const f32x4 v = ((const f32x4*)src)[i]; v2u w; w.x = pk2(v[0], v[1]); w.y = pk2(v[2], v[3]); ((v2u*)dst)[i] = w; }
}

template <int DK, int DV, int TPQ, int KG, bool MOBA>
__device__ __forceinline__ void attn_naive(LAS unsigned char* lds, const bf16* Qp, int ldq, int qhp, const bf16* Kp, int ldk, int khp, const bf16* Vp, int ldv, int vhp,
                                           bf16* Op, int ldo, int ohp, int NH, float scale, const float* kmean, int G, int c) {
    constexpr int DKH = DK / TPQ, DVH = DV / TPQ, QT = NTHR / TPQ, NQT = SEQ / QT;
    static_assert(!MOBA || TPQ == 2, "MoBA units are whole 256-query blocks");
    LAS unsigned short* Ks = (LAS unsigned short*)lds;
    LAS unsigned short* Vs = Ks + 64 * DK;
    LAS unsigned* bmask = (LAS unsigned*)(lds + 64 * (DK + DV) * 2);
    const int tid = tid_fresh(), qi = tid / TPQ, half = tid % TPQ;
    const int nunits = NB * NH * NQT;
    for (int u = c; u < nunits; u += G) {
        const int qt = NQT - 1 - (u / (NB * NH)), bh = u % (NB * NH), b = bh / NH, h = bh % NH;
        const int tq = qt * QT + qi; const size_t row = (size_t)b * SEQ + tq;
        float q[DKH];
        { const v4u* qp = (const v4u*)(Qp + row * ldq + h * qhp + half * DKH);
#pragma unroll
          for (int i = 0; i < DKH / 8; ++i) { const v4u w = qp[i]; q[8 * i + 0] = bflo(w.x); q[8 * i + 1] = bfhi(w.x); q[8 * i + 2] = bflo(w.y); q[8 * i + 3] = bfhi(w.y);
              q[8 * i + 4] = bflo(w.z); q[8 * i + 5] = bfhi(w.z); q[8 * i + 6] = bflo(w.w); q[8 * i + 7] = bfhi(w.w); } }
        unsigned sel = 0u, bm = 0xffffffffu; float slope = 0.f;
        if (MOBA) {
            slope = exp2f(-(float)(h + 1));
            float t0 = -3e38f, t1 = -3e38f, t2 = -3e38f; int i0 = -1, i1 = -1, i2 = -1;
#pragma unroll 1
            for (int n = 0; n < qt; ++n) { const f32x4* km = (const f32x4*)(kmean + ((size_t)(b * NH + h) * 32 + n) * 64 + half * DKH); float g = 0.f;
#pragma unroll
                for (int i = 0; i < DKH / 4; ++i) { const f32x4 kv = km[i]; g += q[4 * i] * kv[0] + q[4 * i + 1] * kv[1] + q[4 * i + 2] * kv[2] + q[4 * i + 3] * kv[3]; }
#pragma unroll
                for (int o_ = 1; o_ < TPQ; o_ <<= 1) g += __shfl_xor(g, o_);
                if (g > t0) { t2 = t1; i2 = i1; t1 = t0; i1 = i0; t0 = g; i0 = n; } else if (g > t1) { t2 = t1; i2 = i1; t1 = g; i1 = n; } else if (g > t2) { t2 = g; i2 = n; } }
            if (i0 >= 0) sel |= 1u << i0; if (i1 >= 0) sel |= 1u << i1; if (i2 >= 0) sel |= 1u << i2;
            __syncthreads(); if (tid == 0) *bmask = 0u; __syncthreads(); if (sel) atomicOr((unsigned*)bmask, sel); __syncthreads(); bm = *bmask;
        }
        float m_run = -1e30f, l_run = 0.f; float o[DVH];
#pragma unroll
        for (int i = 0; i < DVH; ++i) o[i] = 0.f;
        const int nkt = (qt + 1) * QT / 64;
#pragma unroll 1
        for (int kt = 0; kt < nkt; ++kt) {
            const int n = kt >> 2; const bool own = (n == qt);
            if (MOBA && !own && !((bm >> n) & 1u)) continue;
            __syncthreads();
            { const bf16* kg = Kp + ((size_t)b * SEQ + kt * 64) * ldk + h * khp; const bf16* vg = Vp + ((size_t)b * SEQ + kt * 64) * ldv + h * vhp;
              for (int idx = tid; idx < 64 * DK / 8; idx += NTHR) { const int r = idx / (DK / 8), c8 = idx % (DK / 8); *(LAS v4u*)(Ks + r * DK + c8 * 8) = *(const v4u*)(kg + (size_t)r * ldk + c8 * 8); }
              for (int idx = tid; idx < 64 * DV / 8; idx += NTHR) { const int r = idx / (DV / 8), c8 = idx % (DV / 8); *(LAS v4u*)(Vs + r * DV + c8 * 8) = *(const v4u*)(vg + (size_t)r * ldv + c8 * 8); } }
            __syncthreads();
            const bool mine = MOBA ? (own || ((sel >> n) & 1u)) : true;
#pragma unroll 1
            for (int k4 = 0; k4 < 64; k4 += KG) {
                float s[KG];
#pragma unroll
                for (int j = 0; j < KG; ++j) { const LAS v4u* kr = (const LAS v4u*)(Ks + (k4 + j) * DK + half * DKH); float a = 0.f;
#pragma unroll
                    for (int i = 0; i < DKH / 8; ++i) { const v4u w = kr[i]; a += q[8 * i] * bflo(w.x) + q[8 * i + 1] * bfhi(w.x) + q[8 * i + 2] * bflo(w.y) + q[8 * i + 3] * bfhi(w.y)
                                                                      + q[8 * i + 4] * bflo(w.z) + q[8 * i + 5] * bfhi(w.z) + q[8 * i + 6] * bflo(w.w) + q[8 * i + 7] * bfhi(w.w); }
#pragma unroll
                    for (int o_ = 1; o_ < TPQ; o_ <<= 1) a += __shfl_xor(a, o_);
                    const int tk = kt * 64 + k4 + j; float sv = a * scale; if (MOBA) sv -= slope * (float)(tq - tk);
                    s[j] = (mine && tk <= tq) ? sv : -1e30f; }
                float mnew = m_run;
#pragma unroll
                for (int j = 0; j < KG; ++j) mnew = fmaxf(mnew, s[j]);
                const float corr = __expf(m_run - mnew); float p[KG]; float psum = 0.f;
#pragma unroll
                for (int j = 0; j < KG; ++j) { p[j] = (s[j] > -1e29f) ? __expf(s[j] - mnew) : 0.f; psum += p[j]; }
                l_run = l_run * corr + psum; m_run = mnew;
#pragma unroll
                for (int i = 0; i < DVH; ++i) o[i] *= corr;
#pragma unroll
                for (int j = 0; j < KG; ++j) { const LAS v4u* vr = (const LAS v4u*)(Vs + (k4 + j) * DV + half * DVH);
#pragma unroll
                    for (int i = 0; i < DVH / 8; ++i) { const v4u w = vr[i]; o[8 * i] += p[j] * bflo(w.x); o[8 * i + 1] += p[j] * bfhi(w.x); o[8 * i + 2] += p[j] * bflo(w.y); o[8 * i + 3] += p[j] * bfhi(w.y);
                        o[8 * i + 4] += p[j] * bflo(w.z); o[8 * i + 5] += p[j] * bfhi(w.z); o[8 * i + 6] += p[j] * bflo(w.w); o[8 * i + 7] += p[j] * bfhi(w.w); } }
            }
        }
        const float inv = 1.f / l_run; v4u* op = (v4u*)(Op + row * ldo + h * ohp + half * DVH);
#pragma unroll
        for (int i = 0; i < DVH / 8; ++i) { v4u w; w.x = pk2(o[8 * i] * inv, o[8 * i + 1] * inv); w.y = pk2(o[8 * i + 2] * inv, o[8 * i + 3] * inv); w.z = pk2(o[8 * i + 4] * inv, o[8 * i + 5] * inv); w.w = pk2(o[8 * i + 6] * inv, o[8 * i + 7] * inv); op[i] = w; }
    }
    __syncthreads();
}

namespace mla_attn {
constexpr int B = NB, H = 4, HKV = 4, SQ = SEQ, SKV = SEQ, D = 128, LD = 512, OLD = 1024, NQK = 6;
constexpr float THR = 8.f; constexpr bool WSKIP = false;
typedef unsigned short TIN_; typedef unsigned short TOUT_;
constexpr float SCALE = 0.10206207261596575f;
constexpr int NW = 8, QBLK = 32, KVBLK = 64, QB = NW * QBLK;
constexpr int SHM_V = KVBLK * D * 2, SHM_K = KVBLK * D * 2;
constexpr int LDS_BYTES = 2 * SHM_V + 2 * SHM_K + NW * 64 * 4;
static_assert(D == 128 && SQ % QB == 0 && SKV % KVBLK == 0, "geometry");

typedef short bf16x8 __attribute__((ext_vector_type(8)));
typedef short s16x4 __attribute__((ext_vector_type(4)));
typedef float f32x16 __attribute__((ext_vector_type(16)));
typedef unsigned u32x4 __attribute__((ext_vector_type(4)));
template <class A, class Bt> struct same_t { static constexpr bool v = false; };
template <class A> struct same_t<A, A> { static constexpr bool v = true; };

#define KSWZ(row, colB) ((row) * 256 + ((colB) ^ (((row) & 7) << 4)))
#define SBAR() __builtin_amdgcn_sched_barrier(0)
__device__ __forceinline__ int v_st(int k, int c) { const int kk = (k & ~0xC) | ((k & 4) << 1) | ((k & 8) >> 1); return ((kk >> 3) * 4 + (c >> 5)) * 512 + ((kk & 7) * 32 + (c & 31)) * 2; }
__device__ __forceinline__ int v_rd_base(int lane) { return ((lane & 3) << 3) | (((lane >> 2) & 3) << 6) | (((lane >> 4) & 1) << 5) | (((lane >> 5) & 1) << 8); }
constexpr int v_rd_off(int d0, int ks, int half) { return d0 * 512 + ks * 4096 + half * 2048; }
__device__ __forceinline__ int crow(int r, int hi) { return (r & 3) + 8 * (r >> 2) + 4 * hi; }
__device__ __forceinline__ unsigned cvtpk(float lo, float hi) {
    unsigned r; asm volatile("v_cvt_pk_bf16_f32 %0, %1, %2" : "=v"(r) : "v"(lo), "v"(hi)); return r;
}
__device__ __forceinline__ bf16x8 pack8(f32x4 a, f32x4 b) {
    u32x4 w = {cvtpk(a[0], a[1]), cvtpk(a[2], a[3]), cvtpk(b[0], b[1]), cvtpk(b[2], b[3])};
    return *reinterpret_cast<bf16x8*>(&w);
}
template <class T> __device__ __forceinline__ bf16x8 load8(const T* p) {
    if constexpr (same_t<T, float>::v) { return pack8(*(const f32x4*)p, *(const f32x4*)(p + 4)); }
    else { return *reinterpret_cast<const bf16x8*>(p); }
}
__device__ __forceinline__ void mask_tile(f32x16& p0, f32x16& p1, int dq, unsigned W) {
    const float NEG = -__builtin_inff();
#pragma unroll
    for (int r = 0; r < 16; ++r) {
        const int c = (r & 3) + 8 * (r >> 2);
        if ((unsigned)(dq - c) >= W) p0[r] = NEG;
        if ((unsigned)(dq - c - 32) >= W) p1[r] = NEG;
    }
}
__device__ __forceinline__ void partialSM(f32x16& p0, f32x16& p1, float& m_reg, float& mn, float& alpha) {
    float pmax = p0[0]; for (int r = 1; r < 16; ++r) pmax = fmaxf(pmax, p0[r]); for (int r = 0; r < 16; ++r) pmax = fmaxf(pmax, p1[r]);
    { auto rr = __builtin_amdgcn_permlane32_swap(__float_as_uint(pmax), __float_as_uint(pmax), false, false);
      pmax = fmaxf(__uint_as_float(rr[0]), __uint_as_float(rr[1])); }
    constexpr float C2 = 1.4426950408889634f * SCALE;
    if (__builtin_expect(__all((pmax - m_reg) * SCALE <= THR), 1)) { mn = m_reg; alpha = 1.f; }
    else { mn = fmaxf(m_reg, pmax); alpha = __builtin_amdgcn_exp2f((m_reg - mn) * C2); m_reg = mn; }
    const float mnL = -mn * C2;
    for (int r = 0; r < 16; ++r) p0[r] = fmaf(p0[r], C2, mnL); for (int r = 0; r < 16; ++r) p1[r] = fmaf(p1[r], C2, mnL);
    for (int r = 0; r < 16; ++r) p0[r] = __builtin_amdgcn_exp2f(p0[r]);
}
__device__ __forceinline__ void finishSM(f32x16& p0, f32x16& p1, float alpha, float& l_reg, bf16x8& pa0, bf16x8& pa1, bf16x8& pa2, bf16x8& pa3) {
    for (int r = 0; r < 16; ++r) p1[r] = __builtin_amdgcn_exp2f(p1[r]);
    float ps = 0; for (int r = 0; r < 16; ++r) ps += p0[r]; for (int r = 0; r < 16; ++r) ps += p1[r];
    { auto rr = __builtin_amdgcn_permlane32_swap(__float_as_uint(ps), __float_as_uint(ps), false, false);
      ps = __uint_as_float(rr[0]) + __uint_as_float(rr[1]); }
    l_reg = l_reg * alpha + ps;
#define PK4(P, B_, OUT) do { unsigned a0 = cvtpk(P[B_+0], P[B_+1]), a1 = cvtpk(P[B_+2], P[B_+3]);                          \
        unsigned b0 = cvtpk(P[B_+4], P[B_+5]), b1 = cvtpk(P[B_+6], P[B_+7]);                                             \
        auto r0 = __builtin_amdgcn_permlane32_swap(a0, b0, false, false); auto r1 = __builtin_amdgcn_permlane32_swap(a1, b1, false, false); \
        u32x4 w = {r0[0], r1[0], r0[1], r1[1]}; OUT = *reinterpret_cast<bf16x8*>(&w); } while (0)
    PK4(p0, 0, pa0); PK4(p0, 8, pa1); PK4(p1, 0, pa2); PK4(p1, 8, pa3);
#undef PK4
}
template <int KB, bool SK>
__device__ __forceinline__ void qkt(f32x16& p0, f32x16& p1, const char* K_lds, int r32, int hi, const bf16x8* qr, bool act) {
    if (SK && !act) { const float NEG = -__builtin_inff();
#pragma unroll
        for (int r = 0; r < 16; ++r) { p0[r] = NEG; p1[r] = NEG; } return; }
    p0 = f32x16{}; p1 = f32x16{};
    const char* kb[4];
#pragma unroll
    for (int dd = 0; dd < 4; ++dd) kb[dd] = K_lds + KB * SHM_K + KSWZ(r32, (dd * 16 + hi * 8) * 2);
#pragma unroll
    for (int d0 = 0; d0 < NQK; ++d0) { const char* a = kb[d0 & 3] + (d0 >> 2) * 128;
        bf16x8 b0 = *reinterpret_cast<const bf16x8*>(a);
        bf16x8 b1 = *reinterpret_cast<const bf16x8*>(a + 32 * 256);
        p0 = __builtin_amdgcn_mfma_f32_32x32x16_bf16(b0, qr[d0], p0, 0, 0, 0);
        p1 = __builtin_amdgcn_mfma_f32_32x32x16_bf16(b1, qr[d0], p1, 0, 0, 0); }
}
template <int VB, bool SK>
__device__ __forceinline__ void pv_tile(f32x16* o, int vb0, bf16x8 pa0, bf16x8 pa1, bf16x8 pa2, bf16x8 pa3, bool act) {
    if (SK && !act) return;
#define TRRD(dst, off) asm volatile("ds_read_b64_tr_b16 %0, %1 offset:%2" : "=&v"(dst) : "v"(vb0), "i"(off) : "memory")
#define PV_D0(d0) do { s16x4 l0, l1, l2, l3, h0, h1, h2, h3; constexpr int b_ = VB * SHM_V + v_rd_off(d0, 0, 0);     \
        TRRD(l0, b_); TRRD(h0, b_ + 2048); TRRD(l1, b_ + 4096); TRRD(h1, b_ + 6144); TRRD(l2, b_ + 8192); TRRD(h2, b_ + 10240); TRRD(l3, b_ + 12288); TRRD(h3, b_ + 14336); \
        asm volatile("s_waitcnt lgkmcnt(0)" ::: "memory"); SBAR();                 \
        o[d0] = __builtin_amdgcn_mfma_f32_32x32x16_bf16(pa0, (bf16x8){l0[0], l0[1], l0[2], l0[3], h0[0], h0[1], h0[2], h0[3]}, o[d0], 0, 0, 0);   \
        o[d0] = __builtin_amdgcn_mfma_f32_32x32x16_bf16(pa1, (bf16x8){l1[0], l1[1], l1[2], l1[3], h1[0], h1[1], h1[2], h1[3]}, o[d0], 0, 0, 0);   \
        o[d0] = __builtin_amdgcn_mfma_f32_32x32x16_bf16(pa2, (bf16x8){l2[0], l2[1], l2[2], l2[3], h2[0], h2[1], h2[2], h2[3]}, o[d0], 0, 0, 0);   \
        o[d0] = __builtin_amdgcn_mfma_f32_32x32x16_bf16(pa3, (bf16x8){l3[0], l3[1], l3[2], l3[3], h3[0], h3[1], h3[2], h3[3]}, o[d0], 0, 0, 0); } while (0)
    PV_D0(0); PV_D0(1); PV_D0(2); PV_D0(3);
#undef PV_D0
#undef TRRD
}

template <class TIn, class TOut> struct BlockRef { const TIn* Q; const TIn* K; const TIn* V; TOut* O; int P0; };
template <class TIn> struct Seam {
    bf16x8 qr[8];
    bf16x8 st_v0, st_v1, st_k0, st_k1; f32x4 sf0, sf1, sf2, sf3;
    f32x4 tq[16];
};
__device__ __forceinline__ int swa_jlo(int P0, int W) { const int lowk = P0 - W + 1; return lowk > 0 ? lowk / KVBLK : 0; }
#define ROW(p, k0, rr) ((p) + (size_t)((k0) + (rr)) * LD + sc)
#define VMW() asm volatile("s_waitcnt vmcnt(0)" ::: "memory")
#define VMWN(n) asm volatile("s_waitcnt vmcnt(%0)" :: "i"(n) : "memory")
#define SLOAD_H(Kp, Vp, k0) do { S.st_v0 = load8<TIn>(ROW(Vp, k0, sr)); S.st_v1 = load8<TIn>(ROW(Vp, k0, 32 + sr));              \
                         S.st_k0 = load8<TIn>(ROW(Kp, k0, sr)); S.st_k1 = load8<TIn>(ROW(Kp, k0, 32 + sr)); } while (0)
#define SWRITE_HK(bf) do { *(bf16x8*)(K_lds + (bf) * SHM_K + kws) = S.st_k0; *(bf16x8*)(K_lds + (bf) * SHM_K + kws + 32 * 256) = S.st_k1; } while (0)
#define SWRITE_HV(bf) do { *(bf16x8*)(V_lds + (bf) * SHM_V + vst0) = S.st_v0; *(bf16x8*)(V_lds + (bf) * SHM_V + vst1) = S.st_v1; } while (0)
#define SWRITE_H(bf) do { SWRITE_HV(bf); SWRITE_HK(bf); } while (0)
#define SLOAD_F(p, k0) do { S.sf0 = *(const f32x4*)ROW(p, k0, sr); S.sf1 = *(const f32x4*)(ROW(p, k0, sr) + 4);                \
                            S.sf2 = *(const f32x4*)ROW(p, k0, 32 + sr); S.sf3 = *(const f32x4*)(ROW(p, k0, 32 + sr) + 4); } while (0)
#define SWRITE_KF(bf) do { *(bf16x8*)(K_lds + (bf) * SHM_K + kws) = pack8(S.sf0, S.sf1); *(bf16x8*)(K_lds + (bf) * SHM_K + kws + 32 * 256) = pack8(S.sf2, S.sf3); } while (0)
#define SWRITE_VF(bf) do { *(bf16x8*)(V_lds + (bf) * SHM_V + vst0) = pack8(S.sf0, S.sf1); *(bf16x8*)(V_lds + (bf) * SHM_V + vst1) = pack8(S.sf2, S.sf3); } while (0)
template <class TIn, class TOut>
__device__ __forceinline__ void causal_swa_prime(const BlockRef<TIn, TOut>& cur, int W, char* lds, Seam<TIn>& S) {
    constexpr bool F32 = same_t<TIn, float>::v;
    const int tid = tid_fresh(), wid = __builtin_amdgcn_readfirstlane(tid >> 6), lane = tid & 63, r32 = lane & 31, hi = lane >> 5;
    const int sr = tid >> 4, sc = (tid & 15) * 8, kws = KSWZ(sr, sc * 2); char* K_lds = lds + 2 * SHM_V;
    const int kb0 = swa_jlo(cur.P0, W) * KVBLK;
    for (int d0 = 0; d0 < NQK; ++d0) S.qr[d0] = load8<TIn>(cur.Q + (size_t)(wid * QBLK + r32) * LD + d0 * 16 + hi * 8);
    if constexpr (F32) { SLOAD_F((const float*)cur.K, kb0); VMW(); SWRITE_KF(0); SBAR(); SLOAD_F((const float*)cur.V, kb0); }
    else { SLOAD_H(cur.K, cur.V, kb0); VMW(); SWRITE_HK(0); }
    __syncthreads();
}
template <class TIn, class TOut>
__device__ __forceinline__ void causal_swa_block(const BlockRef<TIn, TOut>& cur, const BlockRef<TIn, TOut>& nxt, int skv, int W, char* lds, Seam<TIn>& S) {
    constexpr bool F32 = same_t<TIn, float>::v;
    const int tid = tid_fresh(), wid = __builtin_amdgcn_readfirstlane(tid >> 6), lane = tid & 63, r32 = lane & 31, hi = lane >> 5;
    const int j_lo = swa_jlo(cur.P0, W);
    int j_hi = (cur.P0 + QB - 1) / KVBLK + 1; if (j_hi > skv / KVBLK) j_hi = skv / KVBLK;
    const int NT = j_hi - j_lo;
    const int kbn = swa_jlo(nxt.P0, W) * KVBLK;
    const int qlo = cur.P0 + wid * QBLK, qm = qlo + r32 - 4 * hi;
    char* V_lds = lds; char* K_lds = lds + 2 * SHM_V;
    float* ws = (float*)(lds + 2 * SHM_V + 2 * SHM_K) + wid * 64; float* li_l = ws, * al_l = ws + 32;
    float m_reg = -1e30f, l_reg = 0; f32x16 o[4] = {};
    const int sr = tid >> 4, sc = (tid & 15) * 8, vst0 = v_st(sr, sc), vst1 = v_st(32 + sr, sc), kws = KSWZ(sr, sc * 2);
    const int vb0 = (int)(uintptr_t)V_lds + v_rd_base(lane);
    const TIn* Kh = cur.K; const TIn* Vh = cur.V;
#define RESC(a) do { if (__any((a) < 1.f)) { if (hi == 0) al_l[r32] = (a); asm volatile("s_waitcnt lgkmcnt(0)" ::: "memory");              \
                     for (int d_ = 0; d_ < 4; ++d_) for (int r = 0; r < 16; ++r) o[d_][r] *= al_l[crow(r, hi)]; } } while (0)
#define KBASE(t) ((j_lo + (t)) * KVBLK)
#define ACT(t) (KBASE(t) <= qlo + QBLK - 1 && KBASE(t) + KVBLK - 1 >= qlo - W + 1)
#define MASKT(P0_, P1_, t) do { const int kb_ = KBASE(t); if ((!SK || ACT(t)) && (kb_ + KVBLK - 1 > qlo || kb_ <= qlo + QBLK - 1 - W)) mask_tile(P0_, P1_, qm - kb_, (unsigned)W); } while (0)
    constexpr int NQL = F32 ? 16 : NQK;
    constexpr bool SK = WSKIP && !F32;
#define SEAM_K0() do { VMWN(NQL); if constexpr (F32) { SWRITE_KF(0); SBAR(); SLOAD_F((const float*)nxt.V, kbn); } else { SWRITE_HK(0); } SBAR(); } while (0)
    f32x16 pA0, pA1, pB0, pB1; float mnA, mnB, alA, alB; bf16x8 pa0, pa1, pa2, pa3;
    if constexpr (F32) { VMW(); SWRITE_VF(0); SBAR(); } else { SWRITE_HV(0); SBAR(); }
    if (NT > 1) { if constexpr (F32) SLOAD_F((const float*)Kh, KBASE(1)); else SLOAD_H(Kh, Vh, KBASE(1)); }
    SBAR(); qkt<0, SK>(pA0, pA1, K_lds, r32, hi, S.qr, ACT(0));
    if constexpr (F32) { if (NT > 1) { VMW(); SWRITE_KF(1); SBAR(); SLOAD_F((const float*)Vh, KBASE(1)); } }
    MASKT(pA0, pA1, 0); partialSM(pA0, pA1, m_reg, mnA, alA);
    if (NT > 1) { VMW(); if constexpr (F32) { SWRITE_VF(1); SBAR(); if (NT > 2) SLOAD_F((const float*)Kh, KBASE(2)); } else SWRITE_H(1); }
    __syncthreads();
#define HALF_STEP(PX0, PX1, mnX, alX, PY0, PY1, alY, t, KB, VB, SB) do {                                                      \
        SBAR(); qkt<KB, SK>(PX0, PX1, K_lds, r32, hi, S.qr, ACT(t));                                             \
        finishSM(PY0, PY1, alY, l_reg, pa0, pa1, pa2, pa3); SBAR();                                                           \
        if ((t) + 1 < NT) { if constexpr (F32) { VMW(); SWRITE_KF(SB); SBAR(); SLOAD_F((const float*)Vh, KBASE((t) + 1)); }  \
                            else { SLOAD_H(Kh, Vh, KBASE((t) + 1)); } SBAR(); }                                               \
        pv_tile<VB, SK>(o, vb0, pa0, pa1, pa2, pa3, ACT((t) - 1)); MASKT(PX0, PX1, (t)); partialSM(PX0, PX1, m_reg, mnX, alX);                                        \
        __syncthreads();                                                                                                      \
        if ((t) + 1 < NT) { VMW(); if constexpr (F32) { SWRITE_VF(SB); SBAR(); if ((t) + 2 < NT) SLOAD_F((const float*)Kh, KBASE((t) + 2)); } \
                            else { SWRITE_H(SB); } }                                                                          \
        RESC(alX); __syncthreads(); } while (0)
    for (int t = 1; t + 1 < NT; t += 2) {
        HALF_STEP(pB0, pB1, mnB, alB, pA0, pA1, alA, t, 1, 0, 0);
        HALF_STEP(pA0, pA1, mnA, alA, pB0, pB1, alB, t + 1, 0, 1, 1);
    }
    const bool even = (NT & 1) == 0;
    if (even) { SBAR(); qkt<1, SK>(pB0, pB1, K_lds, r32, hi, S.qr, ACT(NT - 1)); SBAR(); }
#define QROW(e) (nxt.Q + (size_t)(wid * QBLK + r32) * LD + ((e) >> 1) * 16 + hi * 8 + ((e) & 1) * 4)
    if constexpr (F32) { SLOAD_F((const float*)nxt.K, kbn); SBAR();
#pragma unroll
        for (int e = 0; e < 8; ++e) S.tq[e] = *(const f32x4*)QROW(e); }
    else { SLOAD_H(nxt.K, nxt.V, kbn); SBAR();
#pragma unroll
        for (int d0 = 0; d0 < NQK; ++d0) S.qr[d0] = load8<TIn>(nxt.Q + (size_t)(wid * QBLK + r32) * LD + d0 * 16 + hi * 8); }
    SBAR();
    finishSM(pA0, pA1, alA, l_reg, pa0, pa1, pa2, pa3); SBAR();
    if constexpr (F32) {
#pragma unroll
        for (int e = 8; e < 16; ++e) S.tq[e] = *(const f32x4*)QROW(e); SBAR(); }
#undef QROW
    pv_tile<0, SK>(o, vb0, pa0, pa1, pa2, pa3, ACT(even ? NT - 2 : NT - 1));
    if (even) { MASKT(pB0, pB1, NT - 1); partialSM(pB0, pB1, m_reg, mnB, alB); __syncthreads(); RESC(alB);
        finishSM(pB0, pB1, alB, l_reg, pa0, pa1, pa2, pa3); SBAR(); pv_tile<1, SK>(o, vb0, pa0, pa1, pa2, pa3, ACT(NT - 1)); }
    SBAR(); SEAM_K0();
    if (hi == 0) li_l[r32] = l_reg; asm volatile("s_waitcnt lgkmcnt(0)" ::: "memory");
    float rli[16];
#pragma unroll
    for (int r = 0; r < 16; ++r) rli[r] = __builtin_amdgcn_rcpf(li_l[crow(r, hi)]);
    TOut* Ow = cur.O + (size_t)(wid * QBLK) * OLD;
#pragma unroll
    for (int r = 0; r < 16; ++r) { const int orow = crow(r, hi);
#pragma unroll
        for (int d0 = 0; d0 < 4; ++d0) { const float v = o[d0][r] * rli[r];
            if constexpr (same_t<TOut, float>::v) { Ow[(size_t)orow * OLD + d0 * 32 + r32] = v; }
            else { const float vn = __shfl_xor(v, 1);
                   if ((r32 & 1) == 0) *(unsigned*)(Ow + (size_t)orow * OLD + d0 * 32 + r32) = cvtpk(v, vn); } } }
    if constexpr (F32) {
#pragma unroll
        for (int d0 = 0; d0 < 8; ++d0) S.qr[d0] = pack8(S.tq[2 * d0], S.tq[2 * d0 + 1]); }
    __syncthreads();
#undef RESC
#undef KBASE
#undef ACT
#undef MASKT
#undef SEAM_K0
#undef HALF_STEP
}
#undef ROW
#undef VMW
#undef VMWN
#undef SLOAD_H
#undef SWRITE_HK
#undef SWRITE_HV
#undef SWRITE_H
#undef SLOAD_F
#undef SWRITE_KF
#undef SWRITE_VF

typedef BlockRef<bf16, bf16> BR;
__device__ __forceinline__ BR mk_ref(int L, int pass, const bf16* Qm, const bf16* Km, const bf16* Vm, bf16* O) {
    const int xcd = L & 7, k = L >> 3, bh = xcd * 2 + (k >> 4), x = k & 15, qb = pass ? 31 - x : x, b = bh >> 2, h = bh & 3;
    BR r; r.Q = Qm + ((size_t)b * SEQ + qb * QB) * LD + h * D; r.K = Km + (size_t)b * SEQ * LD + h * D; r.V = Vm + (size_t)b * SEQ * LD + h * D;
    r.O = O + ((size_t)b * SEQ + qb * QB) * OLD + h * D; r.P0 = qb * QB; return r;
}
__device__ __forceinline__ void phase(char* lds, const bf16* Qm, const bf16* Km, const bf16* Vm, bf16* O, int G, int c) {
    constexpr int TOTAL = NB * H * 16;
    int L = c; if (L >= TOTAL) return; int pass = 0;
    BR cur = mk_ref(L, 0, Qm, Km, Vm, O);
    Seam<bf16> S;
    causal_swa_prime<bf16, bf16>(cur, SEQ, lds, S);
    for (;;) {
        const bool more_pass = pass == 0, more_item = L + G < TOTAL, last = !more_pass && !more_item;
        int passn = pass + 1, Ln = L;
        if (!more_pass) { passn = 0; Ln = more_item ? L + G : L; }
        const BR nxt = last ? cur : mk_ref(Ln, passn, Qm, Km, Vm, O);
        causal_swa_block<bf16, bf16>(cur, nxt, SEQ, SEQ, lds, S);
        if (last) break;
        cur = nxt; pass = passn; L = Ln;
    }
}
}

namespace moba_attn {
using mla_attn::bf16x8; using mla_attn::s16x4; using mla_attn::f32x16; using mla_attn::u32x4; using mla_attn::crow; using mla_attn::cvtpk; using mla_attn::v_rd_base;
constexpr int D = 64, LD = U0W, OLD = 1024, NH = 8;
constexpr float SCALE = 0.125f, THR = 8.f;
constexpr int NW = 8, QBLK = 32, KVBLK = 64, QB = NW * QBLK;
constexpr int SHM_V = KVBLK * D * 2, SHM_K = KVBLK * D * 2;
constexpr int LDS_BYTES = 2 * SHM_V + 2 * SHM_K + NW * 64 * 4;
#define KSWZ64(row, colB) ((row) * 128 + ((colB) ^ (((row) & 7) << 4)))
#define SBAR() __builtin_amdgcn_sched_barrier(0)
__device__ __forceinline__ int v_st(int k, int c) { const int kk = (k & ~0xC) | ((k & 4) << 1) | ((k & 8) >> 1); return ((kk >> 3) * 2 + (c >> 5)) * 512 + ((kk & 7) * 32 + (c & 31)) * 2; }
__device__ __forceinline__ void mask_causal(f32x16& p0, f32x16& p1, int dq) {
    const float NEG = -__builtin_inff();
#pragma unroll
    for (int r = 0; r < 16; ++r) { const int c = (r & 3) + 8 * (r >> 2); if (dq - c < 0) p0[r] = NEG; if (dq - c - 32 < 0) p1[r] = NEG; }
}
__device__ __forceinline__ void mask_row(f32x16& p0, f32x16& p1, bool keep) {
    const float NEG = -__builtin_inff();
#pragma unroll
    for (int r = 0; r < 16; ++r) { p0[r] = keep ? p0[r] : NEG; p1[r] = keep ? p1[r] : NEG; }
}
__device__ __forceinline__ void alibi(f32x16& p0, f32x16& p1, float sb, float base) {
    const float t0 = sb * base;
#pragma unroll
    for (int r = 0; r < 16; ++r) { const float c = (float)((r & 3) + 8 * (r >> 2)); p0[r] += fmaf(sb, c, t0); p1[r] += fmaf(sb, c + 32.f, t0); }
}
__device__ __forceinline__ void partialSM(f32x16& p0, f32x16& p1, float& m_reg, float& mn, float& alpha) {
    float pmax = p0[0]; for (int r = 1; r < 16; ++r) pmax = fmaxf(pmax, p0[r]); for (int r = 0; r < 16; ++r) pmax = fmaxf(pmax, p1[r]);
    { auto rr = __builtin_amdgcn_permlane32_swap(__float_as_uint(pmax), __float_as_uint(pmax), false, false);
      pmax = fmaxf(__uint_as_float(rr[0]), __uint_as_float(rr[1])); }
    constexpr float C2 = 1.4426950408889634f * SCALE;
    if (__builtin_expect(__all((pmax - m_reg) * SCALE <= THR), 1)) { mn = m_reg; alpha = 1.f; }
    else { mn = fmaxf(m_reg, pmax); alpha = __builtin_amdgcn_exp2f((m_reg - mn) * C2); m_reg = mn; }
    const float mnL = -mn * C2;
    for (int r = 0; r < 16; ++r) p0[r] = fmaf(p0[r], C2, mnL); for (int r = 0; r < 16; ++r) p1[r] = fmaf(p1[r], C2, mnL);
    for (int r = 0; r < 16; ++r) p0[r] = __builtin_amdgcn_exp2f(p0[r]);
}
__device__ __forceinline__ void finishSM(f32x16& p0, f32x16& p1, float alpha, float& l_reg, bf16x8& pa0, bf16x8& pa1, bf16x8& pa2, bf16x8& pa3) {
    for (int r = 0; r < 16; ++r) p1[r] = __builtin_amdgcn_exp2f(p1[r]);
    float ps = 0; for (int r = 0; r < 16; ++r) ps += p0[r]; for (int r = 0; r < 16; ++r) ps += p1[r];
    { auto rr = __builtin_amdgcn_permlane32_swap(__float_as_uint(ps), __float_as_uint(ps), false, false);
      ps = __uint_as_float(rr[0]) + __uint_as_float(rr[1]); }
    l_reg = l_reg * alpha + ps;
#define PK4(P, B_, OUT) do { unsigned a0 = cvtpk(P[B_+0], P[B_+1]), a1 = cvtpk(P[B_+2], P[B_+3]);                          \
        unsigned b0 = cvtpk(P[B_+4], P[B_+5]), b1 = cvtpk(P[B_+6], P[B_+7]);                                             \
        auto r0 = __builtin_amdgcn_permlane32_swap(a0, b0, false, false); auto r1 = __builtin_amdgcn_permlane32_swap(a1, b1, false, false); \
        u32x4 w = {r0[0], r1[0], r0[1], r1[1]}; OUT = *reinterpret_cast<bf16x8*>(&w); } while (0)
    PK4(p0, 0, pa0); PK4(p0, 8, pa1); PK4(p1, 0, pa2); PK4(p1, 8, pa3);
#undef PK4
}
template <int KB>
__device__ __forceinline__ void qkt(f32x16& p0, f32x16& p1, const char* K_lds, int r32, int hi, const bf16x8* qr) {
    p0 = f32x16{}; p1 = f32x16{};
#pragma unroll
    for (int d0 = 0; d0 < 4; ++d0) { const char* a = K_lds + KB * SHM_K + KSWZ64(r32, (d0 * 16 + hi * 8) * 2);
        bf16x8 b0 = *reinterpret_cast<const bf16x8*>(a);
        bf16x8 b1 = *reinterpret_cast<const bf16x8*>(a + 32 * 128);
        p0 = __builtin_amdgcn_mfma_f32_32x32x16_bf16(b0, qr[d0], p0, 0, 0, 0);
        p1 = __builtin_amdgcn_mfma_f32_32x32x16_bf16(b1, qr[d0], p1, 0, 0, 0); }
}
template <int VB>
__device__ __forceinline__ void pv_tile(f32x16* o, int vb0, bf16x8 pa0, bf16x8 pa1, bf16x8 pa2, bf16x8 pa3) {
#define TRRD(dst, off) asm volatile("ds_read_b64_tr_b16 %0, %1 offset:%2" : "=&v"(dst) : "v"(vb0), "i"(off) : "memory")
#define PV_D0(d0) do { s16x4 l0, l1, l2, l3, h0, h1, h2, h3; constexpr int b_ = VB * SHM_V + (d0) * 512;     \
        TRRD(l0, b_); TRRD(h0, b_ + 1024); TRRD(l1, b_ + 2048); TRRD(h1, b_ + 3072); TRRD(l2, b_ + 4096); TRRD(h2, b_ + 5120); TRRD(l3, b_ + 6144); TRRD(h3, b_ + 7168); \
        asm volatile("s_waitcnt lgkmcnt(0)" ::: "memory"); SBAR();   \
        o[d0] = __builtin_amdgcn_mfma_f32_32x32x16_bf16(pa0, (bf16x8){l0[0], l0[1], l0[2], l0[3], h0[0], h0[1], h0[2], h0[3]}, o[d0], 0, 0, 0);   \
        o[d0] = __builtin_amdgcn_mfma_f32_32x32x16_bf16(pa1, (bf16x8){l1[0], l1[1], l1[2], l1[3], h1[0], h1[1], h1[2], h1[3]}, o[d0], 0, 0, 0);   \
        o[d0] = __builtin_amdgcn_mfma_f32_32x32x16_bf16(pa2, (bf16x8){l2[0], l2[1], l2[2], l2[3], h2[0], h2[1], h2[2], h2[3]}, o[d0], 0, 0, 0);   \
        o[d0] = __builtin_amdgcn_mfma_f32_32x32x16_bf16(pa3, (bf16x8){l3[0], l3[1], l3[2], l3[3], h3[0], h3[1], h3[2], h3[3]}, o[d0], 0, 0, 0); } while (0)
    PV_D0(0); PV_D0(1);
#undef PV_D0
#undef TRRD
}
struct BlockRef { const bf16* Q; const bf16* K; const bf16* V; bf16* O; int P0, bh; };
struct Seam { bf16x8 qr[4]; bf16x8 st_v0, st_k0; };
#define ROW(p, k0) ((p) + (size_t)((k0) + sr) * LD + sc)
#define VMW() asm volatile("s_waitcnt vmcnt(0)" ::: "memory")
#define VMWN(n) asm volatile("s_waitcnt vmcnt(%0)" :: "i"(n) : "memory")
#define SLOAD(Kp, Vp, k0) do { S.st_v0 = *reinterpret_cast<const bf16x8*>(ROW(Vp, k0)); S.st_k0 = *reinterpret_cast<const bf16x8*>(ROW(Kp, k0)); } while (0)
#define SWRITE_K(bf) do { *(bf16x8*)(K_lds + (bf) * SHM_K + kws) = S.st_k0; } while (0)
#define SWRITE_V(bf) do { *(bf16x8*)(V_lds + (bf) * SHM_V + vst0) = S.st_v0; } while (0)
__device__ __forceinline__ void prime(const BlockRef& cur, char* lds, Seam& S) {
    const int tid = tid_fresh(), wid = __builtin_amdgcn_readfirstlane(tid >> 6), lane = tid & 63, r32 = lane & 31, hi = lane >> 5;
    const int sr = tid >> 3, sc = (tid & 7) * 8, kws = KSWZ64(sr, sc * 2); char* K_lds = lds + 2 * SHM_V;
#pragma unroll
    for (int d0 = 0; d0 < 4; ++d0) S.qr[d0] = *reinterpret_cast<const bf16x8*>(cur.Q + (size_t)(wid * QBLK + r32) * LD + d0 * 16 + hi * 8);
    SLOAD(cur.K, cur.V, 0); VMW(); SWRITE_K(0);
    __syncthreads();
}
__device__ __forceinline__ void block(const BlockRef& cur, const BlockRef& nxt, const float* kmean, char* lds, Seam& S) {
    const int tid = tid_fresh(), wid = __builtin_amdgcn_readfirstlane(tid >> 6), lane = tid & 63, r32 = lane & 31, hi = lane >> 5;
    const int qb = cur.P0 / QB, NT = 4 * (qb + 1);
    const int qlo = cur.P0 + wid * QBLK, qm = qlo + r32 - 4 * hi;
    char* V_lds = lds; char* K_lds = lds + 2 * SHM_V;
    float* ws = (float*)(lds + 2 * SHM_V + 2 * SHM_K) + wid * 64; float* li_l = ws, * al_l = ws + 32;
    const int sr = tid >> 3, sc = (tid & 7) * 8, vst0 = v_st(sr, sc), kws = KSWZ64(sr, sc * 2);
    const int vb0 = (int)(uintptr_t)V_lds + v_rd_base(lane);
    const bf16* Kh = cur.K; const bf16* Vh = cur.V;
    const float sb = exp2f(-(float)((cur.bh & (NH - 1)) + 1)) * (1.f / SCALE);
    unsigned sel = 0u;
    { float qf[32];
#pragma unroll
      for (int d0 = 0; d0 < 4; ++d0)
#pragma unroll
          for (int j = 0; j < 8; ++j) qf[8 * d0 + j] = __uint_as_float(((unsigned)(unsigned short)S.qr[d0][j]) << 16);
      float t0 = -3e38f, t1 = -3e38f, t2 = -3e38f; int i0 = -1, i1 = -1, i2 = -1;
#pragma unroll 1
      for (int n = 0; n < qb; ++n) { const float* km = kmean + ((size_t)cur.bh * 32 + n) * 64 + hi * 8; float g = 0.f;
#pragma unroll
          for (int d0 = 0; d0 < 4; ++d0) { const f32x4 k0 = *(const f32x4*)(km + d0 * 16), k1 = *(const f32x4*)(km + d0 * 16 + 4);
              g += qf[8 * d0] * k0[0] + qf[8 * d0 + 1] * k0[1] + qf[8 * d0 + 2] * k0[2] + qf[8 * d0 + 3] * k0[3] + qf[8 * d0 + 4] * k1[0] + qf[8 * d0 + 5] * k1[1] + qf[8 * d0 + 6] * k1[2] + qf[8 * d0 + 7] * k1[3]; }
          g += __shfl_xor(g, 32);
          if (g > t0) { t2 = t1; i2 = i1; t1 = t0; i1 = i0; t0 = g; i0 = n; } else if (g > t1) { t2 = t1; i2 = i1; t1 = g; i1 = n; } else if (g > t2) { t2 = g; i2 = n; } }
      if (i0 >= 0) sel |= 1u << i0; if (i1 >= 0) sel |= 1u << i1; if (i2 >= 0) sel |= 1u << i2; }
    float m_reg = -1e30f, l_reg = 0; f32x16 o[2] = {};
#define RESC(a) do { if (__any((a) < 1.f)) { if (hi == 0) al_l[r32] = (a); asm volatile("s_waitcnt lgkmcnt(0)" ::: "memory");              \
                     for (int d_ = 0; d_ < 2; ++d_) for (int r = 0; r < 16; ++r) o[d_][r] *= al_l[crow(r, hi)]; } } while (0)
#define KBASE(t) ((t) * KVBLK)
#define MASKT(P0_, P1_, t) do { const int kb_ = KBASE(t); alibi(P0_, P1_, sb, (float)(kb_ - cur.P0 + 4 * hi));                                  \
        if (kb_ < cur.P0) mask_row(P0_, P1_, ((sel >> (kb_ >> 8)) & 1u) != 0u); else if (kb_ + KVBLK - 1 > qlo) mask_causal(P0_, P1_, qm - kb_); } while (0)
#define SEAM_K0() do { VMWN(4); SWRITE_K(0); SBAR(); } while (0)
    f32x16 pA0, pA1, pB0, pB1; float mnA, mnB, alA, alB; bf16x8 pa0, pa1, pa2, pa3;
    SWRITE_V(0); SBAR();
    SLOAD(Kh, Vh, KBASE(1));
    SBAR(); qkt<0>(pA0, pA1, K_lds, r32, hi, S.qr);
    MASKT(pA0, pA1, 0); partialSM(pA0, pA1, m_reg, mnA, alA);
    VMW(); SWRITE_V(1); SWRITE_K(1);
    __syncthreads();
#define HALF_STEP(PX0, PX1, mnX, alX, PY0, PY1, alY, t, KB, VB, SB) do {                                                      \
        SBAR(); qkt<KB>(PX0, PX1, K_lds, r32, hi, S.qr);                                                                      \
        finishSM(PY0, PY1, alY, l_reg, pa0, pa1, pa2, pa3); SBAR();                                                           \
        if ((t) + 1 < NT) { SLOAD(Kh, Vh, KBASE((t) + 1)); SBAR(); }                                                          \
        pv_tile<VB>(o, vb0, pa0, pa1, pa2, pa3); MASKT(PX0, PX1, (t)); partialSM(PX0, PX1, m_reg, mnX, alX);                  \
        __syncthreads();                                                                                                      \
        if ((t) + 1 < NT) { VMW(); SWRITE_V(SB); SWRITE_K(SB); }                                                              \
        RESC(alX); __syncthreads(); } while (0)
#pragma unroll 1
    for (int t = 1; t + 1 < NT; t += 2) {
        HALF_STEP(pB0, pB1, mnB, alB, pA0, pA1, alA, t, 1, 0, 0);
        HALF_STEP(pA0, pA1, mnA, alA, pB0, pB1, alB, t + 1, 0, 1, 1);
    }
    SBAR(); qkt<1>(pB0, pB1, K_lds, r32, hi, S.qr); SBAR();
    SLOAD(nxt.K, nxt.V, 0); SBAR();
#pragma unroll
    for (int d0 = 0; d0 < 4; ++d0) S.qr[d0] = *reinterpret_cast<const bf16x8*>(nxt.Q + (size_t)(wid * QBLK + r32) * LD + d0 * 16 + hi * 8);
    SBAR();
    finishSM(pA0, pA1, alA, l_reg, pa0, pa1, pa2, pa3); SBAR();
    pv_tile<0>(o, vb0, pa0, pa1, pa2, pa3);
    MASKT(pB0, pB1, NT - 1); partialSM(pB0, pB1, m_reg, mnB, alB); __syncthreads(); RESC(alB);
    finishSM(pB0, pB1, alB, l_reg, pa0, pa1, pa2, pa3); SBAR(); pv_tile<1>(o, vb0, pa0, pa1, pa2, pa3);
    SBAR(); SEAM_K0();
    if (hi == 0) li_l[r32] = l_reg; asm volatile("s_waitcnt lgkmcnt(0)" ::: "memory");
    float rli[16];
#pragma unroll
    for (int r = 0; r < 16; ++r) rli[r] = __builtin_amdgcn_rcpf(li_l[crow(r, hi)]);
    bf16* Ow = cur.O + (size_t)(wid * QBLK) * OLD;
#pragma unroll
    for (int r = 0; r < 16; ++r) { const int orow = crow(r, hi);
#pragma unroll
        for (int d0 = 0; d0 < 2; ++d0) { const float v = o[d0][r] * rli[r]; const float vn = __shfl_xor(v, 1);
            if ((r32 & 1) == 0) *(unsigned*)(Ow + (size_t)orow * OLD + d0 * 32 + r32) = cvtpk(v, vn); } }
    __syncthreads();
#undef RESC
#undef KBASE
#undef MASKT
#undef SEAM_K0
#undef HALF_STEP
}
struct SRef { const bf16* K; const bf16* V; int qoff; int oidx; float mcorr; int own; float sb; };
__device__ __forceinline__ void sprime(const SRef& cur, const bf16* U0, char* lds, Seam& S) {
    const int tid = tid_fresh(), lane = tid & 63, hi = lane >> 5;
    const int sr = tid >> 3, sc = (tid & 7) * 8, kws = KSWZ64(sr, sc * 2); char* K_lds = lds + 2 * SHM_V;
#pragma unroll
    for (int d0 = 0; d0 < 4; ++d0) S.qr[d0] = *reinterpret_cast<const bf16x8*>(U0 + cur.qoff + d0 * 16 + hi * 8);
    SLOAD(cur.K, cur.V, 0); VMW(); SWRITE_K(0);
    __syncthreads();
}
__device__ __forceinline__ void sblock(const SRef& cur, const SRef& nxt, const bf16* U0, bf16* PO, float* PM, char* lds, Seam& S) {
    const int tid = tid_fresh(), wid = __builtin_amdgcn_readfirstlane(tid >> 6), lane = tid & 63, r32 = lane & 31, hi = lane >> 5;
    constexpr int NT = 4;
    const int qlo = wid * QBLK, qm = qlo + r32 - 4 * hi;
    char* V_lds = lds; char* K_lds = lds + 2 * SHM_V;
    float* ws = (float*)(lds + 2 * SHM_V + 2 * SHM_K) + wid * 64; float* li_l = ws, * al_l = ws + 32;
    const int sr = tid >> 3, sc = (tid & 7) * 8, vst0 = v_st(sr, sc), kws = KSWZ64(sr, sc * 2);
    const int vb0 = (int)(uintptr_t)V_lds + v_rd_base(lane);
    const bf16* Kh = cur.K; const bf16* Vh = cur.V; const float sb = cur.sb;
    float m_reg = -1e30f, l_reg = 0; f32x16 o[2] = {};
#define RESC(a) do { if (__any((a) < 1.f)) { if (hi == 0) al_l[r32] = (a); asm volatile("s_waitcnt lgkmcnt(0)" ::: "memory");              \
                     for (int d_ = 0; d_ < 2; ++d_) for (int r = 0; r < 16; ++r) o[d_][r] *= al_l[crow(r, hi)]; } } while (0)
#define KBASE(t) ((t) * KVBLK)
#define MASKT(P0_, P1_, t) do { const int kb_ = KBASE(t); alibi(P0_, P1_, sb, (float)(kb_ + 4 * hi));                                  \
        if (cur.own && kb_ + KVBLK - 1 > qlo) mask_causal(P0_, P1_, qm - kb_); } while (0)
#define SEAM_K0() do { VMWN(4); SWRITE_K(0); SBAR(); } while (0)
    f32x16 pA0, pA1, pB0, pB1; float mnA, mnB, alA, alB; bf16x8 pa0, pa1, pa2, pa3;
    SWRITE_V(0); SBAR();
    SLOAD(Kh, Vh, KBASE(1));
    SBAR(); qkt<0>(pA0, pA1, K_lds, r32, hi, S.qr);
    MASKT(pA0, pA1, 0); partialSM(pA0, pA1, m_reg, mnA, alA);
    VMW(); SWRITE_V(1); SWRITE_K(1);
    __syncthreads();
#define HALF_STEP(PX0, PX1, mnX, alX, PY0, PY1, alY, t, KB, VB, SB) do {                                                      \
        SBAR(); qkt<KB>(PX0, PX1, K_lds, r32, hi, S.qr);                                                                      \
        finishSM(PY0, PY1, alY, l_reg, pa0, pa1, pa2, pa3); SBAR();                                                           \
        if ((t) + 1 < NT) { SLOAD(Kh, Vh, KBASE((t) + 1)); SBAR(); }                                                          \
        pv_tile<VB>(o, vb0, pa0, pa1, pa2, pa3); MASKT(PX0, PX1, (t)); partialSM(PX0, PX1, m_reg, mnX, alX);                  \
        __syncthreads();                                                                                                      \
        if ((t) + 1 < NT) { VMW(); SWRITE_V(SB); SWRITE_K(SB); }                                                              \
        RESC(alX); __syncthreads(); } while (0)
    HALF_STEP(pB0, pB1, mnB, alB, pA0, pA1, alA, 1, 1, 0, 0);
    HALF_STEP(pA0, pA1, mnA, alA, pB0, pB1, alB, 2, 0, 1, 1);
    SBAR(); qkt<1>(pB0, pB1, K_lds, r32, hi, S.qr); SBAR();
    SLOAD(nxt.K, nxt.V, 0); SBAR();
#pragma unroll
    for (int d0 = 0; d0 < 4; ++d0) S.qr[d0] = *reinterpret_cast<const bf16x8*>(U0 + nxt.qoff + d0 * 16 + hi * 8);
    SBAR();
    finishSM(pA0, pA1, alA, l_reg, pa0, pa1, pa2, pa3); SBAR();
    pv_tile<0>(o, vb0, pa0, pa1, pa2, pa3);
    MASKT(pB0, pB1, NT - 1); partialSM(pB0, pB1, m_reg, mnB, alB); __syncthreads(); RESC(alB);
    finishSM(pB0, pB1, alB, l_reg, pa0, pa1, pa2, pa3); SBAR(); pv_tile<1>(o, vb0, pa0, pa1, pa2, pa3);
    SBAR(); SEAM_K0();
    if (hi == 0) { li_l[r32] = l_reg; ((int*)al_l)[r32] = cur.oidx;
        if (cur.oidx >= 0) { PM[2 * (size_t)cur.oidx] = m_reg * (1.4426950408889634f * SCALE) - cur.mcorr; PM[2 * (size_t)cur.oidx + 1] = l_reg; } }
    asm volatile("s_waitcnt lgkmcnt(0)" ::: "memory");
#pragma unroll
    for (int r = 0; r < 16; ++r) { const int rr = crow(r, hi); const float rl = __builtin_amdgcn_rcpf(li_l[rr]); const int oi = ((const int*)al_l)[rr];
#pragma unroll
        for (int d0 = 0; d0 < 2; ++d0) { const float v = o[d0][r] * rl; const float vn = __shfl_xor(v, 1);
            if ((r32 & 1) == 0 && oi >= 0) *(unsigned*)(PO + (size_t)oi * 64 + d0 * 32 + r32) = cvtpk(v, vn); } }
    __syncthreads();
#undef RESC
#undef KBASE
#undef MASKT
#undef SEAM_K0
#undef HALF_STEP
}
__device__ __forceinline__ SRef mk_sref(int v, const int* pex, const bf16* U0, const int* lists, const int* cnts, int lane, int wid) {
    int lo = 0, hi_ = 1024;
#pragma unroll 1
    while (hi_ - lo > 1) { const int mid = (lo + hi_) >> 1; if (pex[mid] <= v) lo = mid; else hi_ = mid; }
    const int g = lo, local = v - pex[g], bh = g >> 5, n = g & 31, b = bh >> 3, h = bh & 7, r32 = lane & 31;
    SRef r; r.K = U0 + ((size_t)b * SEQ + n * 256) * LD + 512 + h * D; r.V = U0 + ((size_t)b * SEQ + n * 256) * LD + 1024 + h * D;
    r.own = (local == 0) ? 1 : 0; const float slope = exp2f(-(float)(h + 1)); r.sb = slope * (1.f / SCALE);
    int tq, slot; bool valid = true;
    if (local == 0) { tq = n * 256 + wid * QBLK + r32; slot = 3; }
    else { int rem = (local - 1) * 256 + wid * QBLK + r32, jj = -1;
#pragma unroll 1
        for (int j = n + 1; j < 32; ++j) { const int cj = cnts[g * 32 + j]; if (jj < 0) { if (rem < cj) jj = j; else rem -= cj; } }
        valid = jj >= 0; const int e = lists[((size_t)g * 32 + (valid ? jj : 31)) * 256 + (valid ? rem : 0)]; tq = e & (SEQ - 1); slot = (e >> 16) & 3; }
    const int row = b * SEQ + tq;
    r.qoff = row * LD + h * D; r.oidx = valid ? (row * NH + h) * 4 + slot : -1; r.mcorr = slope * 1.4426950408889634f * (float)(tq - n * 256);
    return r;
}
__device__ __forceinline__ void sphase(char* lds, const bf16* U0, const int* lists, const int* cnts, bf16* PO, float* PM, int G, int c) {
    const int tid = tid_fresh(), lane = tid & 63, wid = __builtin_amdgcn_readfirstlane(tid >> 6);
    int* pex = (int*)(lds + LDS_BYTES);
    int* part = pex + 1056;
    __syncthreads();
    int* nit = part + 40;
    for (int g = tid; g < 1024; g += NTHR) { int s = 0; for (int j = (g & 31) + 1; j < 32; ++j) s += cnts[g * 32 + j]; nit[g] = 1 + ((s + 255) >> 8); }
    __syncthreads();
    if (tid < 32) { int s = 0; for (int i = 0; i < 32; ++i) s += nit[tid * 32 + i]; part[tid] = s; }
    __syncthreads();
    if (tid == 0) { int s = 0; for (int i = 0; i < 32; ++i) { const int t = part[i]; part[i] = s; s += t; } part[32] = s; }
    __syncthreads();
    for (int g = tid; g < 1024; g += NTHR) { int s = part[g >> 5]; for (int i = (g & ~31); i < g; ++i) s += nit[i]; pex[g] = s; }
    if (tid == 0) pex[1024] = part[32];
    __syncthreads();
    const int total = pex[1024];
    int vbeg, vend, vstep;
    if (G % 8 == 0) { const int chunk = (total + 7) >> 3, x = c & 7; vbeg = x * chunk + (c >> 3); vend = (x + 1) * chunk < total ? (x + 1) * chunk : total; vstep = G >> 3; }
    else { vbeg = c; vend = total; vstep = G; }
    if (vbeg >= vend) return;
    int v = vbeg;
    SRef cur = mk_sref(v, pex, U0, lists, cnts, lane, wid);
    Seam S;
    sprime(cur, U0, lds, S);
#pragma unroll 1
    for (;;) {
        const bool last = v + vstep >= vend;
        const SRef nxt = last ? cur : mk_sref(v + vstep, pex, U0, lists, cnts, lane, wid);
        sblock(cur, nxt, U0, PO, PM, lds, S);
        if (last) break;
        cur = nxt; v += vstep;
    }
}
#undef ROW
#undef VMW
#undef VMWN
#undef SLOAD
#undef SWRITE_K
#undef SWRITE_V
__device__ __forceinline__ BlockRef mk_ref(int L, int pass, const bf16* U0, bf16* O) {
    const int xcd = L & 7, k = L >> 3, bh = xcd * 4 + (k >> 4), x = k & 15, qb = pass ? 31 - x : x, b = bh >> 3, h = bh & 7;
    BlockRef r; r.Q = U0 + ((size_t)b * SEQ + qb * QB) * LD + h * D; r.K = U0 + (size_t)b * SEQ * LD + 512 + h * D; r.V = U0 + (size_t)b * SEQ * LD + 1024 + h * D;
    r.O = O + ((size_t)b * SEQ + qb * QB) * OLD + h * D; r.P0 = qb * QB; r.bh = bh; return r;
}
__device__ __forceinline__ void phase(char* lds, const bf16* U0, const float* kmean, bf16* O, int G, int c) {
    constexpr int TOTAL = NB * NH * 16;
    int L = c; if (L >= TOTAL) return; int pass = 0;
    BlockRef cur = mk_ref(L, 0, U0, O);
    Seam S;
    prime(cur, lds, S);
#pragma unroll 1
    for (;;) {
        const bool more_pass = pass == 0, more_item = L + G < TOTAL, last = !more_pass && !more_item;
        int passn = pass + 1, Ln = L;
        if (!more_pass) { passn = 0; Ln = more_item ? L + G : L; }
        const BlockRef nxt = last ? cur : mk_ref(Ln, passn, U0, O);
        block(cur, nxt, kmean, lds, S);
        if (last) break;
        cur = nxt; pass = passn; L = Ln;
    }
}
#undef KSWZ64
#undef SBAR
}

__device__ __forceinline__ float conv_silu(const bf16* u1, size_t row, int t, int col, const float* cw) {
    float a = 0.f;
#pragma unroll
    for (int j = 0; j < 4; ++j) if (t - 3 + j >= 0) a += cw[j * 1024 + col] * bf2f(u1[(row - 3 + j) * U1W + col]);
    return silu_f(a);
}
__device__ __forceinline__ void mlstm_a(LAS unsigned char* lds, const bf16* u1, const float* cw, const float* b_i, const float* b_f, bf16* mU, float* mN, float* mD, int G, int c) {
    LAS float* kf = (LAS float*)lds; LAS float* vf = kf + 8192; LAS float* wg = vf + 8192; LAS float* tb = wg + 64;
    const int tid = tid_fresh();
    for (int u = c; u < 2048; u += G) {
        const int bh = u >> 7, ch = u & 127, b = bh >> 2, hh = bh & 3, t0 = ch * 64; const size_t r0 = (size_t)b * SEQ + t0;
        __syncthreads();
#pragma unroll 1
        for (int idx = tid; idx < 8192; idx += NTHR) { const int s = idx >> 7, d = idx & 127;
            kf[idx] = conv_silu(u1, r0 + s, t0 + s, 512 + hh * 128 + d, cw) * 0.08838834764831845f; vf[idx] = bf2f(u1[(r0 + s) * U1W + 1024 + hh * 128 + d]); }
        if (tid < 64) { const size_t row = r0 + tid; tb[tid] = logsig_f(bf2f(u1[row * U1W + 2304 + 164 + hh]) + b_f[hh]); tb[64 + tid] = bf2f(u1[row * U1W + 2304 + 160 + hh]) + b_i[hh]; }
        __syncthreads();
        if (tid == 0) { float bs = 0.f; for (int s = 0; s < 64; ++s) { bs += tb[s]; tb[128 + s] = bs; } }
        __syncthreads();
        if (tid < 64) wg[tid] = __expf(tb[128 + 63] - tb[128 + tid] + tb[64 + tid]);
        __syncthreads();
        { const int v = tid >> 2, kq = tid & 3; float acc[32];
#pragma unroll
          for (int i = 0; i < 32; ++i) acc[i] = 0.f;
#pragma unroll 1
          for (int s = 0; s < 64; ++s) { const float wv = wg[s] * vf[s * 128 + v];
#pragma unroll
              for (int i = 0; i < 32; ++i) acc[i] += wv * kf[s * 128 + 4 * i + kq]; }
          bf16* Uo = mU + ((size_t)u * 128 + v) * 128;
#pragma unroll
          for (int i = 0; i < 32; ++i) Uo[4 * i + kq] = (bf16)f2bf(acc[i]); }
        if (tid < 128) { float a = 0.f; for (int s = 0; s < 64; ++s) a += wg[s] * kf[s * 128 + tid]; mN[(size_t)u * 128 + tid] = a; }
        if (tid == 0) mD[u] = __expf(tb[128 + 63]);
    }
    __syncthreads();
}
__device__ __forceinline__ void mlstm_b(bf16* mU, float* mN, const float* mD, size_t gt, size_t GT) {
    for (size_t e = gt; e < (size_t)16 * 8192; e += GT) { const int bh = (int)(e >> 13), idx = (int)(e & 8191) * 2; float s0 = 0.f, s1 = 0.f;
#pragma unroll 16
        for (int ch = 0; ch < 128; ++ch) { unsigned* p = (unsigned*)(mU + ((size_t)(bh * 128 + ch) << 14) + idx); const unsigned uv = *p; *p = pk2(s0, s1); const float d = mD[bh * 128 + ch]; s0 = d * s0 + bflo(uv); s1 = d * s1 + bfhi(uv); } }
    for (size_t e = gt; e < (size_t)16 * 128; e += GT) { const int bh = (int)(e >> 7), k = (int)(e & 127); float st = 0.f;
#pragma unroll 8
        for (int ch = 0; ch < 128; ++ch) { float* p = mN + (size_t)(bh * 128 + ch) * 128 + k; const float uv = *p; *p = st; st = mD[bh * 128 + ch] * st + uv; } }
}
__device__ __forceinline__ void mlstm_c(LAS unsigned char* lds, const bf16* u1, const float* cw, const float* b_i, const float* b_f, const float* hn, const bf16* mU, const float* mN, bf16* mix1, int G, int c) {
    LAS unsigned short* qs = (LAS unsigned short*)lds; LAS unsigned short* ks = qs + 8192; LAS unsigned short* vs = ks + 8192; LAS unsigned short* Cs = vs + 8192;
    LAS unsigned short* hb16 = ks;
    LAS float* As = (LAS float*)(lds + 81920);
    LAS float* nv = (LAS float*)(lds + 98560); LAS float* tb = nv + 128; LAS float* den = tb + 192;
    const int tid = tid_fresh(), lane = tid & 63, wave = tid >> 6;
    for (int u = c; u < 2048; u += G) {
        const int bh = u >> 7, ch = u & 127, b = bh >> 2, hh = bh & 3, t0 = ch * 64; const size_t r0 = (size_t)b * SEQ + t0;
        __syncthreads();
#pragma unroll 1
        for (int idx = tid; idx < 8192; idx += NTHR) { const int s = idx >> 7, d = idx & 127;
            qs[idx] = (unsigned short)f2bf(conv_silu(u1, r0 + s, t0 + s, hh * 128 + d, cw));
            ks[idx] = (unsigned short)f2bf(conv_silu(u1, r0 + s, t0 + s, 512 + hh * 128 + d, cw) * 0.08838834764831845f);
            vs[idx] = u1[(r0 + s) * U1W + 1024 + hh * 128 + d]; }
        for (int idx = tid; idx < 2048; idx += NTHR) ((LAS v4u*)Cs)[idx] = ((const v4u*)(mU + (size_t)u * 16384))[idx];
        if (tid < 128) nv[tid] = mN[(size_t)u * 128 + tid];
        if (tid < 64) { const size_t row = r0 + tid; tb[tid] = logsig_f(bf2f(u1[row * U1W + 2304 + 164 + hh]) + b_f[hh]); tb[64 + tid] = bf2f(u1[row * U1W + 2304 + 160 + hh]) + b_i[hh]; }
        __syncthreads();
        if (tid == 0) { float bs = 0.f; for (int s = 0; s < 64; ++s) { bs += tb[s]; tb[128 + s] = bs; } }
        __syncthreads();
#pragma unroll 1
        for (int e = tid; e < 4096; e += NTHR) { const int t = e >> 6, s = e & 63; float a = 0.f;
            if (s <= t) { const LAS unsigned* qr = (const LAS unsigned*)(qs + t * 128); const LAS unsigned* kr = (const LAS unsigned*)(ks + s * 128); float dot = 0.f;
#pragma unroll 4
                for (int k2 = 0; k2 < 64; ++k2) { const unsigned a_ = qr[k2], b_ = kr[k2]; dot += bflo(a_) * bflo(b_) + bfhi(a_) * bfhi(b_); }
                a = __expf(tb[128 + t] - tb[128 + s] + tb[64 + s]) * dot; }
            As[t * 65 + s] = a; }
        __syncthreads();
        if (tid < 64) { const int t = tid; const LAS unsigned* qr = (const LAS unsigned*)(qs + t * 128); float dq = 0.f;
#pragma unroll 4
            for (int k2 = 0; k2 < 64; ++k2) { const unsigned a_ = qr[k2]; dq += nv[2 * k2] * bflo(a_) + nv[2 * k2 + 1] * bfhi(a_); }
            float sa = 0.f; for (int s = 0; s <= t; ++s) sa += As[t * 65 + s];
            den[t] = __expf(tb[128 + t]) * dq + sa; }
        __syncthreads();
        { const int v = tid & 127, tq = tid >> 7; const LAS unsigned* cr = (const LAS unsigned*)(Cs + v * 128);
#pragma unroll 1
          for (int pass = 0; pass < 4; ++pass) { float hv[4];
#pragma unroll
              for (int i = 0; i < 4; ++i) hv[i] = 0.f;
#pragma unroll 2
              for (int k2 = 0; k2 < 64; ++k2) { const unsigned b_ = cr[k2]; const float c0 = bflo(b_), c1 = bfhi(b_);
#pragma unroll
                  for (int i = 0; i < 4; ++i) { const unsigned a_ = ((const LAS unsigned*)(qs + (tq + 16 * pass + 4 * i) * 128))[k2]; hv[i] += bflo(a_) * c0 + bfhi(a_) * c1; } }
#pragma unroll
              for (int i = 0; i < 4; ++i) hv[i] *= __expf(tb[128 + tq + 16 * pass + 4 * i]);
#pragma unroll 2
              for (int s = 0; s < 64; ++s) { const float vv = bf2f(vs[s * 128 + v]);
#pragma unroll
                  for (int i = 0; i < 4; ++i) { const int t = tq + 16 * pass + 4 * i; if (s <= t) hv[i] += As[t * 65 + s] * vv; } }
#pragma unroll
              for (int i = 0; i < 4; ++i) { const int t = tq + 16 * pass + 4 * i; hb16[t * 128 + v] = (unsigned short)f2bf(hv[i] / fmaxf(fabsf(den[t]), 1.f)); } } }
        __syncthreads();
#pragma unroll 1
        for (int tt = 0; tt < 8; ++tt) { const int t = wave * 8 + tt; const float a0 = bf2f(hb16[t * 128 + lane]), a1 = bf2f(hb16[t * 128 + 64 + lane]);
            const float rstd = rsqrtf(wave_sum(a0 * a0 + a1 * a1) * (1.f / 128.f) + EPS); const size_t row = r0 + t;
            const float o0 = a0 * rstd * hn[hh * 128 + lane] * sigmoid_f(bf2f(u1[row * U1W + 1536 + hh * 128 + lane]));
            const float o1 = a1 * rstd * hn[hh * 128 + 64 + lane] * sigmoid_f(bf2f(u1[row * U1W + 1536 + hh * 128 + 64 + lane]));
            mix1[row * D + hh * 128 + lane] = (bf16)f2bf(o0); mix1[row * D + hh * 128 + 64 + lane] = (bf16)f2bf(o1); }
    }
    __syncthreads();
}

namespace mlm {
using mla_attn::bf16x8; using mla_attn::f32x16; using mla_attn::crow;
constexpr int PS = 72, PK = 136;
__device__ __forceinline__ bf16x8 frag(const LAS unsigned char* base, int row, int pitchB, int colB) { return *(const LAS bf16x8*)(base + row * pitchB + colB); }
__device__ __forceinline__ void gates(LAS float* tb, const bf16* u1, size_t r0, int hh, const float* b_i, const float* b_f, int tid) {
    if (tid < 64) { const size_t row = r0 + tid; float v = logsig_f(bf2f(u1[row * U1W + 2304 + 164 + hh]) + b_f[hh]); tb[tid] = v; tb[64 + tid] = bf2f(u1[row * U1W + 2304 + 160 + hh]) + b_i[hh];
#pragma unroll
        for (int o = 1; o < 64; o <<= 1) { const float t = __shfl_up(v, o); if (tid >= o) v += t; }
        tb[128 + tid] = v; }
    __syncthreads();
}
__device__ __forceinline__ void conv2(const bf16* u1, size_t row, int t, int col, const float* cw, float& y0, float& y1) {
    float x[5];
#pragma unroll
    for (int j = 0; j < 5; ++j) x[j] = (t - 3 + j >= 0) ? bf2f(u1[(row - 3 + j) * U1W + col]) : 0.f;
    const float w0 = cw[col], w1 = cw[1024 + col], w2 = cw[2048 + col], w3 = cw[3072 + col];
    y0 = silu_f(w0 * x[0] + w1 * x[1] + w2 * x[2] + w3 * x[3]); y1 = silu_f(w0 * x[1] + w1 * x[2] + w2 * x[3] + w3 * x[4]);
}
__device__ __forceinline__ void stage_a(LAS unsigned char* lds, const bf16* u1, const float* cw, const float* b_i, const float* b_f, bf16* mU, float* mN, float* mD, int G, int c) {
    LAS unsigned char* KT = lds; LAS unsigned char* VT = lds + 18432; LAS unsigned char* UT = lds + 36864; LAS float* tb = (LAS float*)(lds + 71680); LAS float* wg = tb + 192;
    const int tid = tid_fresh(), lane = tid & 63, wave = __builtin_amdgcn_readfirstlane(tid >> 6), l31 = lane & 31, hi = lane >> 5;
#pragma unroll 1
    for (int u = c; u < 2048; u += G) {
        const int bh = u >> 7, ch = u & 127, b = bh >> 2, hh = bh & 3, t0 = ch * 64; const size_t r0 = (size_t)b * SEQ + t0;
        __syncthreads();
        gates(tb, u1, r0, hh, b_i, b_f, tid);
        if (tid < 64) wg[tid] = __expf(tb[128 + 63] - tb[128 + tid] + tb[64 + tid]);
        if (tid == 0) mD[u] = __expf(tb[128 + 63]);
        __syncthreads();
        { const int d = tid & 127, sq = tid >> 7;
#pragma unroll
          for (int i = 0; i < 8; ++i) { const int s0 = 2 * (sq + 4 * i); float y0, y1;
              conv2(u1, r0 + s0, t0 + s0, 512 + hh * 128 + d, cw, y0, y1);
              *(LAS unsigned*)(KT + d * (PS * 2) + s0 * 2) = pk2(y0 * 0.08838834764831845f, y1 * 0.08838834764831845f); }
#pragma unroll
          for (int i = 0; i < 8; ++i) { const int s0 = 2 * (sq + 4 * i);
              const float v0 = bf2f(u1[(r0 + s0) * U1W + 1024 + hh * 128 + d]) * wg[s0], v1 = bf2f(u1[(r0 + s0 + 1) * U1W + 1024 + hh * 128 + d]) * wg[s0 + 1];
              *(LAS unsigned*)(VT + d * (PS * 2) + s0 * 2) = pk2(v0, v1); } }
        __syncthreads();
        { const int vt = wave & 3, kt0 = (wave >> 2) * 2; f32x16 acc[2] = {};
#pragma unroll
          for (int ks = 0; ks < 4; ++ks) { const bf16x8 Bf = frag(VT, vt * 32 + l31, PS * 2, ks * 32 + hi * 16);
#pragma unroll
              for (int a = 0; a < 2; ++a) acc[a] = __builtin_amdgcn_mfma_f32_32x32x16_bf16(frag(KT, (kt0 + a) * 32 + l31, PS * 2, ks * 32 + hi * 16), Bf, acc[a], 0, 0, 0); }
#pragma unroll
          for (int a = 0; a < 2; ++a)
#pragma unroll
              for (int g = 0; g < 4; ++g) { v2u w; w.x = cvt2(acc[a][4 * g], acc[a][4 * g + 1]); w.y = cvt2(acc[a][4 * g + 2], acc[a][4 * g + 3]);
                  *(LAS v2u*)(UT + (vt * 32 + l31) * (PK * 2) + ((kt0 + a) * 32 + 8 * g + 4 * hi) * 2) = w; } }
        if (tid < 128) { float a = 0.f; const LAS unsigned* kr = (const LAS unsigned*)(KT + tid * (PS * 2));
#pragma unroll 4
            for (int s2 = 0; s2 < 32; ++s2) { const unsigned w = kr[s2]; a += wg[2 * s2] * bflo(w) + wg[2 * s2 + 1] * bfhi(w); }
            mN[(size_t)u * 128 + tid] = a; }
        __syncthreads();
#pragma unroll
        for (int i = 0; i < 4; ++i) { const int idx = tid + NTHR * i, row = idx >> 4, c16 = idx & 15;
            *(v4u*)(mU + ((size_t)u * 128 + row) * 128 + c16 * 8) = *(const LAS v4u*)(UT + row * (PK * 2) + c16 * 16); }
    }
    __syncthreads();
}
__device__ __forceinline__ void stage_a2(LAS unsigned char* lds, const bf16* u1, const float* cw, const float* b_i, const float* b_f, bf16* mU, float* mN, float* mD, int G, int c) {
    LAS unsigned char* RK = lds; LAS unsigned char* RV = lds + 17408; LAS unsigned char* UT = lds;
    LAS unsigned char* KT = lds + 34816; LAS unsigned char* VT = lds + 53248; LAS float* wg = (LAS float*)(lds + 71680);
    const int tid = tid_fresh(), lane = tid & 63, wave = __builtin_amdgcn_readfirstlane(tid >> 6), l31 = lane & 31, hi = lane >> 5;
    v4u rk0, rk1, rk2, rv0, rv1; float gf = 0.f, gi = 0.f;
    rk0 = rk1 = rk2 = rv0 = rv1 = (v4u){0u, 0u, 0u, 0u};
#define A2_FETCH(uu) do { const int bh_ = (uu) >> 7, ch_ = (uu) & 127, b_ = bh_ >> 2, hh_ = bh_ & 3, t0_ = ch_ * 64; const size_t r0_ = (size_t)b_ * SEQ + t0_;                  \
        { const int p = tid, row = p >> 4, c16 = p & 15; rk0 = (t0_ - 3 + row >= 0) ? *(const v4u*)(u1 + (r0_ - 3 + row) * U1W + 512 + hh_ * 128 + c16 * 8) : (v4u){0u, 0u, 0u, 0u}; }   \
        { const int p = tid + 512, row = p >> 4, c16 = p & 15; rk1 = *(const v4u*)(u1 + (r0_ - 3 + row) * U1W + 512 + hh_ * 128 + c16 * 8); }                                           \
        if (tid < 48) { const int p = tid + 1024, row = p >> 4, c16 = p & 15; rk2 = *(const v4u*)(u1 + (r0_ - 3 + row) * U1W + 512 + hh_ * 128 + c16 * 8); }                            \
        { const int p = tid, row = p >> 4, c16 = p & 15; rv0 = *(const v4u*)(u1 + (r0_ + row) * U1W + 1024 + hh_ * 128 + c16 * 8); }                                                   \
        { const int p = tid + 512, row = p >> 4, c16 = p & 15; rv1 = *(const v4u*)(u1 + (r0_ + row) * U1W + 1024 + hh_ * 128 + c16 * 8); }                                             \
        if (tid < 64) { const size_t row = r0_ + tid; gf = bf2f(u1[row * U1W + 2304 + 164 + hh_]) + b_f[hh_]; gi = bf2f(u1[row * U1W + 2304 + 160 + hh_]) + b_i[hh_]; } } while (0)
    if (c < 2048) A2_FETCH(c);
#pragma unroll 1
    for (int u = c; u < 2048; u += G) {
        const int hh = (u >> 7) & 3; const int cd_ = 2 * (tid & 63);
        typedef float f2t_ __attribute__((ext_vector_type(2)));
        const f2t_ w0 = *(const f2t_*)(cw + 512 + hh * 128 + cd_), w1 = *(const f2t_*)(cw + 1024 + 512 + hh * 128 + cd_), w2 = *(const f2t_*)(cw + 2048 + 512 + hh * 128 + cd_), w3 = *(const f2t_*)(cw + 3072 + 512 + hh * 128 + cd_);
        __syncthreads();
        ((LAS v4u*)RK)[tid] = rk0; ((LAS v4u*)RK)[tid + 512] = rk1; if (tid < 48) ((LAS v4u*)RK)[tid + 1024] = rk2;
        ((LAS v4u*)RV)[tid] = rv0; ((LAS v4u*)RV)[tid + 512] = rv1;
        if (tid < 64) { float v = logsig_f(gf);
#pragma unroll
            for (int o = 1; o < 64; o <<= 1) { const float t = __shfl_up(v, o); if (tid >= o) v += t; }
            const float bend = __shfl(v, 63); wg[tid] = __expf(bend - v + gi); if (tid == 63) mD[u] = __expf(bend); }
        if (u + G < 2048) A2_FETCH(u + G);
        __syncthreads();
        { const int d2 = tid & 63, sq = tid >> 6; const float ksc = 0.08838834764831845f;
#pragma unroll
          for (int i = 0; i < 4; ++i) { const int s0 = 2 * (sq + 8 * i); unsigned x[5];
#pragma unroll
              for (int j = 0; j < 5; ++j) x[j] = *(const LAS unsigned*)(RK + (s0 + j) * 256 + d2 * 4);
              const float y0a = silu_f(w0[0] * bflo(x[0]) + w1[0] * bflo(x[1]) + w2[0] * bflo(x[2]) + w3[0] * bflo(x[3])), y1a = silu_f(w0[0] * bflo(x[1]) + w1[0] * bflo(x[2]) + w2[0] * bflo(x[3]) + w3[0] * bflo(x[4]));
              const float y0b = silu_f(w0[1] * bfhi(x[0]) + w1[1] * bfhi(x[1]) + w2[1] * bfhi(x[2]) + w3[1] * bfhi(x[3])), y1b = silu_f(w0[1] * bfhi(x[1]) + w1[1] * bfhi(x[2]) + w2[1] * bfhi(x[3]) + w3[1] * bfhi(x[4]));
              *(LAS unsigned*)(KT + (2 * d2) * (PS * 2) + s0 * 2) = pk2(y0a * ksc, y1a * ksc); *(LAS unsigned*)(KT + (2 * d2 + 1) * (PS * 2) + s0 * 2) = pk2(y0b * ksc, y1b * ksc);
              const unsigned r0 = *(const LAS unsigned*)(RV + s0 * 256 + d2 * 4), r1 = *(const LAS unsigned*)(RV + (s0 + 1) * 256 + d2 * 4); const float g0 = wg[s0], g1 = wg[s0 + 1];
              *(LAS unsigned*)(VT + (2 * d2) * (PS * 2) + s0 * 2) = pk2(bflo(r0) * g0, bflo(r1) * g1); *(LAS unsigned*)(VT + (2 * d2 + 1) * (PS * 2) + s0 * 2) = pk2(bfhi(r0) * g0, bfhi(r1) * g1); } }
        __syncthreads();
        { const int vt = wave & 3, kt0 = (wave >> 2) * 2; f32x16 acc[2] = {};
#pragma unroll
          for (int ks = 0; ks < 4; ++ks) { const bf16x8 Bf = frag(VT, vt * 32 + l31, PS * 2, ks * 32 + hi * 16);
#pragma unroll
              for (int a = 0; a < 2; ++a) acc[a] = __builtin_amdgcn_mfma_f32_32x32x16_bf16(frag(KT, (kt0 + a) * 32 + l31, PS * 2, ks * 32 + hi * 16), Bf, acc[a], 0, 0, 0); }
#pragma unroll
          for (int a = 0; a < 2; ++a)
#pragma unroll
              for (int g = 0; g < 4; ++g) { v2u w; w.x = cvt2(acc[a][4 * g], acc[a][4 * g + 1]); w.y = cvt2(acc[a][4 * g + 2], acc[a][4 * g + 3]);
                  *(LAS v2u*)(UT + (vt * 32 + l31) * (PK * 2) + ((kt0 + a) * 32 + 8 * g + 4 * hi) * 2) = w; } }
        if (tid < 128) { float a = 0.f; const LAS unsigned* kr = (const LAS unsigned*)(KT + tid * (PS * 2));
#pragma unroll 4
            for (int s2 = 0; s2 < 32; ++s2) { const unsigned w = kr[s2]; a += wg[2 * s2] * bflo(w) + wg[2 * s2 + 1] * bfhi(w); }
            mN[(size_t)u * 128 + tid] = a; }
        __syncthreads();
#pragma unroll
        for (int i = 0; i < 4; ++i) { const int idx = tid + NTHR * i, row = idx >> 4, c16 = idx & 15;
            *(v4u*)(mU + ((size_t)u * 128 + row) * 128 + c16 * 8) = *(const LAS v4u*)(UT + row * (PK * 2) + c16 * 16); }
    }
#undef A2_FETCH
    __syncthreads();
}
__device__ __forceinline__ void stage_c(LAS unsigned char* lds, const bf16* u1, const float* cw, const float* b_i, const float* b_f, const float* hn, const bf16* mU, const float* mN, bf16* mix1, int G, int c) {
    LAS unsigned char* Qs = lds; LAS unsigned char* Ks = lds + 17408; LAS unsigned char* VT = lds + 34816; LAS unsigned char* Cs = lds + 53248; LAS unsigned char* As = lds + 88064;
    LAS float* hbuf = (LAS float*)Cs;
    LAS float* tb = (LAS float*)(lds + 97280); LAS float* ebt = tb + 192; LAS float* nv = ebt + 64; LAS float* den = nv + 128;
    const int tid = tid_fresh(), lane = tid & 63, wave = __builtin_amdgcn_readfirstlane(tid >> 6), l31 = lane & 31, hi = lane >> 5;
#pragma unroll 1
    for (int u = c; u < 2048; u += G) {
        const int bh = u >> 7, ch = u & 127, b = bh >> 2, hh = bh & 3, t0 = ch * 64; const size_t r0 = (size_t)b * SEQ + t0;
        __syncthreads();
        gates(tb, u1, r0, hh, b_i, b_f, tid);
        if (tid < 64) ebt[tid] = __expf(tb[128 + tid]);
        if (tid < 128) nv[tid] = mN[(size_t)u * 128 + tid];
        { const int d = tid & 127, sq = tid >> 7;
#pragma unroll
          for (int i = 0; i < 8; ++i) { const int s0 = 2 * (sq + 4 * i); float y0, y1;
              conv2(u1, r0 + s0, t0 + s0, hh * 128 + d, cw, y0, y1);
              *(LAS unsigned short*)(Qs + s0 * (PK * 2) + d * 2) = (unsigned short)f2bf(y0); *(LAS unsigned short*)(Qs + (s0 + 1) * (PK * 2) + d * 2) = (unsigned short)f2bf(y1); }
#pragma unroll
          for (int i = 0; i < 8; ++i) { const int s0 = 2 * (sq + 4 * i); float y0, y1;
              conv2(u1, r0 + s0, t0 + s0, 512 + hh * 128 + d, cw, y0, y1);
              *(LAS unsigned short*)(Ks + s0 * (PK * 2) + d * 2) = (unsigned short)f2bf(y0 * 0.08838834764831845f); *(LAS unsigned short*)(Ks + (s0 + 1) * (PK * 2) + d * 2) = (unsigned short)f2bf(y1 * 0.08838834764831845f); }
#pragma unroll
          for (int i = 0; i < 8; ++i) { const int s0 = 2 * (sq + 4 * i);
              *(LAS unsigned*)(VT + d * (PS * 2) + s0 * 2) = (unsigned)u1[(r0 + s0) * U1W + 1024 + hh * 128 + d] | ((unsigned)u1[(r0 + s0 + 1) * U1W + 1024 + hh * 128 + d] << 16); } }
#pragma unroll
        for (int i = 0; i < 4; ++i) { const int idx = tid + NTHR * i, row = idx >> 4, c16 = idx & 15;
            *(LAS v4u*)(Cs + row * (PK * 2) + c16 * 16) = *(const v4u*)(mU + ((size_t)u * 128 + row) * 128 + c16 * 8); }
        __syncthreads();
        if (wave < 3) { const int st = (wave == 2) ? 1 : 0, tt = (wave == 0) ? 0 : 1; f32x16 sacc = {};
#pragma unroll
            for (int ks = 0; ks < 8; ++ks) sacc = __builtin_amdgcn_mfma_f32_32x32x16_bf16(frag(Ks, st * 32 + l31, PK * 2, ks * 32 + hi * 16), frag(Qs, tt * 32 + l31, PK * 2, ks * 32 + hi * 16), sacc, 0, 0, 0);
            const int t = tt * 32 + l31; const float bt = tb[128 + t];
#pragma unroll
            for (int g = 0; g < 4; ++g) { float av[4];
#pragma unroll
                for (int j = 0; j < 4; ++j) { const int s = st * 32 + 8 * g + 4 * hi + j; av[j] = (s <= t) ? __expf(bt - tb[128 + s] + tb[64 + s]) * sacc[4 * g + j] : 0.f; }
                v2u w; w.x = cvt2(av[0], av[1]); w.y = cvt2(av[2], av[3]); *(LAS v2u*)(As + t * (PS * 2) + (st * 32 + 8 * g + 4 * hi) * 2) = w; } }
        else if (wave == 3) { for (int i = lane; i < 32 * 8; i += 64) { const int t = i >> 3, c8 = i & 7; *(LAS v2u*)(As + t * (PS * 2) + 64 + c8 * 8) = (v2u){0u, 0u}; } }
        __syncthreads();
        { const int t = tid >> 3, part = tid & 7; float dq = 0.f, sa = 0.f; const LAS unsigned* qr = (const LAS unsigned*)(Qs + t * (PK * 2) + part * 32); const LAS unsigned* ar = (const LAS unsigned*)(As + t * (PS * 2) + part * 16);
#pragma unroll
          for (int k2 = 0; k2 < 8; ++k2) { const unsigned w = qr[k2]; dq += nv[part * 16 + 2 * k2] * bflo(w) + nv[part * 16 + 2 * k2 + 1] * bfhi(w); }
#pragma unroll
          for (int s2 = 0; s2 < 4; ++s2) { const unsigned w = ar[s2]; sa += bflo(w) + bfhi(w); }
          float dv = ebt[t] * dq + sa; dv += __shfl_xor(dv, 1); dv += __shfl_xor(dv, 2); dv += __shfl_xor(dv, 4);
          if (part == 0) den[t] = dv; }
        f32x16 acc = {}; const int tt = wave & 1, vt = wave >> 1;
#pragma unroll
        for (int ks = 0; ks < 8; ++ks) acc = __builtin_amdgcn_mfma_f32_32x32x16_bf16(frag(Qs, tt * 32 + l31, PK * 2, ks * 32 + hi * 16), frag(Cs, vt * 32 + l31, PK * 2, ks * 32 + hi * 16), acc, 0, 0, 0);
#pragma unroll
        for (int r = 0; r < 16; ++r) acc[r] *= ebt[tt * 32 + crow(r, hi)];
#pragma unroll
        for (int ks = 0; ks < 4; ++ks) acc = __builtin_amdgcn_mfma_f32_32x32x16_bf16(frag(As, tt * 32 + l31, PS * 2, ks * 32 + hi * 16), frag(VT, vt * 32 + l31, PS * 2, ks * 32 + hi * 16), acc, 0, 0, 0);
        __syncthreads();
#pragma unroll
        for (int r = 0; r < 16; ++r) { const int t = tt * 32 + crow(r, hi); hbuf[t * 132 + vt * 32 + l31] = acc[r] * __builtin_amdgcn_rcpf(fmaxf(fabsf(den[t]), 1.f)); }
        __syncthreads();
#pragma unroll 1
        for (int q8 = 0; q8 < 8; ++q8) { const int t = wave * 8 + q8; const float a0 = hbuf[t * 132 + lane], a1 = hbuf[t * 132 + 64 + lane];
            const float rstd = rsqrtf(wave_sum(a0 * a0 + a1 * a1) * (1.f / 128.f) + EPS); const size_t row = r0 + t;
            const float o0 = a0 * rstd * hn[hh * 128 + lane] * sigmoid_f(bf2f(u1[row * U1W + 1536 + hh * 128 + lane]));
            const float o1 = a1 * rstd * hn[hh * 128 + 64 + lane] * sigmoid_f(bf2f(u1[row * U1W + 1536 + hh * 128 + 64 + lane]));
            mix1[row * D + hh * 128 + lane] = (bf16)f2bf(o0); mix1[row * D + hh * 128 + 64 + lane] = (bf16)f2bf(o1); }
    }
    __syncthreads();
}
__device__ __forceinline__ void stage_c2(LAS unsigned char* lds, const bf16* u1, const float* cw, const float* b_i, const float* b_f, const float* hn, const bf16* mU, const float* mN, bf16* mix1, int G, int c) {
    LAS unsigned char* Qs = lds; LAS unsigned char* Ks = lds + 17408; LAS unsigned char* VT = lds + 34816; LAS unsigned char* Cs = lds + 53248; LAS unsigned char* As = lds + 88064;
    LAS unsigned char* RQ = Cs; LAS unsigned char* RK = Cs + 17408;
    LAS float* hbuf = (LAS float*)Cs;
    LAS float* tb = (LAS float*)(lds + 97280); LAS float* ebt = tb + 192; LAS float* nv = ebt + 64; LAS float* den = nv + 128;
    const int tid = tid_fresh(), lane = tid & 63, wave = __builtin_amdgcn_readfirstlane(tid >> 6), l31 = lane & 31, hi = lane >> 5;
    v4u rq0, rq1, rq2, rk0, rk1, rk2, rv0, rv1; float gf = 0.f, gi = 0.f, nvr = 0.f;
    rq0 = rq1 = rq2 = rk0 = rk1 = rk2 = rv0 = rv1 = (v4u){0u, 0u, 0u, 0u};
#define C2_FETCH(uu) do { const int bh_ = (uu) >> 7, ch_ = (uu) & 127, b_ = bh_ >> 2, hh_ = bh_ & 3, t0_ = ch_ * 64; const size_t r0_ = (size_t)b_ * SEQ + t0_;                  \
        { const int p = tid, row = p >> 4, c16 = p & 15; const bool ok_ = t0_ - 3 + row >= 0; const bf16* s_ = u1 + (r0_ - 3 + row) * U1W + hh_ * 128 + c16 * 8;                          \
          rq0 = ok_ ? *(const v4u*)s_ : (v4u){0u, 0u, 0u, 0u}; rk0 = ok_ ? *(const v4u*)(s_ + 512) : (v4u){0u, 0u, 0u, 0u}; }                                                          \
        { const int p = tid + 512, row = p >> 4, c16 = p & 15; const bf16* s_ = u1 + (r0_ - 3 + row) * U1W + hh_ * 128 + c16 * 8; rq1 = *(const v4u*)s_; rk1 = *(const v4u*)(s_ + 512); } \
        if (tid < 48) { const int p = tid + 1024, row = p >> 4, c16 = p & 15; const bf16* s_ = u1 + (r0_ - 3 + row) * U1W + hh_ * 128 + c16 * 8; rq2 = *(const v4u*)s_; rk2 = *(const v4u*)(s_ + 512); } \
        { const int p = tid, row = p >> 4, c16 = p & 15; rv0 = *(const v4u*)(u1 + (r0_ + row) * U1W + 1024 + hh_ * 128 + c16 * 8); }                                                   \
        { const int p = tid + 512, row = p >> 4, c16 = p & 15; rv1 = *(const v4u*)(u1 + (r0_ + row) * U1W + 1024 + hh_ * 128 + c16 * 8); }                                             \
        if (tid < 128) nvr = mN[(size_t)(uu) * 128 + tid];                                                                                                                            \
        if (tid < 64) { const size_t row = r0_ + tid; gf = bf2f(u1[row * U1W + 2304 + 164 + hh_]) + b_f[hh_]; gi = bf2f(u1[row * U1W + 2304 + 160 + hh_]) + b_i[hh_]; } } while (0)
#define C2_VT(rv_, p_) do { const int s_ = (p_) >> 4, d_ = ((p_) & 15) * 8; LAS unsigned short* vt_ = (LAS unsigned short*)(VT + d_ * (PS * 2) + s_ * 2);                            \
        vt_[0 * PS] = (unsigned short)(rv_.x & 0xffffu); vt_[1 * PS] = (unsigned short)(rv_.x >> 16); vt_[2 * PS] = (unsigned short)(rv_.y & 0xffffu); vt_[3 * PS] = (unsigned short)(rv_.y >> 16); \
        vt_[4 * PS] = (unsigned short)(rv_.z & 0xffffu); vt_[5 * PS] = (unsigned short)(rv_.z >> 16); vt_[6 * PS] = (unsigned short)(rv_.w & 0xffffu); vt_[7 * PS] = (unsigned short)(rv_.w >> 16); } while (0)
    if (c < 2048) C2_FETCH(c);
#pragma unroll 1
    for (int u = c; u < 2048; u += G) {
        const int bh = u >> 7, ch = u & 127, b = bh >> 2, hh = bh & 3, t0 = ch * 64; const size_t r0 = (size_t)b * SEQ + t0;
        const int cd_ = 2 * (tid & 63);
        typedef float f2t_ __attribute__((ext_vector_type(2)));
        const f2t_ q0 = *(const f2t_*)(cw + hh * 128 + cd_), q1 = *(const f2t_*)(cw + 1024 + hh * 128 + cd_), q2 = *(const f2t_*)(cw + 2048 + hh * 128 + cd_), q3 = *(const f2t_*)(cw + 3072 + hh * 128 + cd_);
        const f2t_ k0 = *(const f2t_*)(cw + 512 + hh * 128 + cd_), k1 = *(const f2t_*)(cw + 1024 + 512 + hh * 128 + cd_), k2 = *(const f2t_*)(cw + 2048 + 512 + hh * 128 + cd_), k3 = *(const f2t_*)(cw + 3072 + 512 + hh * 128 + cd_);
        __syncthreads();
        ((LAS v4u*)RQ)[tid] = rq0; ((LAS v4u*)RQ)[tid + 512] = rq1; ((LAS v4u*)RK)[tid] = rk0; ((LAS v4u*)RK)[tid + 512] = rk1;
        if (tid < 48) { ((LAS v4u*)RQ)[tid + 1024] = rq2; ((LAS v4u*)RK)[tid + 1024] = rk2; }
        C2_VT(rv0, tid); C2_VT(rv1, tid + 512);
        if (tid < 64) { float v = logsig_f(gf);
#pragma unroll
            for (int o = 1; o < 64; o <<= 1) { const float t = __shfl_up(v, o); if (tid >= o) v += t; }
            tb[64 + tid] = gi; tb[128 + tid] = v; ebt[tid] = __expf(v); }
        if (tid < 128) nv[tid] = nvr;
        v4u cr[4];
#pragma unroll
        for (int i = 0; i < 4; ++i) { const int idx = tid + NTHR * i, row = idx >> 4, c16 = idx & 15; cr[i] = *(const v4u*)(mU + ((size_t)u * 128 + row) * 128 + c16 * 8); }
        unsigned og[8];
#pragma unroll
        for (int q8 = 0; q8 < 8; ++q8) og[q8] = *(const unsigned*)(u1 + (r0 + wave * 8 + q8) * U1W + 1536 + hh * 128 + 2 * lane);
        if (u + G < 2048) C2_FETCH(u + G);
        __syncthreads();
        { const int d2 = tid & 63, sq = tid >> 6;
#pragma unroll
          for (int i = 0; i < 4; ++i) { const int s0 = 2 * (sq + 8 * i); unsigned x[5], y[5];
#pragma unroll
              for (int j = 0; j < 5; ++j) { x[j] = *(const LAS unsigned*)(RQ + (s0 + j) * 256 + d2 * 4); y[j] = *(const LAS unsigned*)(RK + (s0 + j) * 256 + d2 * 4); }
              *(LAS unsigned*)(Qs + s0 * (PK * 2) + d2 * 4) = pk2(silu_f(q0[0] * bflo(x[0]) + q1[0] * bflo(x[1]) + q2[0] * bflo(x[2]) + q3[0] * bflo(x[3])), silu_f(q0[1] * bfhi(x[0]) + q1[1] * bfhi(x[1]) + q2[1] * bfhi(x[2]) + q3[1] * bfhi(x[3])));
              *(LAS unsigned*)(Qs + (s0 + 1) * (PK * 2) + d2 * 4) = pk2(silu_f(q0[0] * bflo(x[1]) + q1[0] * bflo(x[2]) + q2[0] * bflo(x[3]) + q3[0] * bflo(x[4])), silu_f(q0[1] * bfhi(x[1]) + q1[1] * bfhi(x[2]) + q2[1] * bfhi(x[3]) + q3[1] * bfhi(x[4])));
              *(LAS unsigned*)(Ks + s0 * (PK * 2) + d2 * 4) = pk2(silu_f(k0[0] * bflo(y[0]) + k1[0] * bflo(y[1]) + k2[0] * bflo(y[2]) + k3[0] * bflo(y[3])) * 0.08838834764831845f, silu_f(k0[1] * bfhi(y[0]) + k1[1] * bfhi(y[1]) + k2[1] * bfhi(y[2]) + k3[1] * bfhi(y[3])) * 0.08838834764831845f);
              *(LAS unsigned*)(Ks + (s0 + 1) * (PK * 2) + d2 * 4) = pk2(silu_f(k0[0] * bflo(y[1]) + k1[0] * bflo(y[2]) + k2[0] * bflo(y[3]) + k3[0] * bflo(y[4])) * 0.08838834764831845f, silu_f(k0[1] * bfhi(y[1]) + k1[1] * bfhi(y[2]) + k2[1] * bfhi(y[3]) + k3[1] * bfhi(y[4])) * 0.08838834764831845f); } }
        __syncthreads();
#pragma unroll
        for (int i = 0; i < 4; ++i) { const int idx = tid + NTHR * i, row = idx >> 4, c16 = idx & 15; *(LAS v4u*)(Cs + row * (PK * 2) + c16 * 16) = cr[i]; }
        __syncthreads();
        if (wave < 3) { const int st = (wave == 2) ? 1 : 0, tt = (wave == 0) ? 0 : 1; f32x16 sacc = {};
#pragma unroll
            for (int ks = 0; ks < 8; ++ks) sacc = __builtin_amdgcn_mfma_f32_32x32x16_bf16(frag(Ks, st * 32 + l31, PK * 2, ks * 32 + hi * 16), frag(Qs, tt * 32 + l31, PK * 2, ks * 32 + hi * 16), sacc, 0, 0, 0);
            const int t = tt * 32 + l31; const float bt = tb[128 + t];
#pragma unroll
            for (int g = 0; g < 4; ++g) { float av[4];
#pragma unroll
                for (int j = 0; j < 4; ++j) { const int s = st * 32 + 8 * g + 4 * hi + j; av[j] = (s <= t) ? __expf(bt - tb[128 + s] + tb[64 + s]) * sacc[4 * g + j] : 0.f; }
                v2u w; w.x = cvt2(av[0], av[1]); w.y = cvt2(av[2], av[3]); *(LAS v2u*)(As + t * (PS * 2) + (st * 32 + 8 * g + 4 * hi) * 2) = w; } }
        else if (wave == 3) { for (int i = lane; i < 32 * 8; i += 64) { const int t = i >> 3, c8 = i & 7; *(LAS v2u*)(As + t * (PS * 2) + 64 + c8 * 8) = (v2u){0u, 0u}; } }
        __syncthreads();
        { const int t = tid >> 3, part = tid & 7; float dq = 0.f, sa = 0.f; const LAS unsigned* qr = (const LAS unsigned*)(Qs + t * (PK * 2) + part * 32); const LAS unsigned* ar = (const LAS unsigned*)(As + t * (PS * 2) + part * 16);
#pragma unroll
          for (int k2 = 0; k2 < 8; ++k2) { const unsigned w = qr[k2]; dq += nv[part * 16 + 2 * k2] * bflo(w) + nv[part * 16 + 2 * k2 + 1] * bfhi(w); }
#pragma unroll
          for (int s2 = 0; s2 < 4; ++s2) { const unsigned w = ar[s2]; sa += bflo(w) + bfhi(w); }
          float dv = ebt[t] * dq + sa; dv += __shfl_xor(dv, 1); dv += __shfl_xor(dv, 2); dv += __shfl_xor(dv, 4);
          if (part == 0) den[t] = dv; }
        f32x16 acc = {}; const int tt = wave & 1, vt = wave >> 1;
#pragma unroll
        for (int ks = 0; ks < 8; ++ks) acc = __builtin_amdgcn_mfma_f32_32x32x16_bf16(frag(Qs, tt * 32 + l31, PK * 2, ks * 32 + hi * 16), frag(Cs, vt * 32 + l31, PK * 2, ks * 32 + hi * 16), acc, 0, 0, 0);
#pragma unroll
        for (int r = 0; r < 16; ++r) acc[r] *= ebt[tt * 32 + crow(r, hi)];
#pragma unroll
        for (int ks = 0; ks < 4; ++ks) acc = __builtin_amdgcn_mfma_f32_32x32x16_bf16(frag(As, tt * 32 + l31, PS * 2, ks * 32 + hi * 16), frag(VT, vt * 32 + l31, PS * 2, ks * 32 + hi * 16), acc, 0, 0, 0);
        __syncthreads();
#pragma unroll
        for (int r = 0; r < 16; ++r) { const int t = tt * 32 + crow(r, hi); hbuf[t * 132 + vt * 32 + l31] = acc[r] * __builtin_amdgcn_rcpf(fmaxf(fabsf(den[t]), 1.f)); }
        __syncthreads();
        { const float hn0 = hn[hh * 128 + 2 * lane], hn1 = hn[hh * 128 + 2 * lane + 1];
#pragma unroll
          for (int q8 = 0; q8 < 8; ++q8) { const int t = wave * 8 + q8; typedef float f2_ __attribute__((ext_vector_type(2))); const f2_ av = *(const LAS f2_*)(hbuf + t * 132 + 2 * lane);
            const float rstd = rsqrtf(wave_sum(av[0] * av[0] + av[1] * av[1]) * (1.f / 128.f) + EPS); const size_t row = r0 + t;
            const float o0 = av[0] * rstd * hn0 * sigmoid_f(bflo(og[q8])), o1 = av[1] * rstd * hn1 * sigmoid_f(bfhi(og[q8]));
            *(unsigned*)(mix1 + row * D + hh * 128 + 2 * lane) = pk2(o0, o1); } }
    }
    __syncthreads();
}
#undef C2_FETCH
#undef C2_VT
}

struct Args { const float* in[32]; float* out; unsigned char* ws; int ph_lo, ph_hi, li, pad; };
__global__ void __launch_bounds__(NTHR, 2) fwd_kernel(Args args) {
    extern __shared__ __attribute__((aligned(16))) unsigned char lds_raw[];
    LAS unsigned char* lds = (LAS unsigned char*)lds_raw;
    volatile LAS unsigned* MISC = (volatile LAS unsigned*)(lds + MISC_OFF);
    const int G = gridDim.x, c = blockIdx.x, NGW = G * NWAVES; const size_t GT = (size_t)G * NTHR;
#define PHASE_IDS const int tid = tid_fresh(), lane = tid & 63, wave = __builtin_amdgcn_readfirstlane(tid >> 6), gw = c * NWAVES + wave; const size_t gt = (size_t)c * NTHR + tid; \
    LAS float* scr = (LAS float*)(lds + wave * 16384); (void)lane; (void)gw; (void)gt; (void)scr
    unsigned char* ws = args.ws; float* hout = args.out;
    bf16* hb2 = (bf16*)args.out;
    gu32* ctl = (gu32*)(ws + WS_CTL);
    float* ssqb = (float*)(ws + WS_SSQ);
    for (int u = tid_fresh(); u < (LDS_BYTES - RING_BYTES) / 4; u += NTHR) ((LAS unsigned*)(lds + RING_BYTES))[u] = 0u;
    __syncthreads();
    const int lo = args.ph_lo, hi = args.ph_hi;
    int k256 = 256; asm volatile("" : "+s"(k256)); int k512 = 512; asm volatile("" : "+s"(k512)); int k1792 = EXD / 2; asm volatile("" : "+s"(k1792)); int k1408 = FFN / 2; asm volatile("" : "+s"(k1408));
    XcdBarrier bar; bar.bar = (unsigned*)(ctl + CW_BAR) + args.li * XCD_BAR_WORDS; bar.x = 0; bar.st = nullptr;
    if (hi - lo > 1) bar = xcd_barrier_post((unsigned*)(ctl + CW_BAR) + args.li * XCD_BAR_WORDS, MISC + 8);
#ifndef PH_MASK
#define PH_MASK 0x7fffff
#endif
#define IN(k) ((((PH_MASK) >> (k)) & 1) && lo <= (k) && (k) < hi)
#ifndef DUP_MASK
#define DUP_MASK 0
#endif
#define REPEAT(k) _Pragma("unroll") for (int rep_ = 0; rep_ < ((((DUP_MASK) >> (k)) & 1) ? 2 : 1); ++rep_)
#define SEAM(k) do { if (IN(k) && IN((k) + 1)) xcd_barrier(bar); } while (0)
    const float* x = args.in[0]; const float* p_in = args.in[1];
    bf16* hb = (bf16*)(ws + WS_HB);
    bf16* U0 = (bf16*)hout;

    if (IN(0)) REPEAT(0) {
        PHASE_IDS;
        int rot = 0;
        cvt_job<MAP_ID>(args.in[3], nullptr, nullptr, (bf16*)(ws + W_IN0), 1024, 2048, 2048, 1024, 1024, 0, scr, gw, NGW, rot, lane);
        cvt_job<MAP_ID>(args.in[6], nullptr, nullptr, (bf16*)(ws + W_OUT0), 512, 1024, 1024, 1024, 512, 0, scr, gw, NGW, rot, lane);
        cvt_fold(args.in[4], args.in[5], args.in[6], (bf16*)(ws + W_OUT0), scr, gw, NGW, rot, lane);
        cvt_job<MAP_IL>(args.in[8], args.in[9], args.in[7], (bf16*)(ws + W_FFNGU), 1024, FFN, 2 * FFN, 1024, 1024, 0, scr, gw, NGW, rot, lane);
        cvt_job<MAP_ID, true>(args.in[10], nullptr, nullptr, (bf16*)(ws + W_FFND), FFN, 1024, 1024, FFN, FFN, 0, scr, gw, NGW, rot, lane, FFN_WSC_DN);
        cvt_job<MAP_ID>(args.in[29], nullptr, args.in[28], (bf16*)(ws + W_PLEG0), 1024, 1024, 1024, 1024, 1024, 0, scr, gw, NGW, rot, lane);
        cvt_job<MAP_ID>(args.in[30], nullptr, nullptr, (bf16*)(ws + W_PLEP0), 256, 1024, 1024, 256, 256, 0, scr, gw, NGW, rot, lane);
        cvt_job<MAP_U1>(args.in[12], nullptr, args.in[11], (bf16*)(ws + W_IN1), 1024, 2472, U1W, 1024, 1024, 0, scr, gw, NGW, rot, lane);
        cvt_job<MAP_UQ>(args.in[18], nullptr, args.in[17], (bf16*)(ws + W_UQ), 256, 384, 512, 256, 256, 0, scr, gw, NGW, rot, lane);
        cvt_job<MAP_UKV>(args.in[20], nullptr, args.in[19], (bf16*)(ws + W_UKV), 128, 768, 768, 256, 256, 0, scr, gw, NGW, rot, lane);
        cvt_job<MAP_ID>(args.in[21], nullptr, nullptr, (bf16*)(ws + W_OUT1), 1024, 1024, 1024, 1024, 1024, 0, scr, gw, NGW, rot, lane);
        { const float* g0 = args.in[2]; bf16* xn0 = (bf16*)(ws + WS_XN0);
          for (int m = gw; m < M; m += NGW) { const f32x4* xr = (const f32x4*)(x + (size_t)m * D) + lane; f32x4 v[4]; float s = 0.f;
#pragma unroll
              for (int j = 0; j < 4; ++j) { v[j] = xr[64 * j]; s += (v[j][0] * v[j][0] + v[j][1] * v[j][1]) + (v[j][2] * v[j][2] + v[j][3] * v[j][3]); }
              const float rstd = rsqrtf(wave_sum(s) * (1.f / D) + EPS); v2u* o8 = (v2u*)(xn0 + (size_t)m * D) + lane;
#pragma unroll
              for (int j = 0; j < 4; ++j) { const f32x4 gg = ((const f32x4*)g0)[lane + 64 * j]; v2u w; w.x = pk2(v[j][0] * rstd * gg[0], v[j][1] * rstd * gg[1]); w.y = pk2(v[j][2] * rstd * gg[2], v[j][3] * rstd * gg[3]); o8[64 * j] = w; } } }
        cvt_flat(p_in, (bf16*)(ws + WS_PB0), (size_t)M * 64, gt, GT);
        if (DUP_MASK) { int* idn = (int*)(ws + T_IDENT); for (size_t i = gt; i < (size_t)M; i += GT) idn[i] = (int)i; }
        { float* rc = (float*)(ws + T_ROPEC); float* rsn = (float*)(ws + T_ROPES);
          for (size_t i = gt; i < (size_t)SEQ * 16; i += GT) { const int t = (int)(i >> 4), j = (int)(i & 15);
              const float invf = exp2f(-(float)j * (13.287712379549449f / 16.f)); const float ang = (float)t * invf;
              const double rev = (double)ang * 0.15915494309189533577; const float fr = (float)(rev - floor(rev));
              rc[i] = __builtin_amdgcn_cosf(fr); rsn[i] = __builtin_amdgcn_sinf(fr); } }
    }
    SEAM(0);
    if (IN(1)) REPEAT(1) {
        PHASE_IDS;
        { pg8::Gemm g{(const bf16*)(ws + WS_XN0), (const bf16*)(ws + W_IN0), M, U0W, 1024, 1024}; pg8::StaticOrder S; S.init(M, U0W, G, c);
          epi::Store E{U0, U0W, nullptr, 0.f}; pg8::gemm_phase<epi::Store, pg8::StaticOrder, true, true>(lds, g, S, E); }
        { pg8::Gemm g{(const bf16*)(ws + WS_PB0), (const bf16*)(ws + W_PLEP0), M, 1024, k256, 256}; pg8::StaticOrder S; S.init(M, 1024, G, c);
          epi::Store E{(bf16*)(ws + WS_P0G), 1024, nullptr, 0.f}; pg8::gemm_phase<epi::Store, pg8::StaticOrder, true, true>(lds, g, S, E); }
    }
    SEAM(1);
    if (IN(2)) REPEAT(2) {
        PHASE_IDS;
        float* kmean = (float*)(ws + T_KMEAN); bf16* mix0 = (bf16*)(ws + WS_MIX0);
        { LAS float* red = (LAS float*)lds;
          for (int u = c; u < NB * 32 * 2; u += G) { const int b = u >> 6, n = (u >> 1) & 31, half = u & 1, rg = tid >> 5, c8 = tid & 31;
              const bf16* kp = U0 + ((size_t)b * SEQ + n * 256 + rg * 16) * U0W + 512 + half * 256 + c8 * 8; float a[8];
#pragma unroll
              for (int q = 0; q < 8; ++q) a[q] = 0.f;
#pragma unroll
              for (int r = 0; r < 16; ++r) { const v4u w = *(const v4u*)(kp + (size_t)r * U0W); a[0] += bflo(w.x); a[1] += bfhi(w.x); a[2] += bflo(w.y); a[3] += bfhi(w.y); a[4] += bflo(w.z); a[5] += bfhi(w.z); a[6] += bflo(w.w); a[7] += bfhi(w.w); }
              __syncthreads();
#pragma unroll
              for (int q = 0; q < 8; ++q) red[rg * 256 + c8 * 8 + q] = a[q];
              __syncthreads();
              if (tid < 256) { float s = 0.f;
#pragma unroll
                  for (int g2 = 0; g2 < 16; ++g2) s += red[g2 * 256 + tid];
                  const int col = half * 256 + tid; kmean[((size_t)(b * 8 + (col >> 6)) * 32 + n) * 64 + (col & 63)] = s * (1.f / 256.f); } }
          __syncthreads(); }
        for (int rb = c; rb < M / 128; rb += G) { const int g = (wave + (wave >> 2)) & 3, w = 2 << g, c8 = g * 16 + (lane & 15); const size_t row0 = ((size_t)rb * 8 + (wave >> 2) * 4 + (lane >> 4)) * 16; const int t0 = (int)(row0 & (SEQ - 1));
            const bf16* up = U0 + row0 * U0W + 1536 + c8 * 8; float a[8];
#pragma unroll
            for (int j = 0; j < 8; ++j) a[j] = 0.f;
            if (t0 > 0) {
#pragma unroll 4
                for (int r = 1; r < w; ++r) { const v4u wv = *(const v4u*)(up - (size_t)r * U0W);
                    a[0] += bflo(wv.x); a[1] += bfhi(wv.x); a[2] += bflo(wv.y); a[3] += bfhi(wv.y); a[4] += bflo(wv.z); a[5] += bfhi(wv.z); a[6] += bflo(wv.w); a[7] += bfhi(wv.w); } }
#pragma unroll 4
            for (int o = 0; o < 16; ++o) { const int t = t0 + o; const v4u x0 = *(const v4u*)(up + (size_t)o * U0W);
                a[0] += bflo(x0.x); a[1] += bfhi(x0.x); a[2] += bflo(x0.y); a[3] += bfhi(x0.y); a[4] += bflo(x0.z); a[5] += bfhi(x0.z); a[6] += bflo(x0.w); a[7] += bfhi(x0.w);
                const int cnt = (t + 1 < w) ? t + 1 : w; const float ic = 1.f / (float)cnt; v4u ov;
                ov.x = pk2(a[0] * ic - bflo(x0.x), a[1] * ic - bfhi(x0.x)); ov.y = pk2(a[2] * ic - bflo(x0.y), a[3] * ic - bfhi(x0.y));
                ov.z = pk2(a[4] * ic - bflo(x0.z), a[5] * ic - bfhi(x0.z)); ov.w = pk2(a[6] * ic - bflo(x0.w), a[7] * ic - bfhi(x0.w));
                *(v4u*)(mix0 + (row0 + o) * D + 512 + c8 * 8) = ov;
                if (t + 1 >= w) { const v4u wv = *(const v4u*)(up + ((long)o - (w - 1)) * U0W);
                    a[0] -= bflo(wv.x); a[1] -= bfhi(wv.x); a[2] -= bflo(wv.y); a[3] -= bfhi(wv.y); a[4] -= bflo(wv.z); a[5] -= bfhi(wv.z); a[6] -= bflo(wv.w); a[7] -= bfhi(wv.w); } } }
    }
    SEAM(2);
    if (IN(3)) REPEAT(3) {
        PHASE_IDS;
        LAS float* km = (LAS float*)lds; const float* kmean = (const float*)(ws + T_KMEAN); int* lists = (int*)(ws + WS_LISTS); int* cntj = (int*)(ws + T_CNTJ);
        for (int u = c, it_ = 0; u < NB * 8 * 32; u += G, ++it_) { const int bh = u >> 5, j = ((u & 31) + 8 * it_) & 31, b = bh >> 3, h = bh & 7;
            __syncthreads();
            for (int i = tid; i < j * 64; i += NTHR) km[i] = kmean[(size_t)bh * 2048 + i];
            __syncthreads();
            int i0 = -1, i1 = -1, i2 = -1; float t0 = -3e38f, t1 = -3e38f, t2 = -3e38f;
            const int qi = tid & 255, hf = tid >> 8, jh = (j + 1) >> 1;
            if (j > 0) { float qf[64]; const v4u* qp = (const v4u*)(U0 + ((size_t)b * SEQ + j * 256 + qi) * U0W + h * 64);
#pragma unroll
                for (int i = 0; i < 8; ++i) { const v4u w = qp[i]; qf[8 * i] = bflo(w.x); qf[8 * i + 1] = bfhi(w.x); qf[8 * i + 2] = bflo(w.y); qf[8 * i + 3] = bfhi(w.y); qf[8 * i + 4] = bflo(w.z); qf[8 * i + 5] = bfhi(w.z); qf[8 * i + 6] = bflo(w.w); qf[8 * i + 7] = bfhi(w.w); }
#pragma unroll 1
                for (int n = hf ? jh : 0; n < (hf ? j : jh); ++n) { const LAS f32x4* kr = (const LAS f32x4*)(km + n * 64); float g = 0.f;
#pragma unroll
                    for (int i = 0; i < 16; ++i) { const f32x4 kv = kr[i]; g += qf[4 * i] * kv[0] + qf[4 * i + 1] * kv[1] + qf[4 * i + 2] * kv[2] + qf[4 * i + 3] * kv[3]; }
                    if (g > t0) { t2 = t1; i2 = i1; t1 = t0; i1 = i0; t0 = g; i0 = n; } else if (g > t1) { t2 = t1; i2 = i1; t1 = g; i1 = n; } else if (g > t2) { t2 = g; i2 = n; } } }
            { LAS float* exv = (LAS float*)(lds + 12288); LAS int* exi = (LAS int*)(lds + 12288 + 3072);
              if (hf) { exv[qi * 3] = t0; exv[qi * 3 + 1] = t1; exv[qi * 3 + 2] = t2; exi[qi * 3] = i0; exi[qi * 3 + 1] = i1; exi[qi * 3 + 2] = i2; }
              __syncthreads();
              if (!hf) {
#pragma unroll
                  for (int k = 0; k < 3; ++k) { const float g = exv[qi * 3 + k]; const int n = exi[qi * 3 + k];
                      if (n >= 0) { if (g > t0) { t2 = t1; i2 = i1; t1 = t0; i1 = i0; t0 = g; i0 = n; } else if (g > t1) { t2 = t1; i2 = i1; t1 = g; i1 = n; } else if (g > t2) { t2 = g; i2 = n; } } } }
              else { i0 = -1; i1 = -1; i2 = -1; } }
            LAS int* wc = (LAS int*)(lds + 8192);
            int r0 = 0, r1 = 0, r2 = 0; const unsigned long long lt = (1ull << lane) - 1ull;
            if (wave < 4) {
#pragma unroll 1
                for (int n = 0; n < j; ++n) { const bool m_ = (i0 == n) || (i1 == n) || (i2 == n); const unsigned long long bl = __ballot(m_); const int below = __popcll(bl & lt);
                    if (i0 == n) r0 = below; if (i1 == n) r1 = below; if (i2 == n) r2 = below; if (lane == 0) wc[n * 4 + wave] = __popcll(bl); } }
            __syncthreads();
            if (tid < 256 && j > 0) { const int me = j * 256 + tid;
                if (i0 >= 0) { int off = r0; for (int w = 0; w < wave; ++w) off += wc[i0 * 4 + w]; lists[((size_t)(bh * 32 + i0) * 32 + j) * 256 + off] = me; }
                if (i1 >= 0) { int off = r1; for (int w = 0; w < wave; ++w) off += wc[i1 * 4 + w]; lists[((size_t)(bh * 32 + i1) * 32 + j) * 256 + off] = me | (1 << 16); }
                if (i2 >= 0) { int off = r2; for (int w = 0; w < wave; ++w) off += wc[i2 * 4 + w]; lists[((size_t)(bh * 32 + i2) * 32 + j) * 256 + off] = me | (2 << 16); } }
            if (tid < j) cntj[(bh * 32 + tid) * 32 + j] = wc[tid * 4] + wc[tid * 4 + 1] + wc[tid * 4 + 2] + wc[tid * 4 + 3];
        }
        __syncthreads();
    }
    SEAM(3);
    if (IN(4)) REPEAT(4) {
        __syncthreads();
        moba_attn::sphase((char*)lds_raw, U0, (const int*)(ws + WS_LISTS), (const int*)(ws + T_CNTJ), (bf16*)(ws + WS_PO), (float*)(ws + WS_PM), G, c);
    }
    SEAM(4);
    if (IN(5)) REPEAT(5) {
        PHASE_IDS;
        const bf16* PO = (const bf16*)(ws + WS_PO); const float* PM = (const float*)(ws + WS_PM); bf16* mix0 = (bf16*)(ws + WS_MIX0);
        for (size_t i = gt; i < (size_t)M * 64; i += GT) { const size_t pair = i >> 3; const int ch = (int)(i & 7), h = (int)(pair & 7); const size_t token = pair >> 3; const int j = (int)(token & (SEQ - 1)) >> 8, nv = j < 3 ? j : 3;
            float mm[4], ll[4]; float mx = -3e38f;
#pragma unroll
            for (int s = 0; s < 4; ++s) { const bool ok = (s == 3) || (s < nv); mm[s] = ok ? PM[(pair * 4 + s) * 2] : -3e38f; ll[s] = ok ? PM[(pair * 4 + s) * 2 + 1] : 0.f; mx = fmaxf(mx, mm[s]); }
            float acc[8], den = 0.f;
#pragma unroll
            for (int d = 0; d < 8; ++d) acc[d] = 0.f;
#pragma unroll
            for (int s = 0; s < 4; ++s) { const bool ok = (s == 3) || (s < nv); if (ok) { const float a = ll[s] * exp2f(mm[s] - mx); den += a; const v4u w = *(const v4u*)(PO + (pair * 4 + s) * 64 + ch * 8);
                acc[0] += a * bflo(w.x); acc[1] += a * bfhi(w.x); acc[2] += a * bflo(w.y); acc[3] += a * bfhi(w.y); acc[4] += a * bflo(w.z); acc[5] += a * bfhi(w.z); acc[6] += a * bflo(w.w); acc[7] += a * bfhi(w.w); } }
            const float inv = 1.f / den; v4u o; o.x = pk2(acc[0] * inv, acc[1] * inv); o.y = pk2(acc[2] * inv, acc[3] * inv); o.z = pk2(acc[4] * inv, acc[5] * inv); o.w = pk2(acc[6] * inv, acc[7] * inv);
            *(v4u*)(mix0 + token * D + h * 64 + ch * 8) = o; }
    }
    SEAM(5);
    if (IN(6)) REPEAT(6) {
        PHASE_IDS;
        pg8::Gemm g{(const bf16*)(ws + WS_MIX0), (const bf16*)(ws + W_OUT0), M, 1024, 1024, 1024}; pg8::StaticOrder S; S.init(M, 1024, G, c);
        epi::Res<0, true, true> E{x, nullptr, hb, ssqb + SSQ_H1, nullptr, nullptr, nullptr, nullptr, 1.f, nullptr, (LAS float*)(lds + RING_BYTES + 4096)};
        pg8::gemm_phase<epi::Res<0, true, true>, pg8::StaticOrder, true, true>(lds, g, S, E);
    }
    SEAM(6);
    if (IN(7)) REPEAT(7) {
        PHASE_IDS;
        pg8::Gemm g{hb, (const bf16*)(ws + W_FFNGU), M, 2 * FFN, 1024, 1024}; pg8::StaticOrder S; S.init(M, 2 * FFN, G, c);
        epi::SwiGLU8<0> E{(unsigned char*)(ws + WS_HMID0), FFN, ssqb + SSQ_H1, 1.f, FFN_HSC};
        pg8::gemm_phase<epi::SwiGLU8<0>, pg8::StaticOrder, true, true>(lds, g, S, E);
    }
    SEAM(7);
    if (IN(8)) REPEAT(8) {
        PHASE_IDS;
        pg8::Gemm g{(const bf16*)(ws + WS_HMID0), (const bf16*)(ws + W_FFND), M, 1024, k1408, FFN / 2}; pg8::StaticOrder S; S.init(M, 1024, G, c);
        epi::Res<0, false, true> E{nullptr, hb, hb, ssqb + SSQ_H2, nullptr, nullptr, nullptr, nullptr, 1.f / (FFN_WSC_DN * FFN_HSC), nullptr, (LAS float*)(lds + RING_BYTES + 4096)};
        pg8::gemm_phase<epi::Res<0, false, true>, pg8::StaticOrder, true, true, true>(lds, g, S, E);
    }
    SEAM(8);
    if (IN(9)) REPEAT(9) {
        PHASE_IDS;
        pg8::Gemm g{hb, (const bf16*)(ws + W_PLEG0), M, 1024, 1024, 1024}; pg8::StaticOrder S; S.init(M, 1024, G, c);
        epi::Res<1, false, true> E{nullptr, hb, hb2, ssqb + SSQ_H3, ssqb + SSQ_H2, (const bf16*)(ws + WS_P0G), nullptr, nullptr, 1.f, nullptr, (LAS float*)(lds + RING_BYTES + 4096)};
        pg8::gemm_phase<epi::Res<1, false, true>, pg8::StaticOrder, true, true>(lds, g, S, E);
    }
    SEAM(9);
    bf16* u1 = (bf16*)(ws + WS_U1);
    if (IN(10)) REPEAT(10) {
        PHASE_IDS;
        pg8::Gemm g{hb2, (const bf16*)(ws + W_IN1), M, U1W, 1024, 1024}; pg8::StaticOrder S; S.init(M, U1W, G, c);
        epi::U1 E{u1, ssqb + SSQ_H3, ssqb + SSQ_CQ, ssqb + SSQ_CKV, (bf16*)(ws + WS_KM), (const float*)(ws + T_ROPEC), (const float*)(ws + T_ROPES)};
        pg8::gemm_phase<epi::U1, pg8::StaticOrder, true, true>(lds, g, S, E);
    }
    SEAM(10);
    bf16* mU = (bf16*)(ws + WS_MU); float* mN = (float*)(ws + WS_MN); float* mD = (float*)(ws + T_MD);
    bf16* Qm = (bf16*)(ws + WS_QM); bf16* Km = (bf16*)(ws + WS_KM); bf16* Vm = (bf16*)(ws + WS_VM);
    const float* ropec = (const float*)(ws + T_ROPEC); const float* ropes = (const float*)(ws + T_ROPES);
    if (IN(11)) REPEAT(11) {
        PHASE_IDS;
#ifdef MLSTM_A_NAIVE
        mlstm_a(lds, u1, args.in[13], args.in[14], args.in[15], mU, mN, mD, G, c);
#else
        mlm::stage_a2(lds, u1, args.in[13], args.in[14], args.in[15], mU, mN, mD, G, c);
#endif
        { pg8::Gemm g{u1 + 2048, (const bf16*)(ws + W_UQ), M, 512, k256, U1W}; pg8::StaticOrder S; S.init(M, 512, G, c);
          epi::MlaQ E{Qm, ssqb + SSQ_CQ, ropec, ropes}; pg8::gemm_phase<epi::MlaQ, pg8::StaticOrder, true, true>(lds, g, S, E); }
        { pg8::Gemm g{u1 + 2304, (const bf16*)(ws + W_UKV), M, 768, k256, U1W}; pg8::StaticOrder S; S.init(M, 768, G, c);
          epi::MlaKV E{Km, Vm, ssqb + SSQ_CKV}; pg8::gemm_phase<epi::MlaKV, pg8::StaticOrder, true, true>(lds, g, S, E); }
    }
    SEAM(11);
    bf16* mix1 = (bf16*)(ws + WS_MIX1);
    if (IN(12)) REPEAT(12) {
        PHASE_IDS;
        mlstm_b(mU, mN, mD, gt, GT);
#ifdef MLA_NAIVE
        attn_naive<96, 128, 4, 4, false>(lds, Qm, 512, 128, Km, 512, 128, Vm, 512, 128, mix1 + 512, D, 128, 4, 0.10206207261596575f, nullptr, G, c);
#else
        REPEAT(28) {
        __syncthreads();
        mla_attn::phase((char*)lds_raw, Qm, Km, Vm, mix1 + 512, G, c);
        }
#endif
    }
    SEAM(12);
#ifdef MLSTM_C_NAIVE
    if (IN(13)) mlstm_c(lds, u1, args.in[13], args.in[14], args.in[15], args.in[16], mU, mN, mix1, G, c);
#else
    if (IN(13)) mlm::stage_c2(lds, u1, args.in[13], args.in[14], args.in[15], args.in[16], mU, mN, mix1, G, c);
#endif
    SEAM(13);
    if (IN(14)) REPEAT(14) {
        PHASE_IDS;
        pg8::Gemm g{mix1, (const bf16*)(ws + W_OUT1), M, 1024, 1024, 1024}; pg8::StaticOrder S; S.init(M, 1024, G, c);
        epi::Res<0, false, false> E{nullptr, hb2, hb2, nullptr, nullptr, nullptr, nullptr, nullptr, 1.f, nullptr};
        pg8::gemm_phase<epi::Res<0, false, false>, pg8::StaticOrder, true, true>(lds, g, S, E);
    }
    SEAM(14);
    float* rstd4 = (float*)(ws + T_RSTD4); int* tok_e = (int*)(ws + T_TOKE); int* tok_p = (int*)(ws + T_TOKP); float* tok_w = (float*)(ws + T_TOKW);
    if (IN(15)) REPEAT(15) {
        PHASE_IDS;
        { LAS float* gW = (LAS float*)lds; const float* g4 = args.in[22]; const float* rw = args.in[23]; const float* rb = args.in[24];
          for (int i = tid; i < 8192; i += NTHR) gW[i] = g4[i >> 3] * rw[i];
          __syncthreads();
          for (int m = gw; m < M; m += NGW) { const v2u* hr = (const v2u*)(hb2 + (size_t)m * D) + lane; float lg[8]; float s = 0.f;
#pragma unroll
              for (int e = 0; e < 8; ++e) lg[e] = 0.f;
#pragma unroll
              for (int j = 0; j < 4; ++j) { const v2u hw = hr[64 * j]; const f32x4 v = (f32x4){bflo(hw.x), bfhi(hw.x), bflo(hw.y), bfhi(hw.y)}; s += (v[0] * v[0] + v[1] * v[1]) + (v[2] * v[2] + v[3] * v[3]);
#pragma unroll
                  for (int q = 0; q < 4; ++q) { const LAS f32x4* wp = (const LAS f32x4*)(gW + (size_t)(4 * (lane + 64 * j) + q) * 8); const f32x4 w0 = wp[0], w1 = wp[1];
                      lg[0] += v[q] * w0[0]; lg[1] += v[q] * w0[1]; lg[2] += v[q] * w0[2]; lg[3] += v[q] * w0[3]; lg[4] += v[q] * w1[0]; lg[5] += v[q] * w1[1]; lg[6] += v[q] * w1[2]; lg[7] += v[q] * w1[3]; } }
              const float rstd = rsqrtf(wave_sum(s) * (1.f / D) + EPS);
#pragma unroll
              for (int e = 0; e < 8; ++e) lg[e] = wave_sum(lg[e]) * rstd + rb[e];
              float v1 = -3e38f, v2 = -3e38f; int e1 = 0, e2 = 0;
#pragma unroll
              for (int e = 0; e < 8; ++e) { const float xv = lg[e]; if (xv > v1) { v2 = v1; e2 = e1; v1 = xv; e1 = e; } else if (xv > v2) { v2 = xv; e2 = e; } }
              if (lane == 0) { const float w1 = 1.f / (1.f + __expf(v2 - v1));
                  const int p1 = (int)__hip_atomic_fetch_add(ctl + CW_CNT + e1 * 64, 1u, RLX_AGENT), p2 = (int)__hip_atomic_fetch_add(ctl + CW_CNT + (8 + e2) * 64, 1u, RLX_AGENT);
                  rstd4[m] = rstd; tok_e[2 * m] = e1; tok_e[2 * m + 1] = e2; tok_p[2 * m] = p1; tok_p[2 * m + 1] = p2; tok_w[2 * m] = w1; tok_w[2 * m + 1] = 1.f - w1; } }
          __syncthreads(); }
        REPEAT(27) {
        int rot = 0;
        for (int e = 0; e < NEXP; ++e)
            cvt_pipe<MAP_IL, true>(args.in[25] + (size_t)e * 1024 * EXD, args.in[26] + (size_t)e * 1024 * EXD, args.in[22], (bf16*)(ws + W_MOEGU + (size_t)e * 2 * EXD * 1024), EXD, 2 * EXD, 1024, 1024, 0, scr, gw, NGW, rot, lane, MOE_WSC_UP);
        for (int e = 0; e < NEXP; ++e)
            cvt_pipe<MAP_ID, true>(args.in[27] + (size_t)e * EXD * 1024, nullptr, nullptr, (bf16*)(ws + W_MOED + (size_t)e * 1024 * EXD), 1024, 1024, EXD, EXD, 0, scr, gw, NGW, rot, lane, MOE_WSC_DN);
        cvt_job<MAP_ID>(args.in[29] + (size_t)1024 * 1024, nullptr, args.in[28] + 1024, (bf16*)(ws + W_PLEG1), 1024, 1024, 1024, 1024, 1024, 0, scr, gw, NGW, rot, lane);
        cvt_job<MAP_ID>(args.in[30] + (size_t)256 * 1024, nullptr, nullptr, (bf16*)(ws + W_PLEP1), 256, 1024, 1024, 256, 256, 0, scr, gw, NGW, rot, lane);
        cvt_flat(p_in + (size_t)M * 256, (bf16*)(ws + WS_PB1), (size_t)M * 64, gt, GT);
        }
    }
    SEAM(15);
    int* slot_t = (int*)(ws + T_SLOTT); float* slot_w = (float*)(ws + T_SLOTW); float* slot_r = (float*)(ws + T_SLOTR); int* tile_e = (int*)(ws + T_TILEE);
    bf16* xg = (bf16*)(ws + WS_XG); bf16* hmidg = (bf16*)(ws + WS_HMIDG);
    if (IN(16)) REPEAT(16) {
        PHASE_IDS; LAS int* sb = (LAS int*)lds;
        __syncthreads();
        if (tid < 2) { int bs = 0; for (int e = 0; e < 8; ++e) { const int cn = (int)__hip_atomic_load(ctl + CW_CNT + (tid * 8 + e) * 64, RLX_AGENT); sb[32 * tid + e] = bs; sb[32 * tid + 16 + e] = cn; bs += (cn + 255) & ~255; } sb[32 * tid + 8] = bs; }
        __syncthreads();
        if (c == 0) { const int nt0 = sb[8] >> 8, nt1 = sb[40] >> 8;
            for (int T = tid; T < nt0 + nt1; T += NTHR) { const int kk = T < nt0 ? 0 : 1, Tl = T - kk * nt0; int e = 0; for (int q = 1; q < 8; ++q) if (Tl * 256 >= sb[32 * kk + q]) e = q;
                tile_e[kk * 256 + Tl] = e; tile_e[512 + T] = (kk * (SLOTCAP / 256) + Tl) | (e << 16); }
            if (tid == 0) { tile_e[255] = nt0; tile_e[256 + 255] = nt1; tile_e[512 + 300] = nt0 + nt1; } }
        for (size_t i = gt; i < 4096; i += GT) { const int kk = (int)(i >> 11), e = (int)(i >> 8) & 7, off = (int)(i & 255); const int cn = sb[32 * kk + 16 + e]; if (cn + off < ((cn + 255) & ~255)) slot_t[kk * SLOTCAP + sb[32 * kk + e] + cn + off] = -1; }
#pragma unroll 2
        for (int m = gw; m < M; m += NGW) {
            const v4u* src = (const v4u*)(hb2 + (size_t)m * D) + 2 * lane; const v4u s0 = src[0], s1 = src[1]; const float rs = rstd4[m]; int w0 = 0, w1 = 0, w2 = 0, w3 = 0;
            w0 = __builtin_amdgcn_cvt_pk_fp8_f32(bflo(s0.x) * rs, bfhi(s0.x) * rs, w0, false); w0 = __builtin_amdgcn_cvt_pk_fp8_f32(bflo(s0.y) * rs, bfhi(s0.y) * rs, w0, true); w1 = __builtin_amdgcn_cvt_pk_fp8_f32(bflo(s0.z) * rs, bfhi(s0.z) * rs, w1, false); w1 = __builtin_amdgcn_cvt_pk_fp8_f32(bflo(s0.w) * rs, bfhi(s0.w) * rs, w1, true);
            w2 = __builtin_amdgcn_cvt_pk_fp8_f32(bflo(s1.x) * rs, bfhi(s1.x) * rs, w2, false); w2 = __builtin_amdgcn_cvt_pk_fp8_f32(bflo(s1.y) * rs, bfhi(s1.y) * rs, w2, true); w3 = __builtin_amdgcn_cvt_pk_fp8_f32(bflo(s1.z) * rs, bfhi(s1.z) * rs, w3, false); w3 = __builtin_amdgcn_cvt_pk_fp8_f32(bflo(s1.w) * rs, bfhi(s1.w) * rs, w3, true);
            const v4u row8 = (v4u){(unsigned)w0, (unsigned)w1, (unsigned)w2, (unsigned)w3};
#pragma unroll
            for (int kk = 0; kk < 2; ++kk) { const int slot = kk * SLOTCAP + sb[32 * kk + tok_e[2 * m + kk]] + tok_p[2 * m + kk];
                ((v4u*)((unsigned char*)xg + (size_t)slot * D))[lane] = row8;
                if (lane == 0) { slot_t[slot] = m; slot_w[slot] = tok_w[2 * m + kk]; } } }
        __syncthreads();
    }
    SEAM(16);
    if (IN(17)) REPEAT(17) {
        const int nt0_ = tile_e[255], nt1_ = tile_e[256 + 255]; LightDeal d0; d0.init(nt0_, G, c); int nlt = (G == 256 && nt0_ > 128) ? (3 * d0.nl) / 28 : 0; if (nlt > nt1_) nlt = nt1_;
        pg8::Gemm g{xg, (const bf16*)(ws + W_MOEGU), 2 * SLOTCAP, 2 * EXD, k512, 512}; MoeOrderC S; S.init(tile_e + 512, nt0_ + nt1_ - nlt, 2 * EXD / 256, G, c);
        epi::SwiGLU8<2> E{(unsigned char*)hmidg, EXD, nullptr, 1.f / MOE_WSC_UP, MOE_HSC}; pg8::gemm_phase<epi::SwiGLU8<2>, MoeOrderC, true, true, true>(lds, g, S, E);
    }
    SEAM(17);
    if (IN(18)) {
        pg8::Gemm g{hmidg, (const bf16*)(ws + W_MOED), SLOTCAP, 1024, k1792, EXD / 2}; MoeOrder S; S.init(tile_e, tile_e[255], 4, G, c);
        epi::Res<2, false, false> E{nullptr, hb2, hb, nullptr, nullptr, nullptr, slot_t, slot_w, 1.f / (MOE_WSC_DN * MOE_HSC), nullptr};
        pg8::gemm_phase<epi::Res<2, false, false>, MoeOrder, true, true, true>(lds, g, S, E);
        { const int nt0_ = tile_e[255], nt1_ = tile_e[256 + 255]; LightDeal d0; d0.init(nt0_, G, c); int nlt = (G == 256 && nt0_ > 128) ? (3 * d0.nl) / 28 : 0; if (nlt > nt1_) nlt = nt1_;
          pg8::Gemm gu{xg, (const bf16*)(ws + W_MOEGU), 2 * SLOTCAP, 2 * EXD, k512, 512}; LeftOrder L; L.init(tile_e + 512 + nt0_ + nt1_ - nlt, nlt, 2 * EXD / 256, d0);
          epi::SwiGLU8<2> Eu{(unsigned char*)hmidg, EXD, nullptr, 1.f / MOE_WSC_UP, MOE_HSC}; pg8::gemm_phase<epi::SwiGLU8<2>, LeftOrder, true, true, true>(lds, gu, L, Eu); }
    }
    SEAM(18);
    if (IN(19)) {
        { pg8::Gemm g{(const bf16*)((const unsigned char*)hmidg + (size_t)SLOTCAP * EXD), (const bf16*)(ws + W_MOED), SLOTCAP, 1024, k1792, EXD / 2}; MoeOrder S; S.init(tile_e + 256, tile_e[256 + 255], 4, G, c);
          epi::Res<2, false, true> E{nullptr, hb, hb2, ssqb + SSQ_H5, nullptr, nullptr, slot_t + SLOTCAP, slot_w + SLOTCAP, 1.f / (MOE_WSC_DN * MOE_HSC), nullptr, (LAS float*)(lds + RING_BYTES + 4096)};
          pg8::gemm_phase<epi::Res<2, false, true>, MoeOrder, true, true, true>(lds, g, S, E); }
        { LightDeal d1; d1.init(tile_e[256 + 255], G, c);
          pg8::Gemm g{(const bf16*)(ws + WS_PB1), (const bf16*)(ws + W_PLEP1), M, 1024, k256, 256}; LightStatic S; S.init(M, 1024, d1);
          epi::Store E{(bf16*)(ws + WS_P1G), 1024, nullptr, 0.f}; pg8::gemm_phase<epi::Store, LightStatic, true, true>(lds, g, S, E); }
    }
    SEAM(19);
    if (IN(20)) REPEAT(20) {
        PHASE_IDS;
        pg8::Gemm g{hb2, (const bf16*)(ws + W_PLEG1), M, 1024, 1024, 1024}; pg8::StaticOrder S; S.init(M, 1024, G, c);
        epi::Res<1, false, false> E{nullptr, hb2, hb, nullptr, ssqb + SSQ_H5, (const bf16*)(ws + WS_P1G), nullptr, nullptr, 1.f, nullptr};
        pg8::gemm_phase<epi::Res<1, false, false>, pg8::StaticOrder, true, true>(lds, g, S, E);
    }
    SEAM(20);
    if (IN(21)) REPEAT(21) {
        PHASE_IDS;
        const float* gf = args.in[31];
        for (int m = gw; m < M; m += NGW) { const v2u* hr = (const v2u*)(hb + (size_t)m * D) + lane; f32x4* orw = (f32x4*)(hout + (size_t)m * D) + lane; f32x4 v[4]; float s = 0.f;
#pragma unroll
            for (int j = 0; j < 4; ++j) { const v2u hw = hr[64 * j]; v[j] = (f32x4){bflo(hw.x), bfhi(hw.x), bflo(hw.y), bfhi(hw.y)}; s += (v[j][0] * v[j][0] + v[j][1] * v[j][1]) + (v[j][2] * v[j][2] + v[j][3] * v[j][3]); }
            const float rstd = rsqrtf(wave_sum(s) * (1.f / D) + EPS);
#pragma unroll
            for (int j = 0; j < 4; ++j) { const f32x4 gg = ((const f32x4*)gf)[lane + 64 * j]; orw[64 * j] = v[j] * rstd * gg; } }
    }
#undef IN
#undef SEAM
}

#ifndef N_CUTS
#define N_CUTS 1
#endif
extern "C" void kernel_launch(void* const* d_in, const int* in_sizes, int n_in, void* d_out, int out_size, void* d_ws, size_t ws_size, hipStream_t stream) {
    static int grid = 0;
    if (grid == 0) {
        if (n_in != 32 || in_sizes[0] != M * D || out_size != M * D || ws_size < WS_END) { fprintf(stderr, "kernel_launch: unexpected problem shape (n_in %d, in0 %d, out %d, ws %zu); nothing launched\n", n_in, n_in > 0 ? in_sizes[0] : -1, out_size, ws_size); grid = -1; return; }
        int dev = 0, cus = 0, per_cu = 0;
        if (hipGetDevice(&dev) != hipSuccess || hipDeviceGetAttribute(&cus, hipDeviceAttributeMultiprocessorCount, dev) != hipSuccess) { grid = -1; return; }
        if (hipFuncSetAttribute((const void*)fwd_kernel, hipFuncAttributeMaxDynamicSharedMemorySize, LDS_BYTES) != hipSuccess) { fprintf(stderr, "kernel_launch: hipFuncSetAttribute failed\n"); grid = -1; return; }
        if (hipOccupancyMaxActiveBlocksPerMultiprocessor(&per_cu, (const void*)fwd_kernel, NTHR, LDS_BYTES) != hipSuccess || per_cu < 1) fprintf(stderr, "kernel_launch: occupancy query reports %d\n", per_cu);
        (void)hipGetLastError();
        grid = cus;
    }
    if (grid < 0) return;
    if (hipMemsetAsync((char*)d_ws + WS_CTL, 0, CTL_ZERO_BYTES, stream) != hipSuccess) return;
    Args a{};
    for (int i = 0; i < 32; ++i) a.in[i] = (const float*)d_in[i];
    a.out = (float*)d_out; a.ws = (unsigned char*)d_ws;
    for (int li = 0; li < N_CUTS; ++li) {
        a.ph_lo = (int)((long)NPHASE * li / N_CUTS); a.ph_hi = (int)((long)NPHASE * (li + 1) / N_CUTS); a.li = li < 8 ? li : 0; a.pad = 0;
        hipLaunchKernelGGL(fwd_kernel, dim3(grid), dim3(NTHR), LDS_BYTES, stream, a);
    }
}
```

```cpp
#include <hip/hip_runtime.h>
#include <cstdio>
#include <cstdint>
typedef float f32x2_cv __attribute__((ext_vector_type(2))); typedef __bf16 bf16x2_cv __attribute__((ext_vector_type(2)));
__device__ __forceinline__ unsigned cvt2(float lo, float hi) { f32x2_cv v = {lo, hi}; bf16x2_cv b = __builtin_convertvector(v, bf16x2_cv); return __builtin_bit_cast(unsigned, b); }
__device__ __forceinline__ int tid_fresh() { int t = threadIdx.x; asm volatile("" : "+v"(t)); return t; }

namespace pg8 {
#define PG8_LAS __attribute__((address_space(3)))
typedef unsigned short bf16_t;
typedef short bf16x8 __attribute__((ext_vector_type(8)));
typedef float f32x4 __attribute__((ext_vector_type(4)));
typedef unsigned u32x4 __attribute__((ext_vector_type(4)));
typedef unsigned u32x2 __attribute__((ext_vector_type(2)));
typedef int v4i_t __attribute__((ext_vector_type(4)));
constexpr int BM = 256, BK = 64, HALF = 128, HTB = HALF * BK * 2  , STAGE_BYTES = 8 * HTB, NXCD = 8, WGM = 8;

__host__ __device__ __forceinline__ int lds_byte(int r, int c) { const int st = (r >> 4) * 2 + (c >> 5), rr = r & 15, cc = c & 31, ob = rr * 64 + cc * 2; return st * 1024 + (ob ^ (((ob >> 9) & 1) << 5)); }
__host__ __device__ __forceinline__ void stage_rc(int b, int& R, int& C) { const int st = b / 1024, sb = b % 1024, swz = sb ^ (((sb >> 9) & 1) << 5); R = (st >> 1) * 16 + swz / 64; C = (st & 1) * 32 + (swz % 64) / 2; }
__host__ __device__ __forceinline__ int perm32(int rho) { const int n = rho >> 4, i = rho & 15; return 8 * (i >> 2) + 4 * n + (i & 3); }

struct Unit { int pm, pn, pb; };
struct Gemm { const bf16_t* A; const bf16_t* Bt; int M, N, K, lda; };

struct StaticOrder {
    int nM, nN, nwg, G, c;
    __host__ __device__ void init(int M, int N, int G_, int c_) { nM = M / BM; nN = N / BM; nwg = nM * nN; G = G_; c = c_; }
    __host__ __device__ bool next(int i, Unit& u) const {
        const long L = (long)i * G + c; if (L >= nwg) return false;
        int wgid = (int)L; { const int q = nwg / NXCD, r = nwg % NXCD, xcd = wgid % NXCD, off = wgid / NXCD; wgid = (xcd < r ? xcd * (q + 1) : r * (q + 1) + (xcd - r) * q) + off; }
        const int nig = WGM * nN, gid = wgid / nig, fm = gid * WGM, gsz = (nM - fm) < WGM ? (nM - fm) : WGM;
        u.pm = fm + ((wgid % nig) % gsz); u.pn = (wgid % nig) / gsz; u.pb = u.pn; return true;
    }
    __device__ __forceinline__ void a_ready(const Unit&) const {}
    __device__ __forceinline__ void done(const Unit&) const {}
};

__device__ __forceinline__ unsigned cvt_pk_bf16(float lo, float hi) { return cvt2(lo, hi); }

template <class Epi, class Sched, bool ALIGN_EPI = false, bool SP2 = false, bool FP8 = false>
__device__ __forceinline__ void gemm_phase(PG8_LAS unsigned char* lds, const Gemm g, const Sched& S, const Epi& E) {
    const int tid = tid_fresh(), wid = __builtin_amdgcn_readfirstlane(tid >> 6), lane = tid & 63, wr = wid >> 2, wc = wid & 3, fr = lane & 15, fq = lane >> 4;
    const int K = g.K, nt = K / BK;
    unsigned voffA[2], voffB[2];
#pragma unroll
    for (int i = 0; i < 2; ++i) { int R, C; stage_rc(tid * 16 + i * 8192, R, C); const int Rb = Epi::PERM ? ((R & ~31) + perm32(R & 31)) : R;
        voffA[i] = (unsigned)(R * g.lda + C) * 2u; voffB[i] = (unsigned)(Rb * K + C) * 2u; }
    const size_t kstep = (size_t)(BK * 2);
    const size_t hstepA = (size_t)HALF * g.lda * 2, hstepB = (size_t)HALF * K * 2;
    const size_t tstepA = 2 * hstepA, tstepB = 2 * hstepB;
    const unsigned ldsw = (unsigned)wid * 1024u;
    const int aoff = lds_byte(wr * 64 + fr, fq * 8), boff = lds_byte(wc * 32 + fr, fq * 8);
#define PG8_SA(b, h) (((b) * 2 + (h)) * HTB)
#define PG8_SB(b, h) ((4 + (b) * 2 + (h)) * HTB)
#define PG8_STAGE(bufoff, gbase, voff) do { _Pragma("unroll") for (int _i = 0; _i < 2; ++_i) \
        __builtin_amdgcn_global_load_lds((const unsigned*)((const char*)(gbase) + (voff)[_i]), (PG8_LAS unsigned*)(lds + (bufoff) + ldsw + _i * 8192), 16, 0, 0); } while (0)
#define PG8_LDA(dst, b, h) do { _Pragma("unroll") for (int m = 0; m < 4; ++m) _Pragma("unroll") for (int k = 0; k < 2; ++k) dst[m][k] = *(const PG8_LAS bf16x8*)(lds + PG8_SA(b, h) + aoff + m * 2048 + k * 1024); } while (0)
#define PG8_LDB(dst, b, h) do { _Pragma("unroll") for (int n = 0; n < 2; ++n) _Pragma("unroll") for (int k = 0; k < 2; ++k) dst[n][k] = *(const PG8_LAS bf16x8*)(lds + PG8_SB(b, h) + boff + n * 2048 + k * 1024); } while (0)
#define PG8_V8(x) __builtin_shufflevector(__builtin_bit_cast(v4i_t, (x)[0]), __builtin_bit_cast(v4i_t, (x)[1]), 0, 1, 2, 3, 4, 5, 6, 7)
#define PG8_MMA(ai, bj, At, Bt) do { __builtin_amdgcn_s_setprio(1); _Pragma("unroll") for (int m = 0; m < 4; ++m) _Pragma("unroll") for (int n = 0; n < 2; ++n) { \
        if constexpr (FP8) asm volatile("v_mfma_scale_f32_16x16x128_f8f6f4 %0, %1, %2, %0, %3, %3 op_sel_hi:[0,0,0]" : "+v"(acc[ai][bj][m][n]) : "v"(PG8_V8(Bt[n])), "v"(PG8_V8(At[m])), "v"(0x7f7f7f7f));     \
        else { _Pragma("unroll") for (int k = 0; k < 2; ++k) acc[ai][bj][m][n] = __builtin_amdgcn_mfma_f32_16x16x32_bf16(Bt[n][k], At[m][k], acc[ai][bj][m][n], 0, 0, 0); } } \
        __builtin_amdgcn_s_setprio(0); } while (0)
#define PG8_WAIT_V(n) asm volatile("s_waitcnt vmcnt(" #n ")" ::: "memory")
#define PG8_WAIT_L(n) asm volatile("s_waitcnt lgkmcnt(" #n ")" ::: "memory")
#define PG8_BAR __builtin_amdgcn_s_barrier()
#define PG8_SCHED __builtin_amdgcn_sched_barrier(0)
    Unit cur, nxt; int ui = 0;
    if (!S.next(0, cur)) return;
    f32x4 acc[2][2][4][2];
#pragma unroll
    for (int a = 0; a < 2; ++a)
#pragma unroll
        for (int b = 0; b < 2; ++b)
#pragma unroll
            for (int m = 0; m < 4; ++m)
#pragma unroll
                for (int n = 0; n < 2; ++n) acc[a][b][m][n] = (f32x4){0.f, 0.f, 0.f, 0.f};
    bf16x8 At[4][2], B0[2][2], B1[2][2];
    const char* cA = (const char*)g.A + (size_t)cur.pm * tstepA; const char* cB = (const char*)g.Bt + (size_t)cur.pb * tstepB;
    S.a_ready(cur);
    if constexpr (SP2) {
        PG8_STAGE(PG8_SB(0, 0), cB, voffB); PG8_STAGE(PG8_SB(0, 1), cB + hstepB, voffB); PG8_STAGE(PG8_SA(0, 0), cA, voffA); PG8_STAGE(PG8_SA(0, 1), cA + hstepA, voffA);
        if (wr == 1) PG8_BAR;
        PG8_WAIT_V(2); PG8_BAR;
        PG8_STAGE(PG8_SB(1, 0), cB + kstep, voffB); PG8_STAGE(PG8_SA(1, 0), cA + kstep, voffA); PG8_STAGE(PG8_SB(1, 1), cB + hstepB + kstep, voffB);
        PG8_WAIT_V(6); PG8_BAR;
    } else {
        PG8_STAGE(PG8_SB(0, 0), cB, voffB); PG8_STAGE(PG8_SA(0, 0), cA, voffA); PG8_STAGE(PG8_SB(0, 1), cB + hstepB, voffB); PG8_STAGE(PG8_SA(0, 1), cA + hstepA, voffA);
        if (wr == 1) PG8_BAR;
        PG8_WAIT_V(4); PG8_BAR;
        PG8_STAGE(PG8_SB(1, 0), cB + kstep, voffB); PG8_STAGE(PG8_SA(1, 0), cA + kstep, voffA); PG8_STAGE(PG8_SB(1, 1), cB + hstepB + kstep, voffB);
        PG8_WAIT_V(6); PG8_BAR;
    }
    for (;;) {
        const bool has_next = S.next(ui + 1, nxt);
        const char* nA = has_next ? (const char*)g.A + (size_t)nxt.pm * tstepA : cA; const char* nB = has_next ? (const char*)g.Bt + (size_t)nxt.pb * tstepB : cB;
        for (int t = 0; t < nt; t += 2) {
            const bool last = (t == nt - 2);
            const char* a1 = cA + (size_t)(t + 1) * kstep;
            const char* a2 = last ? nA : cA + (size_t)(t + 2) * kstep; const char* b2 = last ? nB : cB + (size_t)(t + 2) * kstep;
            const char* a3 = a2 + kstep; const char* b3 = b2 + kstep;
            if (last && has_next) S.a_ready(nxt);
            if constexpr (SP2) {
            PG8_LDB(B0, 0, 0); PG8_LDB(B1, 0, 1); PG8_SCHED; PG8_LDA(At, 0, 0); PG8_STAGE(PG8_SA(1, 1), a1 + hstepA, voffA);
            PG8_WAIT_V(8); PG8_WAIT_L(0); PG8_BAR; PG8_MMA(0, 0, At, B0); PG8_MMA(0, 1, At, B1); PG8_BAR; PG8_SCHED;
            PG8_LDA(At, 0, 1); PG8_STAGE(PG8_SB(0, 0), b2, voffB); PG8_STAGE(PG8_SB(0, 1), b2 + hstepB, voffB); PG8_STAGE(PG8_SA(0, 0), a2, voffA);
            PG8_WAIT_V(8); PG8_WAIT_L(0); PG8_BAR; PG8_MMA(1, 0, At, B0); PG8_MMA(1, 1, At, B1); PG8_BAR; PG8_SCHED;
            PG8_LDB(B0, 1, 0); PG8_LDB(B1, 1, 1); PG8_SCHED; PG8_LDA(At, 1, 0); PG8_STAGE(PG8_SA(0, 1), a2 + hstepA, voffA);
            PG8_WAIT_V(8); PG8_WAIT_L(0); PG8_BAR; PG8_MMA(0, 0, At, B0); PG8_MMA(0, 1, At, B1); PG8_BAR; PG8_SCHED;
            PG8_LDA(At, 1, 1); PG8_STAGE(PG8_SB(1, 0), b3, voffB); PG8_STAGE(PG8_SB(1, 1), b3 + hstepB, voffB); PG8_STAGE(PG8_SA(1, 0), a3, voffA);
            PG8_WAIT_V(8); PG8_WAIT_L(0); PG8_BAR; PG8_MMA(1, 0, At, B0); PG8_MMA(1, 1, At, B1); PG8_BAR; PG8_SCHED;
            } else {
            PG8_LDB(B0, 0, 0); PG8_SCHED; PG8_LDA(At, 0, 0); PG8_STAGE(PG8_SA(1, 1), a1 + hstepA, voffA);
            PG8_WAIT_L(8); PG8_BAR; PG8_WAIT_L(0); PG8_MMA(0, 0, At, B0); PG8_BAR; PG8_SCHED;
            PG8_LDB(B1, 0, 1); PG8_STAGE(PG8_SB(0, 0), b2, voffB);
            PG8_BAR; PG8_WAIT_L(0); PG8_MMA(0, 1, At, B1); PG8_BAR;
            PG8_LDA(At, 0, 1); PG8_STAGE(PG8_SA(0, 0), a2, voffA);
            PG8_BAR; PG8_WAIT_L(0); PG8_MMA(1, 0, At, B0); PG8_BAR; PG8_SCHED;
            PG8_STAGE(PG8_SB(0, 1), b2 + hstepB, voffB);
            PG8_WAIT_V(6); PG8_BAR; PG8_MMA(1, 1, At, B1); PG8_BAR;
            PG8_LDB(B0, 1, 0); PG8_SCHED; PG8_LDA(At, 1, 0); PG8_STAGE(PG8_SA(0, 1), a2 + hstepA, voffA);
            PG8_WAIT_L(8); PG8_BAR; PG8_WAIT_L(0); PG8_MMA(0, 0, At, B0); PG8_BAR; PG8_SCHED;
            PG8_LDB(B1, 1, 1); PG8_STAGE(PG8_SB(1, 0), b3, voffB);
            PG8_BAR; PG8_WAIT_L(0); PG8_MMA(0, 1, At, B1); PG8_BAR;
            PG8_LDA(At, 1, 1); PG8_STAGE(PG8_SA(1, 0), a3, voffA);
            PG8_BAR; PG8_WAIT_L(0); PG8_MMA(1, 0, At, B0); PG8_BAR; PG8_SCHED;
            PG8_STAGE(PG8_SB(1, 1), b3 + hstepB, voffB);
            PG8_WAIT_V(6); PG8_BAR; PG8_MMA(1, 1, At, B1); PG8_BAR;
            }
        }
        if constexpr (ALIGN_EPI) { if (wr == 0) PG8_BAR; }
        if constexpr (FP8) { __builtin_amdgcn_sched_barrier(0); asm volatile("s_nop 15\n\ts_nop 15" ::: "memory"); __builtin_amdgcn_sched_barrier(0); }
        if constexpr (!Epi::AFTER_DRAIN) { E(acc, cur, wr, wc, fr, fq); S.done(cur); }
        if (!has_next) break;
#pragma unroll
        for (int a = 0; a < 2; ++a)
#pragma unroll
            for (int b = 0; b < 2; ++b)
#pragma unroll
                for (int m = 0; m < 4; ++m)
#pragma unroll
                    for (int n = 0; n < 2; ++n) acc[a][b][m][n] = (f32x4){0.f, 0.f, 0.f, 0.f};
        cur = nxt; cA = nA; cB = nB; ++ui;
        if constexpr (ALIGN_EPI) { if (wr == 1) PG8_BAR; }
    }
    PG8_WAIT_V(0);
    if constexpr (!ALIGN_EPI) { if (wr == 0) PG8_BAR; }
    PG8_BAR;
    if constexpr (Epi::AFTER_DRAIN) { E.fused(acc, cur, wr, wc, fr, fq, lds, wid, lane); S.done(cur); }
#undef PG8_SA
#undef PG8_SB
#undef PG8_STAGE
#undef PG8_LDA
#undef PG8_LDB
#undef PG8_MMA
#undef PG8_V8
#undef PG8_WAIT_V
#undef PG8_WAIT_L
#undef PG8_BAR
#undef PG8_SCHED
}
}

#define GAS __attribute__((address_space(1)))
#define LAS __attribute__((address_space(3)))
typedef unsigned short bf16;
typedef unsigned v4u __attribute__((ext_vector_type(4)));
typedef unsigned v2u __attribute__((ext_vector_type(2)));
typedef float f32x4 __attribute__((ext_vector_type(4)));
typedef GAS unsigned gu32;
#define RLX_AGENT __ATOMIC_RELAXED, __HIP_MEMORY_SCOPE_AGENT

#define XB_TMO      128
#define XB_XCNT(j)  (256  + 64 * (j))
#define XB_XSUB(j)  (1280 + 64 * (j))
#define XB_XGEN(j)  (2304 + 64 * (j))
#define XB_TOP      3328
#define XB_TOPGEN   3392
#define XCD_BAR_WORDS 3456
#define XB_SPIN_CAP (1u << 18)

__device__ __forceinline__ unsigned xb_ld(unsigned* p)              { return __hip_atomic_load(p, __ATOMIC_RELAXED, __HIP_MEMORY_SCOPE_AGENT); }
__device__ __forceinline__ unsigned xb_add(unsigned* p, unsigned v) { return __hip_atomic_fetch_add(p, v, __ATOMIC_RELAXED, __HIP_MEMORY_SCOPE_AGENT); }
__device__ __forceinline__ unsigned xb_xcc_id() { return (unsigned)__builtin_amdgcn_s_getreg((3 << 11) | 20) & 0xFu; }
#define XB_SPIN(cond, bar) do { unsigned _sp = 0; while (cond) { __builtin_amdgcn_s_sleep(1); \
    if ((++_sp & 255u) == 0u) { if (xb_ld(&(bar)[XB_TMO])) break; if (_sp > XB_SPIN_CAP) { atomicAdd(&(bar)[XB_TMO], 1u); break; } } } } while (0)

struct XcdBarrier {
    unsigned* bar; unsigned x;
    volatile LAS unsigned* st;
};

__device__ __forceinline__ XcdBarrier xcd_barrier_post(unsigned* bar, volatile LAS unsigned* st) {
    XcdBarrier b; b.bar = bar; b.x = xb_xcc_id(); b.st = st;
    if (threadIdx.x == 0) (void)xb_add(&bar[XB_XCNT(b.x)], 1u);
    return b;
}
__device__ __forceinline__ void xcd_barrier_complete(unsigned* bar, unsigned x, unsigned& nloc, unsigned& nx) {
    const unsigned G = gridDim.x * gridDim.y * gridDim.z;
    unsigned sum, cnt, mine, sp = 0u;
    for (;;) {
        sum = 0u; cnt = 0u; mine = 0u;
#pragma unroll
        for (unsigned j = 0; j < 16; ++j) { const unsigned c = xb_ld(&bar[XB_XCNT(j)]); sum += c; cnt += (c > 0u) ? 1u : 0u; mine = (j == x) ? c : mine; }
        if (sum == G) break;
        __builtin_amdgcn_s_sleep(1);
        if ((++sp & 255u) == 0u) { if (xb_ld(&bar[XB_TMO])) break; if (sp > XB_SPIN_CAP) { atomicAdd(&bar[XB_TMO], 1u); break; } }
    }
    nloc = mine > 0u ? mine : 1u; nx = cnt > 0u ? cnt : 1u;
}

__device__ __forceinline__ void xcd_barrier(const XcdBarrier& b) {
    asm volatile("s_waitcnt vmcnt(0)" ::: "memory");
    __syncthreads();
    if (threadIdx.x == 0) {
        unsigned* bar = b.bar;
        __builtin_amdgcn_s_waitcnt(0);
        unsigned nloc = b.st[0], nx = b.st[1];
        if (nloc == 0u) { xcd_barrier_complete(bar, b.x, nloc, nx); b.st[0] = nloc; b.st[1] = nx; }
        const unsigned old = xb_add(&bar[XB_XSUB(b.x)], 1u);
        const unsigned gen = old / nloc;
        if (old + 1u == (gen + 1u) * nloc) {
            __builtin_amdgcn_fence(__ATOMIC_RELEASE, "agent");
            asm volatile("s_waitcnt vmcnt(0)" ::: "memory");
            const unsigned og = xb_add(&bar[XB_TOP], 1u);
            const unsigned tg = og / nx;
            if (og + 1u == (tg + 1u) * nx) xb_add(&bar[XB_TOPGEN], 1u);
            else XB_SPIN(xb_ld(&bar[XB_TOPGEN]) == tg, bar);
            __builtin_amdgcn_fence(__ATOMIC_ACQUIRE, "agent");
            xb_add(&bar[XB_XGEN(b.x)], 1u);
            asm volatile("s_waitcnt vmcnt(0)" ::: "memory");
        } else {
            XB_SPIN(xb_ld(&bar[XB_XGEN(b.x)]) == gen, bar);
            __builtin_amdgcn_fence(__ATOMIC_ACQUIRE, "agent");
            asm volatile("s_waitcnt vmcnt(0)" ::: "memory");
        }
    }
    __syncthreads();
}

constexpr int NB = 4, SEQ = 8192, D = 1024, M = NB * SEQ;
constexpr int FFN = 2816, EXD = 3584, NEXP = 8;
constexpr int U0W = 2048, U1W = 2560;
constexpr float EPS = 1e-6f;
constexpr int NWAVES = 8, NTHR = NWAVES * 64;
constexpr int SLOTCAP = 34816;
constexpr int NPHASE = 22;
constexpr int FFN8T = 12;
constexpr float FFN_WSC_UP = 32.f, FFN_WSC_DN = 64.f, FFN_HSC = 4.f;
constexpr float MOE_WSC_UP = 32.f, MOE_WSC_DN = 64.f, MOE_HSC = 4.f;

constexpr size_t MiB = 1u << 20;
constexpr size_t WS_CTL = 0, CTL_ZERO_BYTES = 256 * 1024;
constexpr size_t WS_TAB = 2 * MiB;
constexpr size_t T_KMEAN = WS_TAB, T_ROPEC = WS_TAB + 256 * 1024, T_ROPES = WS_TAB + 768 * 1024, T_MD = WS_TAB + 1280 * 1024,
                 T_RSTD4 = WS_TAB + 1536 * 1024, T_TOKE = WS_TAB + 1792 * 1024, T_TOKP = WS_TAB + 2048 * 1024, T_TOKW = WS_TAB + 2304 * 1024,
                 T_SLOTT = WS_TAB + 2560 * 1024, T_SLOTW = WS_TAB + 3072 * 1024, T_SLOTR = WS_TAB + 3584 * 1024, T_TILEE = WS_TAB + 4096 * 1024, T_CNTJ = WS_TAB + 4608 * 1024, T_IDENT = WS_TAB + 4864 * 1024;
constexpr size_t WS_HB = 8 * MiB;
constexpr size_t W_IN0 = 72 * MiB, W_OUT0 = 76 * MiB, W_FFNGU = 78 * MiB, W_FFND = 89 * MiB, W_PLEG0 = 95 * MiB, W_PLEP0 = 97 * MiB,
                 W_IN1 = 98 * MiB, W_UQ = 103 * MiB, W_UKV = 103 * MiB + 512 * 1024, W_OUT1 = 104 * MiB;
constexpr size_t WS_PB0 = 110 * MiB, WS_XN0 = 126 * MiB, WS_P0G = 190 * MiB, WS_MIX0 = 254 * MiB, WS_HMID0 = 318 * MiB;
constexpr size_t WS_HB8 = 500 * MiB;
constexpr size_t WS_LISTS = 320 * MiB, WS_PO = 352 * MiB, WS_PM = 480 * MiB;
constexpr size_t WS_U1 = 126 * MiB, WS_MU = 286 * MiB, WS_MN = 350 * MiB, WS_QM = 352 * MiB, WS_KM = 384 * MiB, WS_VM = 416 * MiB, WS_MIX1 = 448 * MiB;
constexpr size_t W_MOEGU = 72 * MiB, W_MOED = 184 * MiB, WS_HMIDG = 240 * MiB, WS_XG = 478 * MiB, WS_PB1 = 546 * MiB, W_PLEG1 = 562 * MiB, W_PLEP1 = 564 * MiB, WS_P1G = 478 * MiB;
constexpr size_t WS_SSQ = 576 * MiB;
constexpr size_t WS_DUMP = 586 * MiB;
constexpr size_t WS_END = 587 * MiB;
constexpr int CW_TMO = 0, CW_CODE = 1, CW_BAR = 4096, CW_CNT = 32768, CW_SSQ = 65536, CW_MOBA = 131072;
constexpr size_t SSQ_H1 = 0, SSQ_H2 = (size_t)M * 16, SSQ_H3 = (size_t)M * 32, SSQ_H5 = (size_t)M * 48, SSQ_CQ = (size_t)M * 64, SSQ_CKV = (size_t)M * 68;
constexpr int RING_BYTES = 131072, MISC_OFF = RING_BYTES + 320, LDS_BYTES = 147456;

__device__ __forceinline__ float bf2f(unsigned short b) { return __uint_as_float(((unsigned)b) << 16); }
__device__ __forceinline__ float bflo(unsigned w) { return __uint_as_float(w << 16); }
__device__ __forceinline__ float bfhi(unsigned w) { return __uint_as_float(w & 0xffff0000u); }
__device__ __forceinline__ unsigned f2bf(float f) { unsigned u = __builtin_bit_cast(unsigned, f); return (u + 0x7fffu + ((u >> 16) & 1u)) >> 16; }
__device__ __forceinline__ unsigned pk2(float lo, float hi) { return f2bf(lo) | (f2bf(hi) << 16); }
template <int CTRL, int RMASK> __device__ __forceinline__ float dpp_mov0(float v) { return __builtin_bit_cast(float, __builtin_amdgcn_update_dpp(0, __builtin_bit_cast(int, v), CTRL, RMASK, 0xf, false)); }
__device__ __forceinline__ float wave_sum(float v) {
    v += dpp_mov0<0xB1, 0xf>(v);
    v += dpp_mov0<0x4E, 0xf>(v);
    v += dpp_mov0<0x114, 0xf>(v);
    v += dpp_mov0<0x118, 0xf>(v);
    v += dpp_mov0<0x142, 0xa>(v);
    v += dpp_mov0<0x143, 0xc>(v);
    return __builtin_bit_cast(float, __builtin_amdgcn_readlane(__builtin_bit_cast(int, v), 63));
}
__device__ __forceinline__ float wave_scan_incl(float v) {
    v += dpp_mov0<0x111, 0xf>(v); v += dpp_mov0<0x112, 0xf>(v); v += dpp_mov0<0x114, 0xf>(v); v += dpp_mov0<0x118, 0xf>(v);
    v += dpp_mov0<0x142, 0xa>(v);
    v += dpp_mov0<0x143, 0xc>(v);
    return v;
}
__device__ __forceinline__ float silu_f(float x) { return x * __builtin_amdgcn_rcpf(1.f + __expf(-x)); }
__device__ __forceinline__ float sigmoid_f(float x) { return __builtin_amdgcn_rcpf(1.f + __expf(-x)); }
__device__ __forceinline__ float logsig_f(float x) { return fminf(x, 0.f) - __logf(1.f + __expf(-fabsf(x))); }

template <int NP> __device__ __forceinline__ float ssq_row(const float* p, int row) {
    const f32x4* q = (const f32x4*)(p + (size_t)row * NP); float s = 0.f;
#pragma unroll
    for (int i = 0; i < NP / 4; ++i) { const f32x4 v = q[i]; s += (v[0] + v[1]) + (v[2] + v[3]); }
    return s;
}
namespace epi {
using pg8::Unit; using pg8::cvt_pk_bf16;
typedef pg8::f32x4 F4;
typedef pg8::u32x2 U2;
#define ACC_T const F4 (&acc)[2][2][4][2]

struct Store {
    static constexpr bool PERM = true, AFTER_DRAIN = false;
    bf16* O; int ldc; const float* ssq; float invn;
    __device__ __forceinline__ void operator()(ACC_T, const Unit& u, int wr, int wc, int fr, int fq) const {
        const int row0 = u.pm * 256 + wr * 64 + fr, cl0 = wc * 32 + 8 * fq;
#pragma unroll
        for (int ai = 0; ai < 2; ++ai)
#pragma unroll
            for (int m = 0; m < 4; ++m) { const int row = row0 + ai * 128 + m * 16; float rs = 1.f; if (ssq) rs = rsqrtf(ssq_row<16>(ssq, row) * invn + EPS);
                bf16* rp = O + (size_t)row * ldc + u.pn * 256 + cl0;
#pragma unroll
                for (int bj = 0; bj < 2; ++bj) { const F4 v0 = acc[ai][bj][m][0] * rs, v1 = acc[ai][bj][m][1] * rs; v4u w; w.x = cvt_pk_bf16(v0[0], v0[1]); w.y = cvt_pk_bf16(v0[2], v0[3]); w.z = cvt_pk_bf16(v1[0], v1[1]); w.w = cvt_pk_bf16(v1[2], v1[3]);
                    *(v4u*)(rp + bj * 128) = w; } }
    }
};
struct U1 {
    static constexpr bool PERM = true, AFTER_DRAIN = false;
    bf16* O; const float* ssq_in; float* ssq_cq; float* ssq_ckv; bf16* Km; const float* ropec; const float* ropes;
    __device__ __forceinline__ void operator()(ACC_T, const Unit& u, int wr, int wc, int fr, int fq) const {
        const int row0 = u.pm * 256 + wr * 64 + fr, cl0 = wc * 32 + 8 * fq;
        float rsv[2][4];
#pragma unroll
        for (int ai = 0; ai < 2; ++ai)
#pragma unroll
            for (int m = 0; m < 4; ++m) rsv[ai][m] = ssq_row<4>(ssq_in, row0 + ai * 128 + m * 16);
#pragma unroll
        for (int ai = 0; ai < 2; ++ai)
#pragma unroll
            for (int m = 0; m < 4; ++m) { const int row = row0 + ai * 128 + m * 16; const float rs = rsqrtf(rsv[ai][m] * (1.f / 1024.f) + EPS);
                bf16* rp = O + (size_t)row * U1W + u.pn * 256 + cl0; float s0 = 0.f, s1 = 0.f;
#pragma unroll
                for (int bj = 0; bj < 2; ++bj) { const F4 v0 = acc[ai][bj][m][0] * rs, v1 = acc[ai][bj][m][1] * rs; v4u w; w.x = cvt_pk_bf16(v0[0], v0[1]); w.y = cvt_pk_bf16(v0[2], v0[3]); w.z = cvt_pk_bf16(v1[0], v1[1]); w.w = cvt_pk_bf16(v1[2], v1[3]);
                    *(v4u*)(rp + bj * 128) = w;
                    const float sq = ((v0[0] * v0[0] + v0[1] * v0[1]) + (v0[2] * v0[2] + v0[3] * v0[3])) + ((v1[0] * v1[0] + v1[1] * v1[1]) + (v1[2] * v1[2] + v1[3] * v1[3])); if (bj == 0) s0 += sq; else s1 += sq; }
                if (u.pn == 9 && wc == 0) {
                    const int t = row & (SEQ - 1), j0 = 8 * (fq & 1); const F4 c0 = *(const F4*)(ropec + t * 16 + j0), c1 = *(const F4*)(ropec + t * 16 + j0 + 4), n0 = *(const F4*)(ropes + t * 16 + j0), n1 = *(const F4*)(ropes + t * 16 + j0 + 4);
                    const F4 a0 = acc[ai][1][m][0] * rs, a1 = acc[ai][1][m][1] * rs; F4 p0, p1;
#pragma unroll
                    for (int i = 0; i < 4; ++i) { p0[i] = __shfl_xor(a0[i], 32); p1[i] = __shfl_xor(a1[i], 32); }
                    F4 r0, r1;
                    if (fq < 2) { r0 = a0 * c0 - p0 * n0; r1 = a1 * c1 - p1 * n1; }
                    else        { r0 = p0 * n0 + a0 * c0; r1 = p1 * n1 + a1 * c1; }
                    v4u w; w.x = cvt_pk_bf16(r0[0], r0[1]); w.y = cvt_pk_bf16(r0[2], r0[3]); w.z = cvt_pk_bf16(r1[0], r1[1]); w.w = cvt_pk_bf16(r1[2], r1[3]); const v4u z = (v4u){0u, 0u, 0u, 0u};
#pragma unroll
                    for (int h = 0; h < 4; ++h) { bf16* kr = Km + (size_t)row * 512 + h * 128; *(v4u*)(kr + 64 + 8 * fq) = w; *(v4u*)(kr + 96 + 8 * fq) = z; } }
                if (u.pn >= 8) { float s = (u.pn == 8) ? (s0 + s1) : s0; s += __shfl_xor(s, 16); s += __shfl_xor(s, 32);
                    if (fq == 0) ssq_cq[((u.pn == 8) ? 0l : (long)(ssq_ckv - ssq_cq)) + (size_t)row * 4 + wc] = s; } }
    }
};
template <bool RSTD_ARR> struct SwiGLU {
    static constexpr bool PERM = true, AFTER_DRAIN = false;
    bf16* O; int ldc; const float* rsrc; float invn;
    __device__ __forceinline__ void operator()(ACC_T, const Unit& u, int wr, int wc, int fr, int fq) const {
        const int row0 = u.pm * 256 + wr * 64 + fr, cl0 = wc * 32 + 8 * fq;
#pragma unroll
        for (int ai = 0; ai < 2; ++ai)
#pragma unroll
            for (int m = 0; m < 4; ++m) { const int row = row0 + ai * 128 + m * 16; const float rs = RSTD_ARR ? rsrc[row] : rsqrtf(ssq_row<16>(rsrc, row) * invn + EPS);
                float h[8];
#pragma unroll
                for (int n = 0; n < 2; ++n) { const F4 g = acc[ai][0][m][n] * rs, uu = acc[ai][1][m][n] * rs;
#pragma unroll
                    for (int j = 0; j < 4; ++j) h[4 * n + j] = g[j] * __builtin_amdgcn_rcpf(1.f + __expf(-g[j])) * uu[j]; }
                v4u w; w.x = cvt_pk_bf16(h[0], h[1]); w.y = cvt_pk_bf16(h[2], h[3]); w.z = cvt_pk_bf16(h[4], h[5]); w.w = cvt_pk_bf16(h[6], h[7]);
                *(v4u*)(O + (size_t)row * ldc + u.pn * 128 + cl0) = w; }
    }
};
template <int RSTD_ARR  > struct SwiGLU8 {
    static constexpr bool PERM = true, AFTER_DRAIN = false;
    unsigned char* O; int ldc; const float* rsrc; float iwsc, osc;
    __device__ __forceinline__ void operator()(ACC_T, const Unit& u, int wr, int wc, int fr, int fq) const {
        const int row0 = u.pm * 256 + wr * 64 + fr, cl0 = wc * 32 + 8 * fq;
        float rsv[2][4];
#pragma unroll
        for (int ai = 0; ai < 2; ++ai)
#pragma unroll
            for (int m = 0; m < 4; ++m) { const int row = row0 + ai * 128 + m * 16; rsv[ai][m] = (RSTD_ARR == 2 ? 1.f : RSTD_ARR == 1 ? rsrc[row] : ssq_row<4>(rsrc, row)); }
#pragma unroll
        for (int ai = 0; ai < 2; ++ai)
#pragma unroll
            for (int m = 0; m < 4; ++m) { const int row = row0 + ai * 128 + m * 16; const float rs = (RSTD_ARR == 2 ? 1.f : RSTD_ARR == 1 ? rsv[ai][m] : rsqrtf(rsv[ai][m] * (1.f / 1024.f) + EPS)) * iwsc;
                const float k1 = -1.4426950408889634f * rs, k2 = rs * rs * osc;
                F4 hv[2];
#pragma unroll
                for (int n = 0; n < 2; ++n) { const F4 ag = acc[ai][0][m][n], au = acc[ai][1][m][n]; F4 e = ag * k1;
#pragma unroll
                    for (int j = 0; j < 4; ++j) e[j] = __builtin_amdgcn_exp2f(e[j]);
                    e = e + 1.f;
#pragma unroll
                    for (int j = 0; j < 4; ++j) e[j] = __builtin_amdgcn_rcpf(e[j]);
                    hv[n] = (ag * au) * (e * k2); }
                int w0 = 0, w1 = 0; w0 = __builtin_amdgcn_cvt_pk_fp8_f32(hv[0][0], hv[0][1], w0, false); w0 = __builtin_amdgcn_cvt_pk_fp8_f32(hv[0][2], hv[0][3], w0, true);
                w1 = __builtin_amdgcn_cvt_pk_fp8_f32(hv[1][0], hv[1][1], w1, false); w1 = __builtin_amdgcn_cvt_pk_fp8_f32(hv[1][2], hv[1][3], w1, true);
                *(v2u*)(O + (size_t)row * ldc + u.pn * 128 + cl0) = (v2u){(unsigned)w0, (unsigned)w1}; }
    }
};
template <int MODE, bool BASEF32, bool SSQ, bool O8 = false> struct Res {
    static constexpr bool PERM = true, AFTER_DRAIN = false;
    const float* basef; const bf16* baseb; bf16* out; float* ssq_out; const float* ssq_in; const bf16* P; const int* tok; const float* sw; float oscale; unsigned char* out8; LAS float* red; bf16* dump;
    __device__ __forceinline__ void operator()(ACC_T, const Unit& u, int wr, int wc, int fr, int fq) const {
        constexpr bool ALLUP = !BASEF32 && MODE == 0;
        const int row0 = u.pm * 256 + wr * 64 + fr, cl0 = wc * 32 + 8 * fq;
        int orv[2][4]; float wgv[2][4], rsv[2][4];
#pragma unroll
        for (int ai = 0; ai < 2; ++ai)
#pragma unroll
            for (int m = 0; m < 4; ++m) { const int row = row0 + ai * 128 + m * 16; orv[ai][m] = row; wgv[ai][m] = 1.f; rsv[ai][m] = 0.f;
                if (MODE == 2) { orv[ai][m] = tok[row]; wgv[ai][m] = sw[row]; }
                if (MODE == 1) rsv[ai][m] = ssq_row<4>(ssq_in, row); }
        int offv[2][4];
#pragma unroll
        for (int ai = 0; ai < 2; ++ai)
#pragma unroll
            for (int m = 0; m < 4; ++m) { int orow = orv[ai][m]; if (MODE == 2 && orow < 0) orow = 0; offv[ai][m] = orow * D + u.pn * 256 + cl0; }
        v4u bw[ALLUP ? 2 : 1][4][2], pw[4][2]; F4 bfa[4][2], bfb[4][2]; v4u wo[4][2]; v2u qo[4][2];
#define RES_LOAD(ai) do { _Pragma("unroll") for (int m = 0; m < 4; ++m) _Pragma("unroll") for (int bj = 0; bj < 2; ++bj) { const size_t o2 = (size_t)(offv[ai][m] + bj * 128);  \
            if (BASEF32) { bfa[m][bj] = *(const F4*)(basef + o2); bfb[m][bj] = *(const F4*)(basef + o2 + 4); } else bw[ALLUP ? ai : 0][m][bj] = *(const v4u*)(baseb + o2);    \
            if (MODE == 1) pw[m][bj] = *(const v4u*)(P + o2); } } while (0)
#define RES_COMP(ai) do { _Pragma("unroll") for (int m = 0; m < 4; ++m) { const int row = row0 + ai * 128 + m * 16; float wgt = 1.f, rs = 0.f, s = 0.f;                           \
            if (MODE == 2) wgt = orv[ai][m] >= 0 ? wgv[ai][m] * oscale : 0.f;                                                                                                \
            if (MODE == 1) rs = rsqrtf(rsv[ai][m] * (1.f / 1024.f) + EPS);                                                                                                    \
            _Pragma("unroll") for (int bj = 0; bj < 2; ++bj) { const F4 a0 = acc[ai][bj][m][0], a1 = acc[ai][bj][m][1]; F4 b0, b1, h0, h1;                                   \
                if (BASEF32) { b0 = bfa[m][bj]; b1 = bfb[m][bj]; }                                                                                                            \
                else { const v4u w = bw[ALLUP ? ai : 0][m][bj]; b0 = (F4){bflo(w.x), bfhi(w.x), bflo(w.y), bfhi(w.y)}; b1 = (F4){bflo(w.z), bfhi(w.z), bflo(w.w), bfhi(w.w)}; } \
                if (MODE == 0) { h0 = b0 + a0 * oscale; h1 = b1 + a1 * oscale; }                                                                                              \
                if (MODE == 1) { const v4u q = pw[m][bj]; const F4 p0 = (F4){bflo(q.x), bfhi(q.x), bflo(q.y), bfhi(q.y)}, p1 = (F4){bflo(q.z), bfhi(q.z), bflo(q.w), bfhi(q.w)}; \
                    _Pragma("unroll") for (int j = 0; j < 4; ++j) { h0[j] = b0[j] + p0[j] * __builtin_amdgcn_rcpf(1.f + __expf(-rs * a0[j])); h1[j] = b1[j] + p1[j] * __builtin_amdgcn_rcpf(1.f + __expf(-rs * a1[j])); } } \
                if (MODE == 2) { h0 = b0 + a0 * wgt; h1 = b1 + a1 * wgt; }                                                                                                    \
                v4u w; w.x = cvt_pk_bf16(h0[0], h0[1]); w.y = cvt_pk_bf16(h0[2], h0[3]); w.z = cvt_pk_bf16(h1[0], h1[1]); w.w = cvt_pk_bf16(h1[2], h1[3]); wo[m][bj] = w;      \
                if (O8) { int q0 = 0, q1 = 0; q0 = __builtin_amdgcn_cvt_pk_fp8_f32(h0[0], h0[1], q0, false); q0 = __builtin_amdgcn_cvt_pk_fp8_f32(h0[2], h0[3], q0, true); q1 = __builtin_amdgcn_cvt_pk_fp8_f32(h1[0], h1[1], q1, false); q1 = __builtin_amdgcn_cvt_pk_fp8_f32(h1[2], h1[3], q1, true); qo[m][bj] = (v2u){(unsigned)q0, (unsigned)q1}; } \
                s += ((h0[0] * h0[0] + h0[1] * h0[1]) + (h0[2] * h0[2] + h0[3] * h0[3])) + ((h1[0] * h1[0] + h1[1] * h1[1]) + (h1[2] * h1[2] + h1[3] * h1[3])); }             \
            if (SSQ) { s += __shfl_xor(s, 16); s += __shfl_xor(s, 32); if (fq == 0) red[(row - u.pm * 256) * 4 + wc] = s; } } } while (0)
#define RES_STORE(ai) do { _Pragma("unroll") for (int m = 0; m < 4; ++m) _Pragma("unroll") for (int bj = 0; bj < 2; ++bj) { const size_t o2 = (size_t)(offv[ai][m] + bj * 128);  \
            bf16* dst = out + o2; if (MODE == 2) dst = orv[ai][m] >= 0 ? dst : dump + (u.pn * 256 + cl0 + bj * 128);                                                       \
            *(v4u*)dst = wo[m][bj]; if (O8) *(v2u*)(out8 + o2) = qo[m][bj]; } } while (0)
        if constexpr (MODE == 1) {
#pragma unroll
            for (int ai = 0; ai < 2; ++ai)
#pragma unroll
                for (int m = 0; m < 4; ++m) { const int row = row0 + ai * 128 + m * 16; const float rs = rsqrtf(rsv[ai][m] * (1.f / 1024.f) + EPS); float s = 0.f;
#pragma unroll
                    for (int bj = 0; bj < 2; ++bj) { const size_t o2 = (size_t)(offv[ai][m] + bj * 128); const F4 a0 = acc[ai][bj][m][0], a1 = acc[ai][bj][m][1]; F4 h0, h1;
                        const v4u w = *(const v4u*)(baseb + o2); const F4 b0 = (F4){bflo(w.x), bfhi(w.x), bflo(w.y), bfhi(w.y)}, b1 = (F4){bflo(w.z), bfhi(w.z), bflo(w.w), bfhi(w.w)};
                        const v4u q = *(const v4u*)(P + o2); const F4 p0 = (F4){bflo(q.x), bfhi(q.x), bflo(q.y), bfhi(q.y)}, p1 = (F4){bflo(q.z), bfhi(q.z), bflo(q.w), bfhi(q.w)};
#pragma unroll
                        for (int j = 0; j < 4; ++j) { h0[j] = b0[j] + p0[j] * __builtin_amdgcn_rcpf(1.f + __expf(-rs * a0[j])); h1[j] = b1[j] + p1[j] * __builtin_amdgcn_rcpf(1.f + __expf(-rs * a1[j])); }
                        v4u ww; ww.x = cvt_pk_bf16(h0[0], h0[1]); ww.y = cvt_pk_bf16(h0[2], h0[3]); ww.z = cvt_pk_bf16(h1[0], h1[1]); ww.w = cvt_pk_bf16(h1[2], h1[3]); *(v4u*)(out + o2) = ww;
                        s += ((h0[0] * h0[0] + h0[1] * h0[1]) + (h0[2] * h0[2] + h0[3] * h0[3])) + ((h1[0] * h1[0] + h1[1] * h1[1]) + (h1[2] * h1[2] + h1[3] * h1[3])); }
                    if (SSQ) { s += __shfl_xor(s, 16); s += __shfl_xor(s, 32); if (fq == 0) red[(row - u.pm * 256) * 4 + wc] = s; } }
        } else {
        RES_LOAD(0); if (ALLUP) RES_LOAD(1);
        RES_COMP(0);
        if (!ALLUP) { RES_LOAD(1); __builtin_amdgcn_sched_barrier(0); }
        RES_STORE(0); RES_COMP(1); RES_STORE(1);
        }
#undef RES_LOAD
#undef RES_COMP
#undef RES_STORE
        if (SSQ) {
            asm volatile("s_waitcnt lgkmcnt(0)" ::: "memory"); __builtin_amdgcn_s_barrier();
            if (wr == 0) { const int rl = wc * 64 + fq * 16 + fr; const F4 v = *(const LAS F4*)(red + rl * 4); int orow = u.pm * 256 + rl; if (MODE == 2) orow = tok[orow];
                if (orow >= 0) ssq_out[(size_t)orow * 4 + u.pn] = (v[0] + v[1]) + (v[2] + v[3]); } }
    }
};
struct MlaQ {
    static constexpr bool PERM = false, AFTER_DRAIN = false;
    bf16* Qm; const float* ssq_cq; const float* ropec; const float* ropes;
    __device__ __forceinline__ void operator()(ACC_T, const Unit& u, int wr, int wc, int fr, int fq) const {
        const int row0 = u.pm * 256 + wr * 64 + fr;
        float rsv[2][4];
#pragma unroll
        for (int ai = 0; ai < 2; ++ai)
#pragma unroll
            for (int m = 0; m < 4; ++m) rsv[ai][m] = ssq_row<4>(ssq_cq, row0 + ai * 128 + m * 16);
#pragma unroll
        for (int ai = 0; ai < 2; ++ai) { F4 csv[2][4], snv[2][4];
            if (u.pn != 0) {
#pragma unroll
                for (int m = 0; m < 4; ++m) { const int t = (row0 + ai * 128 + m * 16) & (SEQ - 1); csv[ai][m] = *(const F4*)(ropec + t * 16 + 4 * fq); snv[ai][m] = *(const F4*)(ropes + t * 16 + 4 * fq); } }
#pragma unroll
            for (int m = 0; m < 4; ++m) { const int row = row0 + ai * 128 + m * 16; const float rs = rsqrtf(rsv[ai][m] * (1.f / 256.f) + EPS); bf16* qr = Qm + (size_t)row * 512;
                if (u.pn == 0) {
#pragma unroll
                    for (int bj = 0; bj < 2; ++bj)
#pragma unroll
                        for (int n = 0; n < 2; ++n) { const F4 v = acc[ai][bj][m][n] * rs; U2 w; w.x = cvt_pk_bf16(v[0], v[1]); w.y = cvt_pk_bf16(v[2], v[3]);
                            *(U2*)(qr + (2 * bj + (wc >> 1)) * 128 + (wc & 1) * 32 + n * 16 + 4 * fq) = w; }
                } else {
                    const F4 cs = csv[ai][m], sn = snv[ai][m];
                    const F4 x1 = acc[ai][0][m][0] * rs, x2 = acc[ai][0][m][1] * rs; const F4 r1 = x1 * cs - x2 * sn, r2 = x1 * sn + x2 * cs;
                    U2 w; w.x = cvt_pk_bf16(r1[0], r1[1]); w.y = cvt_pk_bf16(r1[2], r1[3]); *(U2*)(qr + wc * 128 + 64 + 4 * fq) = w;
                    w.x = cvt_pk_bf16(r2[0], r2[1]); w.y = cvt_pk_bf16(r2[2], r2[3]); *(U2*)(qr + wc * 128 + 80 + 4 * fq) = w;
                    w.x = 0u; w.y = 0u; *(U2*)(qr + wc * 128 + 96 + 4 * fq) = w; *(U2*)(qr + wc * 128 + 112 + 4 * fq) = w;
                } } }
    }
};
struct MlaKV {
    static constexpr bool PERM = false, AFTER_DRAIN = false;
    bf16* Km; bf16* Vm; const float* ssq_ckv;
    __device__ __forceinline__ void operator()(ACC_T, const Unit& u, int wr, int wc, int fr, int fq) const {
        const int row0 = u.pm * 256 + wr * 64 + fr; const long vdelta = Vm - Km;
        float rsv[2][4];
#pragma unroll
        for (int ai = 0; ai < 2; ++ai)
#pragma unroll
            for (int m = 0; m < 4; ++m) rsv[ai][m] = ssq_row<4>(ssq_ckv, row0 + ai * 128 + m * 16);
#pragma unroll
        for (int ai = 0; ai < 2; ++ai)
#pragma unroll
            for (int m = 0; m < 4; ++m) { const int row = row0 + ai * 128 + m * 16; const float rs = rsqrtf(rsv[ai][m] * (1.f / 128.f) + EPS);
#pragma unroll
                for (int bj = 0; bj < 2; ++bj)
#pragma unroll
                    for (int n = 0; n < 2; ++n) { const F4 v = acc[ai][bj][m][n] * rs; U2 w; w.x = cvt_pk_bf16(v[0], v[1]); w.y = cvt_pk_bf16(v[2], v[3]);
                        const long offk = (2 * bj + (wc >> 1)) * 128 + (wc & 1) * 32 + n * 16 + 4 * fq, offv = vdelta + (u.pn - 1) * 256 + bj * 128 + wc * 32 + n * 16 + 4 * fq;
                        *(U2*)(Km + (size_t)row * 512 + ((u.pn == 0) ? offk : offv)) = w; } }
    }
};
#undef ACC_T
}

struct MoeOrder {
    const int* tile_e; int ntiles, NT, x, r, per;
    __device__ __forceinline__ void init(const int* te, int nt_, int NT_, int G, int c) { tile_e = te; ntiles = nt_; NT = NT_; if (G % 8 == 0) { x = c % 8; r = c / 8; per = G / 8; } else { x = -1; r = c; per = G; } }
    __device__ __forceinline__ bool next(int i, pg8::Unit& u) const {
        const int j = i * per + r; int T, pn;
        if (x >= 0) { T = x + 8 * (j / NT); pn = j % NT; } else { T = j / NT; pn = j % NT; }
        if (T >= ntiles) return false;
        u.pm = T; u.pn = pn; u.pb = tile_e[T] * NT + pn; return true;
    }
    __device__ __forceinline__ void a_ready(const pg8::Unit&) const {}
    __device__ __forceinline__ void done(const pg8::Unit&) const {}
};

struct MoeOrderC {
    const int* tab; int ntiles, NT, x, r, per;
    __device__ __forceinline__ void init(const int* tb, int nt_, int NT_, int G, int c) { tab = tb; ntiles = nt_; NT = NT_; if (G % 8 == 0) { x = c % 8; r = c / 8; per = G / 8; } else { x = -1; r = c; per = G; } }
    __device__ __forceinline__ bool next(int i, pg8::Unit& u) const {
        const int j = i * per + r; int T, pn;
        if (x >= 0) { T = x + 8 * (j / NT); pn = j % NT; } else { T = j / NT; pn = j % NT; }
        if (T >= ntiles) return false;
        const int v = tab[T]; u.pm = v & 0xffff; u.pn = pn; u.pb = (v >> 16) * NT + pn; return true;
    }
    __device__ __forceinline__ void a_ready(const pg8::Unit&) const {}
    __device__ __forceinline__ void done(const pg8::Unit&) const {}
};

struct LightDeal {
    int lr, nl; bool light;
    __device__ __forceinline__ void init(int ntiles, int G, int c) {
        if (G != 256) { lr = c; nl = G; light = true; return; }
        int hb = 0, ha = 0; bool heavy = false;
#pragma unroll
        for (int x = 0; x < 8; ++x) { const int cnt = (ntiles - x + 7) >> 3; int hx = 4 * cnt - 64; hx = hx < 0 ? 0 : (hx > 32 ? 32 : hx);
            const int ni = (c - x + 7) >> 3;
            hb += ni < hx ? ni : hx; ha += hx; if ((c & 7) == x && (c >> 3) < hx) heavy = true; }
        light = !heavy; lr = c - hb; nl = 256 - ha; }
};
struct LeftOrder {
    const int* tab; int nun, NT, lr, nl; bool on;
    __device__ __forceinline__ void init(const int* tb, int ntl, int NT_, const LightDeal& d) { tab = tb; NT = NT_; nun = ntl * NT_; lr = d.lr; nl = d.nl; on = d.light; }
    __device__ __forceinline__ bool next(int i, pg8::Unit& u) const {
        const int idx = i * nl + lr; if (!on || idx >= nun) return false;
        const int tl = idx / NT, pn = idx - tl * NT; const int v = tab[tl]; u.pm = v & 0xffff; u.pn = pn; u.pb = (v >> 16) * NT + pn; return true;
    }
    __device__ __forceinline__ void a_ready(const pg8::Unit&) const {}
    __device__ __forceinline__ void done(const pg8::Unit&) const {}
};
struct LightStatic {
    pg8::StaticOrder S; bool on;
    __device__ __forceinline__ void init(int M_, int N_, const LightDeal& d) { S.init(M_, N_, d.nl, d.lr); on = d.light; }
    __device__ __forceinline__ bool next(int i, pg8::Unit& u) const { return on && S.next(i, u); }
    __device__ __forceinline__ void a_ready(const pg8::Unit&) const {}
    __device__ __forceinline__ void done(const pg8::Unit&) const {}
};

enum { MAP_ID = 0, MAP_IL = 1, MAP_U1 = 2, MAP_UQ = 3, MAP_UKV = 4 };
template <int MAP> __device__ __forceinline__ int map_src(int r, int& which) {
    which = 0;
    if (MAP == MAP_ID) return r;
    if (MAP == MAP_IL) { const int blk = r >> 8, w = r & 255; which = (w >= 128) ? 1 : 0; return blk * 128 + (w & 127); }
    if (MAP == MAP_U1) { if (r < 2048) return r; if (r < 2304) return 2056 + (r - 2048); if (r < 2432) return 2312 + (r - 2304); if (r < 2464) return 2440 + (r - 2432);
                         if (r < 2468) return 2048 + (r - 2464); if (r < 2472) return 2052 + (r - 2468); return -1; }
    if (MAP == MAP_UQ) { if (r < 256) return (r >> 6) * 96 + (r & 63); if (r < 384) return ((r - 256) >> 5) * 96 + 64 + (r & 31); return -1; }
    { if (r < 256) return (r >> 6) * 192 + (r & 63); const int rr = r - 256; return (rr >> 7) * 192 + 64 + (rr & 127); }
}
template <int MAP, bool OUT8 = false> __device__ __forceinline__ void cvt_job(const float* s0, const float* s1, const float* gain, bf16* dst, int Ks, int Ns, int Nd, int Kd, int Kext, int koff,
                                                           LAS float* scr, int gw, int NGW, int& rot, int lane, float oscale = 1.f) {
    const int nkb = Kext / 64, nitems = (Nd / 32) * nkb;
    int first = gw - rot; if (first < 0) first += NGW;
    for (int it = first; it < nitems; it += NGW) {
        const int rb = it / nkb, kb = it - rb * nkb, r0 = rb * 32, k0 = kb * 64;
        if (MAP == MAP_ID || MAP == MAP_IL || (MAP == MAP_U1 && r0 < 2048)) {
            int which; const int sc0 = map_src<MAP>(r0, which); const float* src = (which ? s1 : s0) + sc0 + (lane & 7) * 4; const int kq = lane >> 3;
            f32x4 v[8];
#pragma unroll
            for (int i = 0; i < 8; ++i) v[i] = *(const f32x4*)(src + (size_t)(k0 + 8 * i + kq) * Ns);
#pragma unroll
            for (int i = 0; i < 8; ++i) { f32x4 t = v[i]; if (gain) t = t * gain[k0 + 8 * i + kq]; LAS float* sp = scr + (8 * i + kq) * 33 + (lane & 7) * 4; sp[0] = t[0]; sp[1] = t[1]; sp[2] = t[2]; sp[3] = t[3]; }
        } else {
        int which; const int sc = map_src<MAP>(r0 + (lane & 31), which); const float* src = which ? s1 : s0;
        { float vv[32], gg[32]; const int scc = sc >= 0 ? sc : 0;
#pragma unroll
          for (int i = 0; i < 32; ++i) { const int kk = 2 * i + (lane >> 5), k = k0 + kk, kc = k < Ks ? k : Ks - 1; vv[i] = src[(size_t)kc * Ns + scc]; gg[i] = gain ? gain[kc] : 1.f; }
#pragma unroll
          for (int i = 0; i < 32; ++i) { const int kk = 2 * i + (lane >> 5), k = k0 + kk; scr[kk * 33 + (lane & 31)] = (sc >= 0 && k < Ks) ? vv[i] * gg[i] : 0.f; } }
        }
        asm volatile("s_waitcnt lgkmcnt(0)" ::: "memory");
        if (OUT8) {
#pragma unroll
            for (int j = 0; j < 2; ++j) { const int idx = lane + 64 * j, n = idx >> 2, cch = idx & 3; const LAS float* s = scr + (16 * cch) * 33 + n; int w[4];
#pragma unroll
                for (int q = 0; q < 4; ++q) { int t = 0; t = __builtin_amdgcn_cvt_pk_fp8_f32(s[(4 * q) * 33] * oscale, s[(4 * q + 1) * 33] * oscale, t, false); t = __builtin_amdgcn_cvt_pk_fp8_f32(s[(4 * q + 2) * 33] * oscale, s[(4 * q + 3) * 33] * oscale, t, true); w[q] = t; }
                *(v4u*)((unsigned char*)dst + (size_t)(r0 + n) * Kd + koff + k0 + 16 * cch) = (v4u){(unsigned)w[0], (unsigned)w[1], (unsigned)w[2], (unsigned)w[3]}; }
        } else {
        const int c = lane & 7;
#pragma unroll
        for (int j = 0; j < 4; ++j) { const int n = (lane >> 3) + 8 * j; const LAS float* s = scr + (8 * c) * 33 + n;
            v4u o; o.x = pk2(s[0 * 33], s[1 * 33]); o.y = pk2(s[2 * 33], s[3 * 33]); o.z = pk2(s[4 * 33], s[5 * 33]); o.w = pk2(s[6 * 33], s[7 * 33]);
            *(v4u*)(dst + (size_t)(r0 + n) * Kd + koff + k0 + 8 * c) = o; }
        }
        asm volatile("s_waitcnt lgkmcnt(0)" ::: "memory");
    }
    rot = (rot + nitems) % NGW;
}
template <int MAP, bool OUT8 = false> __device__ __forceinline__ void cvt_pipe(const float* s0, const float* s1, const float* gain, bf16* dst, int Ns, int Nd, int Kd, int Kext, int koff,
                                                            LAS float* scr, int gw, int NGW, int& rot, int lane, float oscale = 1.f) {
    static_assert(MAP == MAP_ID || MAP == MAP_IL, "16-byte-load maps only");
    const int nkb = Kext / 64, nitems = (Nd / 32) * nkb, kq = lane >> 3;
    int it = gw - rot; if (it < 0) it += NGW;
    f32x4 v[8];
#define CVP_LOAD(dst_, it_) do { const int rb_ = (it_) / nkb, kb_ = (it_) - rb_ * nkb; int wh_; const int sc_ = map_src<MAP>(rb_ * 32, wh_); const float* sp_ = (wh_ ? s1 : s0) + sc_ + (lane & 7) * 4 + (size_t)(kb_ * 64 + kq) * Ns; \
        _Pragma("unroll") for (int i = 0; i < 8; ++i) dst_[i] = *(const f32x4*)(sp_ + (size_t)(8 * i) * Ns); } while (0)
    float gv[8];
#pragma unroll
    for (int i = 0; i < 8; ++i) gv[i] = 1.f;
    if (it < nitems) { CVP_LOAD(v, it); if (gain) { const int kb0 = it - (it / nkb) * nkb;
#pragma unroll
        for (int i = 0; i < 8; ++i) gv[i] = gain[kb0 * 64 + 8 * i + kq]; } }
    for (; it < nitems; it += NGW) {
        const int rb = it / nkb, kb = it - rb * nkb, r0 = rb * 32, k0 = kb * 64; const int itn = it + NGW;
        f32x4 vn[8]; float gn[8];
#pragma unroll
        for (int i = 0; i < 8; ++i) { vn[i] = v[i]; gn[i] = gv[i]; }
        if (itn < nitems) { CVP_LOAD(vn, itn); if (gain) { const int kbn = itn - (itn / nkb) * nkb;
#pragma unroll
            for (int i = 0; i < 8; ++i) gn[i] = gain[kbn * 64 + 8 * i + kq]; } }
#pragma unroll
        for (int i = 0; i < 8; ++i) { f32x4 t = v[i]; if (gain) t = t * gv[i]; LAS float* sp = scr + (8 * i + kq) * 33 + (lane & 7) * 4; sp[0] = t[0]; sp[1] = t[1]; sp[2] = t[2]; sp[3] = t[3]; }
        asm volatile("s_waitcnt lgkmcnt(0)" ::: "memory");
        if (OUT8) {
#pragma unroll
            for (int j = 0; j < 2; ++j) { const int idx = lane + 64 * j, n = idx >> 2, cch = idx & 3; const LAS float* sq = scr + (16 * cch) * 33 + n; int w[4];
#pragma unroll
                for (int q = 0; q < 4; ++q) { int t = 0; t = __builtin_amdgcn_cvt_pk_fp8_f32(sq[(4 * q) * 33] * oscale, sq[(4 * q + 1) * 33] * oscale, t, false); t = __builtin_amdgcn_cvt_pk_fp8_f32(sq[(4 * q + 2) * 33] * oscale, sq[(4 * q + 3) * 33] * oscale, t, true); w[q] = t; }
                *(v4u*)((unsigned char*)dst + (size_t)(r0 + n) * Kd + koff + k0 + 16 * cch) = (v4u){(unsigned)w[0], (unsigned)w[1], (unsigned)w[2], (unsigned)w[3]}; }
        } else {
            const int c = lane & 7;
#pragma unroll
            for (int j = 0; j < 4; ++j) { const int n = (lane >> 3) + 8 * j; const LAS float* sq = scr + (8 * c) * 33 + n;
                v4u o; o.x = pk2(sq[0 * 33], sq[1 * 33]); o.y = pk2(sq[2 * 33], sq[3 * 33]); o.z = pk2(sq[4 * 33], sq[5 * 33]); o.w = pk2(sq[6 * 33], sq[7 * 33]);
                *(v4u*)(dst + (size_t)(r0 + n) * Kd + koff + k0 + 8 * c) = o; }
        }
        asm volatile("s_waitcnt lgkmcnt(0)" ::: "memory");
#pragma unroll
        for (int i = 0; i < 8; ++i) { v[i] = vn[i]; gv[i] = gn[i]; }
    }
#undef CVP_LOAD
    rot = (rot + nitems) % NGW;
}
__device__ __forceinline__ void cvt_fold(const float* pw, const float* ps, const float* wo, bf16* dst, LAS float* scr, int gw, int NGW, int& rot, int lane) {
    const int nitems = 32 * 64;
    int first = gw - rot; if (first < 0) first += NGW;
    for (int it = first; it < nitems; it += NGW) {
        const int rb = it >> 6, gc = it & 63, g = gc >> 4, c0 = (gc & 15) * 8, n = rb * 32 + (lane & 31), ch = lane >> 5;
        float acc[4];
#pragma unroll
        for (int i = 0; i < 4; ++i) acc[i] = 0.f;
#pragma unroll 8
        for (int d = 0; d < 128; ++d) { const float wv = wo[(size_t)(512 + g * 128 + d) * D + n] * ps[g * 128 + d]; const float* pr = pw + ((size_t)g * 128 + c0 + ch) * 128 + d;
#pragma unroll
            for (int i = 0; i < 4; ++i) acc[i] += pr[(size_t)(2 * i) * 128] * wv; }
#pragma unroll
        for (int i = 0; i < 4; ++i) scr[(2 * i + ch) * 33 + (lane & 31)] = acc[i];
        asm volatile("s_waitcnt lgkmcnt(0)" ::: "memory");
        if (lane < 32) { const LAS float* s = scr + lane;
            v4u o; o.x = pk2(s[0 * 33], s[1 * 33]); o.y = pk2(s[2 * 33], s[3 * 33]); o.z = pk2(s[4 * 33], s[5 * 33]); o.w = pk2(s[6 * 33], s[7 * 33]);
            *(v4u*)(dst + (size_t)(rb * 32 + lane) * D + 512 + g * 128 + c0) = o; }
        asm volatile("s_waitcnt lgkmcnt(0)" ::: "memory");
    }
    rot = (rot + nitems) % NGW;
}
__device__ __forceinline__ void cvt_flat(const float* src, bf16* dst, size_t n4, size_t gt, size_t GT) {
    for (size_t i = gt; i < n4; i += 4 * GT) { f32x4 v[4];
#pragma unroll
        for (int k = 0; k < 4; ++k) { const size_t ii = i + k * GT; v[k] = ((const f32x4*)src)[ii < n4 ? ii : i]; }
#pragma unroll
        for (int k = 0; k < 4; ++k) { const size_t ii = i + k * GT; if (ii < n4) { v2u w; w.x = pk2(v[k][0], v[k][1]); w.y = pk2(v[k][2], v[k][3]); ((v2u*)dst)[ii] = w; } } }
}

template <int DK, int DV, int TPQ, int KG, bool MOBA>
__device__ __forceinline__ void attn_naive(LAS unsigned char* lds, const bf16* Qp, int ldq, int qhp, const bf16* Kp, int ldk, int khp, const bf16* Vp, int ldv, int vhp,
                                           bf16* Op, int ldo, int ohp, int NH, float scale, const float* kmean, int G, int c) {
    constexpr int DKH = DK / TPQ, DVH = DV / TPQ, QT = NTHR / TPQ, NQT = SEQ / QT;
    static_assert(!MOBA || TPQ == 2, "MoBA units are whole 256-query blocks");
    LAS unsigned short* Ks = (LAS unsigned short*)lds;
    LAS unsigned short* Vs = Ks + 64 * DK;
    LAS unsigned* bmask = (LAS unsigned*)(lds + 64 * (DK + DV) * 2);
    const int tid = tid_fresh(), qi = tid / TPQ, half = tid % TPQ;
    const int nunits = NB * NH * NQT;
    for (int u = c; u < nunits; u += G) {
        const int qt = NQT - 1 - (u / (NB * NH)), bh = u % (NB * NH), b = bh / NH, h = bh % NH;
        const int tq = qt * QT + qi; const size_t row = (size_t)b * SEQ + tq;
        float q[DKH];
        { const v4u* qp = (const v4u*)(Qp + row * ldq + h * qhp + half * DKH);
#pragma unroll
          for (int i = 0; i < DKH / 8; ++i) { const v4u w = qp[i]; q[8 * i + 0] = bflo(w.x); q[8 * i + 1] = bfhi(w.x); q[8 * i + 2] = bflo(w.y); q[8 * i + 3] = bfhi(w.y);
              q[8 * i + 4] = bflo(w.z); q[8 * i + 5] = bfhi(w.z); q[8 * i + 6] = bflo(w.w); q[8 * i + 7] = bfhi(w.w); } }
        unsigned sel = 0u, bm = 0xffffffffu; float slope = 0.f;
        if (MOBA) {
            slope = exp2f(-(float)(h + 1));
            float t0 = -3e38f, t1 = -3e38f, t2 = -3e38f; int i0 = -1, i1 = -1, i2 = -1;
#pragma unroll 1
            for (int n = 0; n < qt; ++n) { const f32x4* km = (const f32x4*)(kmean + ((size_t)(b * NH + h) * 32 + n) * 64 + half * DKH); float g = 0.f;
#pragma unroll
                for (int i = 0; i < DKH / 4; ++i) { const f32x4 kv = km[i]; g += q[4 * i] * kv[0] + q[4 * i + 1] * kv[1] + q[4 * i + 2] * kv[2] + q[4 * i + 3] * kv[3]; }
#pragma unroll
                for (int o_ = 1; o_ < TPQ; o_ <<= 1) g += __shfl_xor(g, o_);
                if (g > t0) { t2 = t1; i2 = i1; t1 = t0; i1 = i0; t0 = g; i0 = n; } else if (g > t1) { t2 = t1; i2 = i1; t1 = g; i1 = n; } else if (g > t2) { t2 = g; i2 = n; } }
            if (i0 >= 0) sel |= 1u << i0; if (i1 >= 0) sel |= 1u << i1; if (i2 >= 0) sel |= 1u << i2;
            __syncthreads(); if (tid == 0) *bmask = 0u; __syncthreads(); if (sel) atomicOr((unsigned*)bmask, sel); __syncthreads(); bm = *bmask;
        }
        float m_run = -1e30f, l_run = 0.f; float o[DVH];
#pragma unroll
        for (int i = 0; i < DVH; ++i) o[i] = 0.f;
        const int nkt = (qt + 1) * QT / 64;
#pragma unroll 1
        for (int kt = 0; kt < nkt; ++kt) {
            const int n = kt >> 2; const bool own = (n == qt);
            if (MOBA && !own && !((bm >> n) & 1u)) continue;
            __syncthreads();
            { const bf16* kg = Kp + ((size_t)b * SEQ + kt * 64) * ldk + h * khp; const bf16* vg = Vp + ((size_t)b * SEQ + kt * 64) * ldv + h * vhp;
              for (int idx = tid; idx < 64 * DK / 8; idx += NTHR) { const int r = idx / (DK / 8), c8 = idx % (DK / 8); *(LAS v4u*)(Ks + r * DK + c8 * 8) = *(const v4u*)(kg + (size_t)r * ldk + c8 * 8); }
              for (int idx = tid; idx < 64 * DV / 8; idx += NTHR) { const int r = idx / (DV / 8), c8 = idx % (DV / 8); *(LAS v4u*)(Vs + r * DV + c8 * 8) = *(const v4u*)(vg + (size_t)r * ldv + c8 * 8); } }
            __syncthreads();
            const bool mine = MOBA ? (own || ((sel >> n) & 1u)) : true;
#pragma unroll 1
            for (int k4 = 0; k4 < 64; k4 += KG) {
                float s[KG];
#pragma unroll
                for (int j = 0; j < KG; ++j) { const LAS v4u* kr = (const LAS v4u*)(Ks + (k4 + j) * DK + half * DKH); float a = 0.f;
#pragma unroll
                    for (int i = 0; i < DKH / 8; ++i) { const v4u w = kr[i]; a += q[8 * i] * bflo(w.x) + q[8 * i + 1] * bfhi(w.x) + q[8 * i + 2] * bflo(w.y) + q[8 * i + 3] * bfhi(w.y)
                                                                      + q[8 * i + 4] * bflo(w.z) + q[8 * i + 5] * bfhi(w.z) + q[8 * i + 6] * bflo(w.w) + q[8 * i + 7] * bfhi(w.w); }
#pragma unroll
                    for (int o_ = 1; o_ < TPQ; o_ <<= 1) a += __shfl_xor(a, o_);
                    const int tk = kt * 64 + k4 + j; float sv = a * scale; if (MOBA) sv -= slope * (float)(tq - tk);
                    s[j] = (mine && tk <= tq) ? sv : -1e30f; }
                float mnew = m_run;
#pragma unroll
                for (int j = 0; j < KG; ++j) mnew = fmaxf(mnew, s[j]);
                const float corr = __expf(m_run - mnew); float p[KG]; float psum = 0.f;
#pragma unroll
                for (int j = 0; j < KG; ++j) { p[j] = (s[j] > -1e29f) ? __expf(s[j] - mnew) : 0.f; psum += p[j]; }
                l_run = l_run * corr + psum; m_run = mnew;
#pragma unroll
                for (int i = 0; i < DVH; ++i) o[i] *= corr;
#pragma unroll
                for (int j = 0; j < KG; ++j) { const LAS v4u* vr = (const LAS v4u*)(Vs + (k4 + j) * DV + half * DVH);
#pragma unroll
                    for (int i = 0; i < DVH / 8; ++i) { const v4u w = vr[i]; o[8 * i] += p[j] * bflo(w.x); o[8 * i + 1] += p[j] * bfhi(w.x); o[8 * i + 2] += p[j] * bflo(w.y); o[8 * i + 3] += p[j] * bfhi(w.y);
                        o[8 * i + 4] += p[j] * bflo(w.z); o[8 * i + 5] += p[j] * bfhi(w.z); o[8 * i + 6] += p[j] * bflo(w.w); o[8 * i + 7] += p[j] * bfhi(w.w); } }
            }
        }
        const float inv = 1.f / l_run; v4u* op = (v4u*)(Op + row * ldo + h * ohp + half * DVH);
#pragma unroll
        for (int i = 0; i < DVH / 8; ++i) { v4u w; w.x = pk2(o[8 * i] * inv, o[8 * i + 1] * inv); w.y = pk2(o[8 * i + 2] * inv, o[8 * i + 3] * inv); w.z = pk2(o[8 * i + 4] * inv, o[8 * i + 5] * inv); w.w = pk2(o[8 * i + 6] * inv, o[8 * i + 7] * inv); op[i] = w; }
    }
    __syncthreads();
}

namespace mla_attn {
constexpr int B = NB, H = 4, HKV = 4, SQ = SEQ, SKV = SEQ, D = 128, LD = 512, OLD = 1024, NQK = 6;
constexpr float THR = 8.f; constexpr bool WSKIP = false;
typedef unsigned short TIN_; typedef unsigned short TOUT_;
constexpr float SCALE = 0.10206207261596575f;
constexpr int NW = 8, QBLK = 32, KVBLK = 64, QB = NW * QBLK;
constexpr int SHM_V = KVBLK * D * 2, SHM_K = KVBLK * D * 2;
constexpr int LDS_BYTES = 2 * SHM_V + 2 * SHM_K + NW * 64 * 4;
static_assert(D == 128 && SQ % QB == 0 && SKV % KVBLK == 0, "geometry");

typedef short bf16x8 __attribute__((ext_vector_type(8)));
typedef short s16x4 __attribute__((ext_vector_type(4)));
typedef float f32x16 __attribute__((ext_vector_type(16)));
typedef unsigned u32x4 __attribute__((ext_vector_type(4)));
template <class A, class Bt> struct same_t { static constexpr bool v = false; };
template <class A> struct same_t<A, A> { static constexpr bool v = true; };

#define KSWZ(row, colB) ((row) * 256 + ((colB) ^ (((row) & 7) << 4)))
#define SBAR() __builtin_amdgcn_sched_barrier(0)
__device__ __forceinline__ int v_st(int k, int c) { const int kk = (k & ~0xC) | ((k & 4) << 1) | ((k & 8) >> 1); return ((kk >> 3) * 4 + (c >> 5)) * 512 + ((kk & 7) * 32 + (c & 31)) * 2; }
__device__ __forceinline__ int v_rd_base(int lane) { return ((lane & 3) << 3) | (((lane >> 2) & 3) << 6) | (((lane >> 4) & 1) << 5) | (((lane >> 5) & 1) << 8); }
constexpr int v_rd_off(int d0, int ks, int half) { return d0 * 512 + ks * 4096 + half * 2048; }
__device__ __forceinline__ int crow(int r, int hi) { return (r & 3) + 8 * (r >> 2) + 4 * hi; }
__device__ __forceinline__ unsigned cvtpk(float lo, float hi) {
    unsigned r; asm volatile("v_cvt_pk_bf16_f32 %0, %1, %2" : "=v"(r) : "v"(lo), "v"(hi)); return r;
}
__device__ __forceinline__ bf16x8 pack8(f32x4 a, f32x4 b) {
    u32x4 w = {cvtpk(a[0], a[1]), cvtpk(a[2], a[3]), cvtpk(b[0], b[1]), cvtpk(b[2], b[3])};
    return *reinterpret_cast<bf16x8*>(&w);
}
template <class T> __device__ __forceinline__ bf16x8 load8(const T* p) {
    if constexpr (same_t<T, float>::v) { return pack8(*(const f32x4*)p, *(const f32x4*)(p + 4)); }
    else { return *reinterpret_cast<const bf16x8*>(p); }
}
__device__ __forceinline__ void mask_tile(f32x16& p0, f32x16& p1, int dq, unsigned W) {
    const float NEG = -__builtin_inff();
#pragma unroll
    for (int r = 0; r < 16; ++r) {
        const int c = (r & 3) + 8 * (r >> 2);
        if ((unsigned)(dq - c) >= W) p0[r] = NEG;
        if ((unsigned)(dq - c - 32) >= W) p1[r] = NEG;
    }
}
__device__ __forceinline__ void partialSM(f32x16& p0, f32x16& p1, float& m_reg, float& mn, float& alpha) {
    float pmax = p0[0]; for (int r = 1; r < 16; ++r) pmax = fmaxf(pmax, p0[r]); for (int r = 0; r < 16; ++r) pmax = fmaxf(pmax, p1[r]);
    { auto rr = __builtin_amdgcn_permlane32_swap(__float_as_uint(pmax), __float_as_uint(pmax), false, false);
      pmax = fmaxf(__uint_as_float(rr[0]), __uint_as_float(rr[1])); }
    constexpr float C2 = 1.4426950408889634f * SCALE;
    if (__builtin_expect(__all((pmax - m_reg) * SCALE <= THR), 1)) { mn = m_reg; alpha = 1.f; }
    else { mn = fmaxf(m_reg, pmax); alpha = __builtin_amdgcn_exp2f((m_reg - mn) * C2); m_reg = mn; }
    const float mnL = -mn * C2;
    for (int r = 0; r < 16; ++r) p0[r] = fmaf(p0[r], C2, mnL); for (int r = 0; r < 16; ++r) p1[r] = fmaf(p1[r], C2, mnL);
    for (int r = 0; r < 16; ++r) p0[r] = __builtin_amdgcn_exp2f(p0[r]);
}
__device__ __forceinline__ void finishSM(f32x16& p0, f32x16& p1, float alpha, float& l_reg, bf16x8& pa0, bf16x8& pa1, bf16x8& pa2, bf16x8& pa3) {
    for (int r = 0; r < 16; ++r) p1[r] = __builtin_amdgcn_exp2f(p1[r]);
    float ps = 0; for (int r = 0; r < 16; ++r) ps += p0[r]; for (int r = 0; r < 16; ++r) ps += p1[r];
    { auto rr = __builtin_amdgcn_permlane32_swap(__float_as_uint(ps), __float_as_uint(ps), false, false);
      ps = __uint_as_float(rr[0]) + __uint_as_float(rr[1]); }
    l_reg = l_reg * alpha + ps;
#define PK4(P, B_, OUT) do { unsigned a0 = cvtpk(P[B_+0], P[B_+1]), a1 = cvtpk(P[B_+2], P[B_+3]);                          \
        unsigned b0 = cvtpk(P[B_+4], P[B_+5]), b1 = cvtpk(P[B_+6], P[B_+7]);                                             \
        auto r0 = __builtin_amdgcn_permlane32_swap(a0, b0, false, false); auto r1 = __builtin_amdgcn_permlane32_swap(a1, b1, false, false); \
        u32x4 w = {r0[0], r1[0], r0[1], r1[1]}; OUT = *reinterpret_cast<bf16x8*>(&w); } while (0)
    PK4(p0, 0, pa0); PK4(p0, 8, pa1); PK4(p1, 0, pa2); PK4(p1, 8, pa3);
#undef PK4
}
template <int KB, bool SK>
__device__ __forceinline__ void qkt(f32x16& p0, f32x16& p1, const char* K_lds, int r32, int hi, const bf16x8* qr, bool act) {
    if (SK && !act) { const float NEG = -__builtin_inff();
#pragma unroll
        for (int r = 0; r < 16; ++r) { p0[r] = NEG; p1[r] = NEG; } return; }
    p0 = f32x16{}; p1 = f32x16{};
    const char* kb[4];
#pragma unroll
    for (int dd = 0; dd < 4; ++dd) kb[dd] = K_lds + KB * SHM_K + KSWZ(r32, (dd * 16 + hi * 8) * 2);
#pragma unroll
    for (int d0 = 0; d0 < NQK; ++d0) { const char* a = kb[d0 & 3] + (d0 >> 2) * 128;
        bf16x8 b0 = *reinterpret_cast<const bf16x8*>(a);
        bf16x8 b1 = *reinterpret_cast<const bf16x8*>(a + 32 * 256);
        p0 = __builtin_amdgcn_mfma_f32_32x32x16_bf16(b0, qr[d0], p0, 0, 0, 0);
        p1 = __builtin_amdgcn_mfma_f32_32x32x16_bf16(b1, qr[d0], p1, 0, 0, 0); }
}
template <int VB, bool SK>
__device__ __forceinline__ void pv_tile(f32x16* o, int vb0, bf16x8 pa0, bf16x8 pa1, bf16x8 pa2, bf16x8 pa3, bool act) {
    if (SK && !act) return;
#define TRRD(dst, off) asm volatile("ds_read_b64_tr_b16 %0, %1 offset:%2" : "=&v"(dst) : "v"(vb0), "i"(off) : "memory")
#define PV_D0(d0) do { s16x4 l0, l1, l2, l3, h0, h1, h2, h3; constexpr int b_ = VB * SHM_V + v_rd_off(d0, 0, 0);     \
        TRRD(l0, b_); TRRD(h0, b_ + 2048); TRRD(l1, b_ + 4096); TRRD(h1, b_ + 6144); TRRD(l2, b_ + 8192); TRRD(h2, b_ + 10240); TRRD(l3, b_ + 12288); TRRD(h3, b_ + 14336); \
        asm volatile("s_waitcnt lgkmcnt(0)" ::: "memory"); SBAR();                 \
        o[d0] = __builtin_amdgcn_mfma_f32_32x32x16_bf16(pa0, (bf16x8){l0[0], l0[1], l0[2], l0[3], h0[0], h0[1], h0[2], h0[3]}, o[d0], 0, 0, 0);   \
        o[d0] = __builtin_amdgcn_mfma_f32_32x32x16_bf16(pa1, (bf16x8){l1[0], l1[1], l1[2], l1[3], h1[0], h1[1], h1[2], h1[3]}, o[d0], 0, 0, 0);   \
        o[d0] = __builtin_amdgcn_mfma_f32_32x32x16_bf16(pa2, (bf16x8){l2[0], l2[1], l2[2], l2[3], h2[0], h2[1], h2[2], h2[3]}, o[d0], 0, 0, 0);   \
        o[d0] = __builtin_amdgcn_mfma_f32_32x32x16_bf16(pa3, (bf16x8){l3[0], l3[1], l3[2], l3[3], h3[0], h3[1], h3[2], h3[3]}, o[d0], 0, 0, 0); } while (0)
    PV_D0(0); PV_D0(1); PV_D0(2); PV_D0(3);
#undef PV_D0
#undef TRRD
}

template <class TIn, class TOut> struct BlockRef { const TIn* Q; const TIn* K; const TIn* V; TOut* O; int P0; };
template <class TIn> struct Seam {
    bf16x8 qr[8];
    bf16x8 st_v0, st_v1, st_k0, st_k1; f32x4 sf0, sf1, sf2, sf3;
    f32x4 tq[16];
};
__device__ __forceinline__ int swa_jlo(int P0, int W) { const int lowk = P0 - W + 1; return lowk > 0 ? lowk / KVBLK : 0; }
#define ROW(p, k0, rr) ((p) + (size_t)((k0) + (rr)) * LD + sc)
#define VMW() asm volatile("s_waitcnt vmcnt(0)" ::: "memory")
#define VMWN(n) asm volatile("s_waitcnt vmcnt(%0)" :: "i"(n) : "memory")
#define SLOAD_H(Kp, Vp, k0) do { S.st_v0 = load8<TIn>(ROW(Vp, k0, sr)); S.st_v1 = load8<TIn>(ROW(Vp, k0, 32 + sr));              \
                         S.st_k0 = load8<TIn>(ROW(Kp, k0, sr)); S.st_k1 = load8<TIn>(ROW(Kp, k0, 32 + sr)); } while (0)
#define SWRITE_HK(bf) do { *(bf16x8*)(K_lds + (bf) * SHM_K + kws) = S.st_k0; *(bf16x8*)(K_lds + (bf) * SHM_K + kws + 32 * 256) = S.st_k1; } while (0)
#define SWRITE_HV(bf) do { *(bf16x8*)(V_lds + (bf) * SHM_V + vst0) = S.st_v0; *(bf16x8*)(V_lds + (bf) * SHM_V + vst1) = S.st_v1; } while (0)
#define SWRITE_H(bf) do { SWRITE_HV(bf); SWRITE_HK(bf); } while (0)
#define SLOAD_F(p, k0) do { S.sf0 = *(const f32x4*)ROW(p, k0, sr); S.sf1 = *(const f32x4*)(ROW(p, k0, sr) + 4);                \
                            S.sf2 = *(const f32x4*)ROW(p, k0, 32 + sr); S.sf3 = *(const f32x4*)(ROW(p, k0, 32 + sr) + 4); } while (0)
#define SWRITE_KF(bf) do { *(bf16x8*)(K_lds + (bf) * SHM_K + kws) = pack8(S.sf0, S.sf1); *(bf16x8*)(K_lds + (bf) * SHM_K + kws + 32 * 256) = pack8(S.sf2, S.sf3); } while (0)
#define SWRITE_VF(bf) do { *(bf16x8*)(V_lds + (bf) * SHM_V + vst0) = pack8(S.sf0, S.sf1); *(bf16x8*)(V_lds + (bf) * SHM_V + vst1) = pack8(S.sf2, S.sf3); } while (0)
template <class TIn, class TOut>
__device__ __forceinline__ void causal_swa_prime(const BlockRef<TIn, TOut>& cur, int W, char* lds, Seam<TIn>& S) {
    constexpr bool F32 = same_t<TIn, float>::v;
    const int tid = tid_fresh(), wid = __builtin_amdgcn_readfirstlane(tid >> 6), lane = tid & 63, r32 = lane & 31, hi = lane >> 5;
    const int sr = tid >> 4, sc = (tid & 15) * 8, kws = KSWZ(sr, sc * 2); char* K_lds = lds + 2 * SHM_V;
    const int kb0 = swa_jlo(cur.P0, W) * KVBLK;
    for (int d0 = 0; d0 < NQK; ++d0) S.qr[d0] = load8<TIn>(cur.Q + (size_t)(wid * QBLK + r32) * LD + d0 * 16 + hi * 8);
    if constexpr (F32) { SLOAD_F((const float*)cur.K, kb0); VMW(); SWRITE_KF(0); SBAR(); SLOAD_F((const float*)cur.V, kb0); }
    else { SLOAD_H(cur.K, cur.V, kb0); VMW(); SWRITE_HK(0); }
    __syncthreads();
}
template <class TIn, class TOut>
__device__ __forceinline__ void causal_swa_block(const BlockRef<TIn, TOut>& cur, const BlockRef<TIn, TOut>& nxt, int skv, int W, char* lds, Seam<TIn>& S) {
    constexpr bool F32 = same_t<TIn, float>::v;
    const int tid = tid_fresh(), wid = __builtin_amdgcn_readfirstlane(tid >> 6), lane = tid & 63, r32 = lane & 31, hi = lane >> 5;
    const int j_lo = swa_jlo(cur.P0, W);
    int j_hi = (cur.P0 + QB - 1) / KVBLK + 1; if (j_hi > skv / KVBLK) j_hi = skv / KVBLK;
    const int NT = j_hi - j_lo;
    const int kbn = swa_jlo(nxt.P0, W) * KVBLK;
    const int qlo = cur.P0 + wid * QBLK, qm = qlo + r32 - 4 * hi;
    char* V_lds = lds; char* K_lds = lds + 2 * SHM_V;
    float* ws = (float*)(lds + 2 * SHM_V + 2 * SHM_K) + wid * 64; float* li_l = ws, * al_l = ws + 32;
    float m_reg = -1e30f, l_reg = 0; f32x16 o[4] = {};
    const int sr = tid >> 4, sc = (tid & 15) * 8, vst0 = v_st(sr, sc), vst1 = v_st(32 + sr, sc), kws = KSWZ(sr, sc * 2);
    const int vb0 = (int)(uintptr_t)V_lds + v_rd_base(lane);
    const TIn* Kh = cur.K; const TIn* Vh = cur.V;
#define RESC(a) do { if (__any((a) < 1.f)) { if (hi == 0) al_l[r32] = (a); asm volatile("s_waitcnt lgkmcnt(0)" ::: "memory");              \
                     for (int d_ = 0; d_ < 4; ++d_) for (int r = 0; r < 16; ++r) o[d_][r] *= al_l[crow(r, hi)]; } } while (0)
#define KBASE(t) ((j_lo + (t)) * KVBLK)
#define ACT(t) (KBASE(t) <= qlo + QBLK - 1 && KBASE(t) + KVBLK - 1 >= qlo - W + 1)
#define MASKT(P0_, P1_, t) do { const int kb_ = KBASE(t); if ((!SK || ACT(t)) && (kb_ + KVBLK - 1 > qlo || kb_ <= qlo + QBLK - 1 - W)) mask_tile(P0_, P1_, qm - kb_, (unsigned)W); } while (0)
    constexpr int NQL = F32 ? 16 : NQK;
    constexpr bool SK = WSKIP && !F32;
#define SEAM_K0() do { VMWN(NQL); if constexpr (F32) { SWRITE_KF(0); SBAR(); SLOAD_F((const float*)nxt.V, kbn); } else { SWRITE_HK(0); } SBAR(); } while (0)
    f32x16 pA0, pA1, pB0, pB1; float mnA, mnB, alA, alB; bf16x8 pa0, pa1, pa2, pa3;
    if constexpr (F32) { VMW(); SWRITE_VF(0); SBAR(); } else { SWRITE_HV(0); SBAR(); }
    if (NT > 1) { if constexpr (F32) SLOAD_F((const float*)Kh, KBASE(1)); else SLOAD_H(Kh, Vh, KBASE(1)); }
    SBAR(); qkt<0, SK>(pA0, pA1, K_lds, r32, hi, S.qr, ACT(0));
    if constexpr (F32) { if (NT > 1) { VMW(); SWRITE_KF(1); SBAR(); SLOAD_F((const float*)Vh, KBASE(1)); } }
    MASKT(pA0, pA1, 0); partialSM(pA0, pA1, m_reg, mnA, alA);
    if (NT > 1) { VMW(); if constexpr (F32) { SWRITE_VF(1); SBAR(); if (NT > 2) SLOAD_F((const float*)Kh, KBASE(2)); } else SWRITE_H(1); }
    __syncthreads();
#define HALF_STEP(PX0, PX1, mnX, alX, PY0, PY1, alY, t, KB, VB, SB) do {                                                      \
        SBAR(); qkt<KB, SK>(PX0, PX1, K_lds, r32, hi, S.qr, ACT(t));                                             \
        finishSM(PY0, PY1, alY, l_reg, pa0, pa1, pa2, pa3); SBAR();                                                           \
        if ((t) + 1 < NT) { if constexpr (F32) { VMW(); SWRITE_KF(SB); SBAR(); SLOAD_F((const float*)Vh, KBASE((t) + 1)); }  \
                            else { SLOAD_H(Kh, Vh, KBASE((t) + 1)); } SBAR(); }                                               \
        pv_tile<VB, SK>(o, vb0, pa0, pa1, pa2, pa3, ACT((t) - 1)); MASKT(PX0, PX1, (t)); partialSM(PX0, PX1, m_reg, mnX, alX);                                        \
        __syncthreads();                                                                                                      \
        if ((t) + 1 < NT) { VMW(); if constexpr (F32) { SWRITE_VF(SB); SBAR(); if ((t) + 2 < NT) SLOAD_F((const float*)Kh, KBASE((t) + 2)); } \
                            else { SWRITE_H(SB); } }                                                                          \
        RESC(alX); __syncthreads(); } while (0)
    for (int t = 1; t + 1 < NT; t += 2) {
        HALF_STEP(pB0, pB1, mnB, alB, pA0, pA1, alA, t, 1, 0, 0);
        HALF_STEP(pA0, pA1, mnA, alA, pB0, pB1, alB, t + 1, 0, 1, 1);
    }
    const bool even = (NT & 1) == 0;
    if (even) { SBAR(); qkt<1, SK>(pB0, pB1, K_lds, r32, hi, S.qr, ACT(NT - 1)); SBAR(); }
#define QROW(e) (nxt.Q + (size_t)(wid * QBLK + r32) * LD + ((e) >> 1) * 16 + hi * 8 + ((e) & 1) * 4)
    if constexpr (F32) { SLOAD_F((const float*)nxt.K, kbn); SBAR();
#pragma unroll
        for (int e = 0; e < 8; ++e) S.tq[e] = *(const f32x4*)QROW(e); }
    else { SLOAD_H(nxt.K, nxt.V, kbn); SBAR();
#pragma unroll
        for (int d0 = 0; d0 < NQK; ++d0) S.qr[d0] = load8<TIn>(nxt.Q + (size_t)(wid * QBLK + r32) * LD + d0 * 16 + hi * 8); }
    SBAR();
    finishSM(pA0, pA1, alA, l_reg, pa0, pa1, pa2, pa3); SBAR();
    if constexpr (F32) {
#pragma unroll
        for (int e = 8; e < 16; ++e) S.tq[e] = *(const f32x4*)QROW(e); SBAR(); }
#undef QROW
    pv_tile<0, SK>(o, vb0, pa0, pa1, pa2, pa3, ACT(even ? NT - 2 : NT - 1));
    if (even) { MASKT(pB0, pB1, NT - 1); partialSM(pB0, pB1, m_reg, mnB, alB); __syncthreads(); RESC(alB);
        finishSM(pB0, pB1, alB, l_reg, pa0, pa1, pa2, pa3); SBAR(); pv_tile<1, SK>(o, vb0, pa0, pa1, pa2, pa3, ACT(NT - 1)); }
    SBAR(); SEAM_K0();
    if (hi == 0) li_l[r32] = l_reg; asm volatile("s_waitcnt lgkmcnt(0)" ::: "memory");
    float rli[16];
#pragma unroll
    for (int r = 0; r < 16; ++r) rli[r] = __builtin_amdgcn_rcpf(li_l[crow(r, hi)]);
    TOut* Ow = cur.O + (size_t)(wid * QBLK) * OLD;
#pragma unroll
    for (int r = 0; r < 16; ++r) { const int orow = crow(r, hi);
#pragma unroll
        for (int d0 = 0; d0 < 4; ++d0) { const float v = o[d0][r] * rli[r];
            if constexpr (same_t<TOut, float>::v) { Ow[(size_t)orow * OLD + d0 * 32 + r32] = v; }
            else { const float vn = __shfl_xor(v, 1);
                   if ((r32 & 1) == 0) *(unsigned*)(Ow + (size_t)orow * OLD + d0 * 32 + r32) = cvtpk(v, vn); } } }
    if constexpr (F32) {
#pragma unroll
        for (int d0 = 0; d0 < 8; ++d0) S.qr[d0] = pack8(S.tq[2 * d0], S.tq[2 * d0 + 1]); }
    __syncthreads();
#undef RESC
#undef KBASE
#undef ACT
#undef MASKT
#undef SEAM_K0
#undef HALF_STEP
}
#undef ROW
#undef VMW
#undef VMWN
#undef SLOAD_H
#undef SWRITE_HK
#undef SWRITE_HV
#undef SWRITE_H
#undef SLOAD_F
#undef SWRITE_KF
#undef SWRITE_VF

typedef BlockRef<bf16, bf16> BR;
__device__ __forceinline__ BR mk_ref(int L, int pass, const bf16* Qm, const bf16* Km, const bf16* Vm, bf16* O) {
    const int xcd = L & 7, k = L >> 3, bh = xcd * 2 + (k >> 4), x = k & 15, qb = pass ? 31 - x : x, b = bh >> 2, h = bh & 3;
    BR r; r.Q = Qm + ((size_t)b * SEQ + qb * QB) * LD + h * D; r.K = Km + (size_t)b * SEQ * LD + h * D; r.V = Vm + (size_t)b * SEQ * LD + h * D;
    r.O = O + ((size_t)b * SEQ + qb * QB) * OLD + h * D; r.P0 = qb * QB; return r;
}
__device__ __forceinline__ void phase(char* lds, const bf16* Qm, const bf16* Km, const bf16* Vm, bf16* O, int G, int c) {
    constexpr int TOTAL = NB * H * 16;
    int L = c; if (L >= TOTAL) return; int pass = 0;
    BR cur = mk_ref(L, 0, Qm, Km, Vm, O);
    Seam<bf16> S;
    causal_swa_prime<bf16, bf16>(cur, SEQ, lds, S);
    for (;;) {
        const bool more_pass = pass == 0, more_item = L + G < TOTAL, last = !more_pass && !more_item;
        int passn = pass + 1, Ln = L;
        if (!more_pass) { passn = 0; Ln = more_item ? L + G : L; }
        const BR nxt = last ? cur : mk_ref(Ln, passn, Qm, Km, Vm, O);
        causal_swa_block<bf16, bf16>(cur, nxt, SEQ, SEQ, lds, S);
        if (last) break;
        cur = nxt; pass = passn; L = Ln;
    }
}
}

namespace moba_attn {
using mla_attn::bf16x8; using mla_attn::s16x4; using mla_attn::f32x16; using mla_attn::u32x4; using mla_attn::crow; using mla_attn::cvtpk; using mla_attn::v_rd_base;
constexpr int D = 64, LD = U0W, OLD = 1024, NH = 8;
constexpr float SCALE = 0.125f, THR = 8.f;
constexpr int NW = 8, QBLK = 32, KVBLK = 64, QB = NW * QBLK;
constexpr int SHM_V = KVBLK * D * 2, SHM_K = KVBLK * D * 2;
constexpr int LDS_BYTES = 2 * SHM_V + 2 * SHM_K + NW * 64 * 4;
#define KSWZ64(row, colB) ((row) * 128 + ((colB) ^ (((row) & 7) << 4)))
#define SBAR() __builtin_amdgcn_sched_barrier(0)
__device__ __forceinline__ int v_st(int k, int c) { const int kk = (k & ~0xC) | ((k & 4) << 1) | ((k & 8) >> 1); return ((kk >> 3) * 2 + (c >> 5)) * 512 + ((kk & 7) * 32 + (c & 31)) * 2; }
__device__ __forceinline__ void mask_causal(f32x16& p0, f32x16& p1, int dq) {
    const float NEG = -__builtin_inff();
#pragma unroll
    for (int r = 0; r < 16; ++r) { const int c = (r & 3) + 8 * (r >> 2); if (dq - c < 0) p0[r] = NEG; if (dq - c - 32 < 0) p1[r] = NEG; }
}
__device__ __forceinline__ void mask_row(f32x16& p0, f32x16& p1, bool keep) {
    const float NEG = -__builtin_inff();
#pragma unroll
    for (int r = 0; r < 16; ++r) { p0[r] = keep ? p0[r] : NEG; p1[r] = keep ? p1[r] : NEG; }
}
__device__ __forceinline__ void alibi(f32x16& p0, f32x16& p1, float sb, float base) {
    const float t0 = sb * base;
#pragma unroll
    for (int r = 0; r < 16; ++r) { const float c = (float)((r & 3) + 8 * (r >> 2)); p0[r] += fmaf(sb, c, t0); p1[r] += fmaf(sb, c + 32.f, t0); }
}
__device__ __forceinline__ void partialSM(f32x16& p0, f32x16& p1, float& m_reg, float& mn, float& alpha) {
    float pmax = p0[0]; for (int r = 1; r < 16; ++r) pmax = fmaxf(pmax, p0[r]); for (int r = 0; r < 16; ++r) pmax = fmaxf(pmax, p1[r]);
    { auto rr = __builtin_amdgcn_permlane32_swap(__float_as_uint(pmax), __float_as_uint(pmax), false, false);
      pmax = fmaxf(__uint_as_float(rr[0]), __uint_as_float(rr[1])); }
    constexpr float C2 = 1.4426950408889634f * SCALE;
    if (__builtin_expect(__all((pmax - m_reg) * SCALE <= THR), 1)) { mn = m_reg; alpha = 1.f; }
    else { mn = fmaxf(m_reg, pmax); alpha = __builtin_amdgcn_exp2f((m_reg - mn) * C2); m_reg = mn; }
    const float mnL = -mn * C2;
    for (int r = 0; r < 16; ++r) p0[r] = fmaf(p0[r], C2, mnL); for (int r = 0; r < 16; ++r) p1[r] = fmaf(p1[r], C2, mnL);
    for (int r = 0; r < 16; ++r) p0[r] = __builtin_amdgcn_exp2f(p0[r]);
}
__device__ __forceinline__ void finishSM(f32x16& p0, f32x16& p1, float alpha, float& l_reg, bf16x8& pa0, bf16x8& pa1, bf16x8& pa2, bf16x8& pa3) {
    for (int r = 0; r < 16; ++r) p1[r] = __builtin_amdgcn_exp2f(p1[r]);
    float ps = 0; for (int r = 0; r < 16; ++r) ps += p0[r]; for (int r = 0; r < 16; ++r) ps += p1[r];
    { auto rr = __builtin_amdgcn_permlane32_swap(__float_as_uint(ps), __float_as_uint(ps), false, false);
      ps = __uint_as_float(rr[0]) + __uint_as_float(rr[1]); }
    l_reg = l_reg * alpha + ps;
#define PK4(P, B_, OUT) do { unsigned a0 = cvtpk(P[B_+0], P[B_+1]), a1 = cvtpk(P[B_+2], P[B_+3]);                          \
        unsigned b0 = cvtpk(P[B_+4], P[B_+5]), b1 = cvtpk(P[B_+6], P[B_+7]);                                             \
        auto r0 = __builtin_amdgcn_permlane32_swap(a0, b0, false, false); auto r1 = __builtin_amdgcn_permlane32_swap(a1, b1, false, false); \
        u32x4 w = {r0[0], r1[0], r0[1], r1[1]}; OUT = *reinterpret_cast<bf16x8*>(&w); } while (0)
    PK4(p0, 0, pa0); PK4(p0, 8, pa1); PK4(p1, 0, pa2); PK4(p1, 8, pa3);
#undef PK4
}
template <int KB>
__device__ __forceinline__ void qkt(f32x16& p0, f32x16& p1, const char* K_lds, int r32, int hi, const bf16x8* qr) {
    p0 = f32x16{}; p1 = f32x16{};
#pragma unroll
    for (int d0 = 0; d0 < 4; ++d0) { const char* a = K_lds + KB * SHM_K + KSWZ64(r32, (d0 * 16 + hi * 8) * 2);
        bf16x8 b0 = *reinterpret_cast<const bf16x8*>(a);
        bf16x8 b1 = *reinterpret_cast<const bf16x8*>(a + 32 * 128);
        p0 = __builtin_amdgcn_mfma_f32_32x32x16_bf16(b0, qr[d0], p0, 0, 0, 0);
        p1 = __builtin_amdgcn_mfma_f32_32x32x16_bf16(b1, qr[d0], p1, 0, 0, 0); }
}
template <int VB>
__device__ __forceinline__ void pv_tile(f32x16* o, int vb0, bf16x8 pa0, bf16x8 pa1, bf16x8 pa2, bf16x8 pa3) {
#define TRRD(dst, off) asm volatile("ds_read_b64_tr_b16 %0, %1 offset:%2" : "=&v"(dst) : "v"(vb0), "i"(off) : "memory")
#define PV_D0(d0) do { s16x4 l0, l1, l2, l3, h0, h1, h2, h3; constexpr int b_ = VB * SHM_V + (d0) * 512;     \
        TRRD(l0, b_); TRRD(h0, b_ + 1024); TRRD(l1, b_ + 2048); TRRD(h1, b_ + 3072); TRRD(l2, b_ + 4096); TRRD(h2, b_ + 5120); TRRD(l3, b_ + 6144); TRRD(h3, b_ + 7168); \
        asm volatile("s_waitcnt lgkmcnt(0)" ::: "memory"); SBAR();   \
        o[d0] = __builtin_amdgcn_mfma_f32_32x32x16_bf16(pa0, (bf16x8){l0[0], l0[1], l0[2], l0[3], h0[0], h0[1], h0[2], h0[3]}, o[d0], 0, 0, 0);   \
        o[d0] = __builtin_amdgcn_mfma_f32_32x32x16_bf16(pa1, (bf16x8){l1[0], l1[1], l1[2], l1[3], h1[0], h1[1], h1[2], h1[3]}, o[d0], 0, 0, 0);   \
        o[d0] = __builtin_amdgcn_mfma_f32_32x32x16_bf16(pa2, (bf16x8){l2[0], l2[1], l2[2], l2[3], h2[0], h2[1], h2[2], h2[3]}, o[d0], 0, 0, 0);   \
        o[d0] = __builtin_amdgcn_mfma_f32_32x32x16_bf16(pa3, (bf16x8){l3[0], l3[1], l3[2], l3[3], h3[0], h3[1], h3[2], h3[3]}, o[d0], 0, 0, 0); } while (0)
    PV_D0(0); PV_D0(1);
#undef PV_D0
#undef TRRD
}
struct BlockRef { const bf16* Q; const bf16* K; const bf16* V; bf16* O; int P0, bh; };
struct Seam { bf16x8 qr[4]; bf16x8 st_v0, st_k0; };
#define ROW(p, k0) ((p) + (size_t)((k0) + sr) * LD + sc)
#define VMW() asm volatile("s_waitcnt vmcnt(0)" ::: "memory")
#define VMWN(n) asm volatile("s_waitcnt vmcnt(%0)" :: "i"(n) : "memory")
#define SLOAD(Kp, Vp, k0) do { S.st_v0 = *reinterpret_cast<const bf16x8*>(ROW(Vp, k0)); S.st_k0 = *reinterpret_cast<const bf16x8*>(ROW(Kp, k0)); } while (0)
#define SWRITE_K(bf) do { *(bf16x8*)(K_lds + (bf) * SHM_K + kws) = S.st_k0; } while (0)
#define SWRITE_V(bf) do { *(bf16x8*)(V_lds + (bf) * SHM_V + vst0) = S.st_v0; } while (0)
__device__ __forceinline__ void prime(const BlockRef& cur, char* lds, Seam& S) {
    const int tid = tid_fresh(), wid = __builtin_amdgcn_readfirstlane(tid >> 6), lane = tid & 63, r32 = lane & 31, hi = lane >> 5;
    const int sr = tid >> 3, sc = (tid & 7) * 8, kws = KSWZ64(sr, sc * 2); char* K_lds = lds + 2 * SHM_V;
#pragma unroll
    for (int d0 = 0; d0 < 4; ++d0) S.qr[d0] = *reinterpret_cast<const bf16x8*>(cur.Q + (size_t)(wid * QBLK + r32) * LD + d0 * 16 + hi * 8);
    SLOAD(cur.K, cur.V, 0); VMW(); SWRITE_K(0);
    __syncthreads();
}
__device__ __forceinline__ void block(const BlockRef& cur, const BlockRef& nxt, const float* kmean, char* lds, Seam& S) {
    const int tid = tid_fresh(), wid = __builtin_amdgcn_readfirstlane(tid >> 6), lane = tid & 63, r32 = lane & 31, hi = lane >> 5;
    const int qb = cur.P0 / QB, NT = 4 * (qb + 1);
    const int qlo = cur.P0 + wid * QBLK, qm = qlo + r32 - 4 * hi;
    char* V_lds = lds; char* K_lds = lds + 2 * SHM_V;
    float* ws = (float*)(lds + 2 * SHM_V + 2 * SHM_K) + wid * 64; float* li_l = ws, * al_l = ws + 32;
    const int sr = tid >> 3, sc = (tid & 7) * 8, vst0 = v_st(sr, sc), kws = KSWZ64(sr, sc * 2);
    const int vb0 = (int)(uintptr_t)V_lds + v_rd_base(lane);
    const bf16* Kh = cur.K; const bf16* Vh = cur.V;
    const float sb = exp2f(-(float)((cur.bh & (NH - 1)) + 1)) * (1.f / SCALE);
    unsigned sel = 0u;
    { float qf[32];
#pragma unroll
      for (int d0 = 0; d0 < 4; ++d0)
#pragma unroll
          for (int j = 0; j < 8; ++j) qf[8 * d0 + j] = __uint_as_float(((unsigned)(unsigned short)S.qr[d0][j]) << 16);
      float t0 = -3e38f, t1 = -3e38f, t2 = -3e38f; int i0 = -1, i1 = -1, i2 = -1;
#pragma unroll 1
      for (int n = 0; n < qb; ++n) { const float* km = kmean + ((size_t)cur.bh * 32 + n) * 64 + hi * 8; float g = 0.f;
#pragma unroll
          for (int d0 = 0; d0 < 4; ++d0) { const f32x4 k0 = *(const f32x4*)(km + d0 * 16), k1 = *(const f32x4*)(km + d0 * 16 + 4);
              g += qf[8 * d0] * k0[0] + qf[8 * d0 + 1] * k0[1] + qf[8 * d0 + 2] * k0[2] + qf[8 * d0 + 3] * k0[3] + qf[8 * d0 + 4] * k1[0] + qf[8 * d0 + 5] * k1[1] + qf[8 * d0 + 6] * k1[2] + qf[8 * d0 + 7] * k1[3]; }
          g += __shfl_xor(g, 32);
          if (g > t0) { t2 = t1; i2 = i1; t1 = t0; i1 = i0; t0 = g; i0 = n; } else if (g > t1) { t2 = t1; i2 = i1; t1 = g; i1 = n; } else if (g > t2) { t2 = g; i2 = n; } }
      if (i0 >= 0) sel |= 1u << i0; if (i1 >= 0) sel |= 1u << i1; if (i2 >= 0) sel |= 1u << i2; }
    float m_reg = -1e30f, l_reg = 0; f32x16 o[2] = {};
#define RESC(a) do { if (__any((a) < 1.f)) { if (hi == 0) al_l[r32] = (a); asm volatile("s_waitcnt lgkmcnt(0)" ::: "memory");              \
                     for (int d_ = 0; d_ < 2; ++d_) for (int r = 0; r < 16; ++r) o[d_][r] *= al_l[crow(r, hi)]; } } while (0)
#define KBASE(t) ((t) * KVBLK)
#define MASKT(P0_, P1_, t) do { const int kb_ = KBASE(t); alibi(P0_, P1_, sb, (float)(kb_ - cur.P0 + 4 * hi));                                  \
        if (kb_ < cur.P0) mask_row(P0_, P1_, ((sel >> (kb_ >> 8)) & 1u) != 0u); else if (kb_ + KVBLK - 1 > qlo) mask_causal(P0_, P1_, qm - kb_); } while (0)
#define SEAM_K0() do { VMWN(4); SWRITE_K(0); SBAR(); } while (0)
    f32x16 pA0, pA1, pB0, pB1; float mnA, mnB, alA, alB; bf16x8 pa0, pa1, pa2, pa3;
    SWRITE_V(0); SBAR();
    SLOAD(Kh, Vh, KBASE(1));
    SBAR(); qkt<0>(pA0, pA1, K_lds, r32, hi, S.qr);
    MASKT(pA0, pA1, 0); partialSM(pA0, pA1, m_reg, mnA, alA);
    VMW(); SWRITE_V(1); SWRITE_K(1);
    __syncthreads();
#define HALF_STEP(PX0, PX1, mnX, alX, PY0, PY1, alY, t, KB, VB, SB) do {                                                      \
        SBAR(); qkt<KB>(PX0, PX1, K_lds, r32, hi, S.qr);                                                                      \
        finishSM(PY0, PY1, alY, l_reg, pa0, pa1, pa2, pa3); SBAR();                                                           \
        if ((t) + 1 < NT) { SLOAD(Kh, Vh, KBASE((t) + 1)); SBAR(); }                                                          \
        pv_tile<VB>(o, vb0, pa0, pa1, pa2, pa3); MASKT(PX0, PX1, (t)); partialSM(PX0, PX1, m_reg, mnX, alX);                  \
        __syncthreads();                                                                                                      \
        if ((t) + 1 < NT) { VMW(); SWRITE_V(SB); SWRITE_K(SB); }                                                              \
        RESC(alX); __syncthreads(); } while (0)
#pragma unroll 1
    for (int t = 1; t + 1 < NT; t += 2) {
        HALF_STEP(pB0, pB1, mnB, alB, pA0, pA1, alA, t, 1, 0, 0);
        HALF_STEP(pA0, pA1, mnA, alA, pB0, pB1, alB, t + 1, 0, 1, 1);
    }
    SBAR(); qkt<1>(pB0, pB1, K_lds, r32, hi, S.qr); SBAR();
    SLOAD(nxt.K, nxt.V, 0); SBAR();
#pragma unroll
    for (int d0 = 0; d0 < 4; ++d0) S.qr[d0] = *reinterpret_cast<const bf16x8*>(nxt.Q + (size_t)(wid * QBLK + r32) * LD + d0 * 16 + hi * 8);
    SBAR();
    finishSM(pA0, pA1, alA, l_reg, pa0, pa1, pa2, pa3); SBAR();
    pv_tile<0>(o, vb0, pa0, pa1, pa2, pa3);
    MASKT(pB0, pB1, NT - 1); partialSM(pB0, pB1, m_reg, mnB, alB); __syncthreads(); RESC(alB);
    finishSM(pB0, pB1, alB, l_reg, pa0, pa1, pa2, pa3); SBAR(); pv_tile<1>(o, vb0, pa0, pa1, pa2, pa3);
    SBAR(); SEAM_K0();
    if (hi == 0) li_l[r32] = l_reg; asm volatile("s_waitcnt lgkmcnt(0)" ::: "memory");
    float rli[16];
#pragma unroll
    for (int r = 0; r < 16; ++r) rli[r] = __builtin_amdgcn_rcpf(li_l[crow(r, hi)]);
    bf16* Ow = cur.O + (size_t)(wid * QBLK) * OLD;
#pragma unroll
    for (int r = 0; r < 16; ++r) { const int orow = crow(r, hi);
#pragma unroll
        for (int d0 = 0; d0 < 2; ++d0) { const float v = o[d0][r] * rli[r]; const float vn = __shfl_xor(v, 1);
            if ((r32 & 1) == 0) *(unsigned*)(Ow + (size_t)orow * OLD + d0 * 32 + r32) = cvtpk(v, vn); } }
    __syncthreads();
#undef RESC
#undef KBASE
#undef MASKT
#undef SEAM_K0
#undef HALF_STEP
}
struct SRef { const bf16* K; const bf16* V; int qoff; int oidx; float mcorr; int own; float sb; };
__device__ __forceinline__ void sprime(const SRef& cur, const bf16* U0, char* lds, Seam& S) {
    const int tid = tid_fresh(), lane = tid & 63, hi = lane >> 5;
    const int sr = tid >> 3, sc = (tid & 7) * 8, kws = KSWZ64(sr, sc * 2); char* K_lds = lds + 2 * SHM_V;
#pragma unroll
    for (int d0 = 0; d0 < 4; ++d0) S.qr[d0] = *reinterpret_cast<const bf16x8*>(U0 + cur.qoff + d0 * 16 + hi * 8);
    SLOAD(cur.K, cur.V, 0); VMW(); SWRITE_K(0);
    __syncthreads();
}
__device__ __forceinline__ void sblock(const SRef& cur, const SRef& nxt, const bf16* U0, bf16* PO, float* PM, char* lds, Seam& S) {
    const int tid = tid_fresh(), wid = __builtin_amdgcn_readfirstlane(tid >> 6), lane = tid & 63, r32 = lane & 31, hi = lane >> 5;
    constexpr int NT = 4;
    const int qlo = wid * QBLK, qm = qlo + r32 - 4 * hi;
    char* V_lds = lds; char* K_lds = lds + 2 * SHM_V;
    float* ws = (float*)(lds + 2 * SHM_V + 2 * SHM_K) + wid * 64; float* li_l = ws, * al_l = ws + 32;
    const int sr = tid >> 3, sc = (tid & 7) * 8, vst0 = v_st(sr, sc), kws = KSWZ64(sr, sc * 2);
    const int vb0 = (int)(uintptr_t)V_lds + v_rd_base(lane);
    const bf16* Kh = cur.K; const bf16* Vh = cur.V; const float sb = cur.sb;
    float m_reg = -1e30f, l_reg = 0; f32x16 o[2] = {};
#define RESC(a) do { if (__any((a) < 1.f)) { if (hi == 0) al_l[r32] = (a); asm volatile("s_waitcnt lgkmcnt(0)" ::: "memory");              \
                     for (int d_ = 0; d_ < 2; ++d_) for (int r = 0; r < 16; ++r) o[d_][r] *= al_l[crow(r, hi)]; } } while (0)
#define KBASE(t) ((t) * KVBLK)
#define MASKT(P0_, P1_, t) do { const int kb_ = KBASE(t); alibi(P0_, P1_, sb, (float)(kb_ + 4 * hi));                                  \
        if (cur.own && kb_ + KVBLK - 1 > qlo) mask_causal(P0_, P1_, qm - kb_); } while (0)
#define SEAM_K0() do { VMWN(4); SWRITE_K(0); SBAR(); } while (0)
    f32x16 pA0, pA1, pB0, pB1; float mnA, mnB, alA, alB; bf16x8 pa0, pa1, pa2, pa3;
    SWRITE_V(0); SBAR();
    SLOAD(Kh, Vh, KBASE(1));
    SBAR(); qkt<0>(pA0, pA1, K_lds, r32, hi, S.qr);
    MASKT(pA0, pA1, 0); partialSM(pA0, pA1, m_reg, mnA, alA);
    VMW(); SWRITE_V(1); SWRITE_K(1);
    __syncthreads();
#define HALF_STEP(PX0, PX1, mnX, alX, PY0, PY1, alY, t, KB, VB, SB) do {                                                      \
        SBAR(); qkt<KB>(PX0, PX1, K_lds, r32, hi, S.qr);                                                                      \
        finishSM(PY0, PY1, alY, l_reg, pa0, pa1, pa2, pa3); SBAR();                                                           \
        if ((t) + 1 < NT) { SLOAD(Kh, Vh, KBASE((t) + 1)); SBAR(); }                                                          \
        pv_tile<VB>(o, vb0, pa0, pa1, pa2, pa3); MASKT(PX0, PX1, (t)); partialSM(PX0, PX1, m_reg, mnX, alX);                  \
        __syncthreads();                                                                                                      \
        if ((t) + 1 < NT) { VMW(); SWRITE_V(SB); SWRITE_K(SB); }                                                              \
        RESC(alX); __syncthreads(); } while (0)
    HALF_STEP(pB0, pB1, mnB, alB, pA0, pA1, alA, 1, 1, 0, 0);
    HALF_STEP(pA0, pA1, mnA, alA, pB0, pB1, alB, 2, 0, 1, 1);
    SBAR(); qkt<1>(pB0, pB1, K_lds, r32, hi, S.qr); SBAR();
    SLOAD(nxt.K, nxt.V, 0); SBAR();
#pragma unroll
    for (int d0 = 0; d0 < 4; ++d0) S.qr[d0] = *reinterpret_cast<const bf16x8*>(U0 + nxt.qoff + d0 * 16 + hi * 8);
    SBAR();
    finishSM(pA0, pA1, alA, l_reg, pa0, pa1, pa2, pa3); SBAR();
    pv_tile<0>(o, vb0, pa0, pa1, pa2, pa3);
    MASKT(pB0, pB1, NT - 1); partialSM(pB0, pB1, m_reg, mnB, alB); __syncthreads(); RESC(alB);
    finishSM(pB0, pB1, alB, l_reg, pa0, pa1, pa2, pa3); SBAR(); pv_tile<1>(o, vb0, pa0, pa1, pa2, pa3);
    SBAR(); SEAM_K0();
    if (hi == 0) { li_l[r32] = l_reg; ((int*)al_l)[r32] = cur.oidx;
        if (cur.oidx >= 0) { PM[2 * (size_t)cur.oidx] = m_reg * (1.4426950408889634f * SCALE) - cur.mcorr; PM[2 * (size_t)cur.oidx + 1] = l_reg; } }
    asm volatile("s_waitcnt lgkmcnt(0)" ::: "memory");
    { char* stg = lds + 49152 + wid * 4608;
#pragma unroll
      for (int r = 0; r < 16; ++r) { const int rr = crow(r, hi); const float rl = __builtin_amdgcn_rcpf(li_l[rr]);
#pragma unroll
          for (int d0 = 0; d0 < 2; ++d0) *(unsigned short*)(stg + rr * 144 + (d0 * 32 + r32) * 2) = (unsigned short)cvtpk(o[d0][r] * rl, 0.f); }
      asm volatile("s_waitcnt lgkmcnt(0)" ::: "memory");
#pragma unroll
      for (int k = 0; k < 4; ++k) { const int idx = lane + 64 * k, rr = idx >> 3, pc = idx & 7; const int oi = ((const int*)al_l)[rr]; const v4u w = *(const v4u*)(stg + rr * 144 + pc * 16);
          if (oi >= 0) *(v4u*)(PO + (size_t)oi * 64 + pc * 8) = w; }
      asm volatile("s_waitcnt lgkmcnt(0)" ::: "memory"); }
    __syncthreads();
#undef RESC
#undef KBASE
#undef MASKT
#undef SEAM_K0
#undef HALF_STEP
}
__device__ __forceinline__ SRef mk_sref(int v, const int* pex, const bf16* U0, const int* lists, const int* cnts, int lane, int wid) {
    int lo = 0, hi_ = 1024;
#pragma unroll 1
    while (hi_ - lo > 1) { const int mid = (lo + hi_) >> 1; if (pex[mid] <= v) lo = mid; else hi_ = mid; }
    const int g = lo, local = v - pex[g], bh = g >> 5, n = g & 31, b = bh >> 3, h = bh & 7, r32 = lane & 31;
    SRef r; r.K = U0 + ((size_t)b * SEQ + n * 256) * LD + 512 + h * D; r.V = U0 + ((size_t)b * SEQ + n * 256) * LD + 1024 + h * D;
    r.own = (local == 0) ? 1 : 0; const float slope = exp2f(-(float)(h + 1)); r.sb = slope * (1.f / SCALE);
    int tq, slot; bool valid = true;
    if (local == 0) { tq = n * 256 + wid * QBLK + r32; slot = 3; }
    else { int rem = (local - 1) * 256 + wid * QBLK + r32, jj = -1;
#pragma unroll 1
        for (int j = n + 1; j < 32; ++j) { const int cj = cnts[g * 32 + j]; if (jj < 0) { if (rem < cj) jj = j; else rem -= cj; } }
        valid = jj >= 0; const int e = lists[((size_t)g * 32 + (valid ? jj : 31)) * 256 + (valid ? rem : 0)]; tq = e & (SEQ - 1); slot = (e >> 16) & 3; }
    const int row = b * SEQ + tq;
    r.qoff = row * LD + h * D; r.oidx = valid ? (row * NH + h) * 4 + slot : -1; r.mcorr = slope * 1.4426950408889634f * (float)(tq - n * 256);
    return r;
}
__device__ __forceinline__ void sphase(char* lds, const bf16* U0, const int* lists, const int* cnts, bf16* PO, float* PM, int G, int c) {
    const int tid = tid_fresh(), lane = tid & 63, wid = __builtin_amdgcn_readfirstlane(tid >> 6);
    int* pex = (int*)(lds + LDS_BYTES);
    int* part = pex + 1056;
    __syncthreads();
    int* nit = part + 40;
    for (int g = tid; g < 1024; g += NTHR) { int s = 0; for (int j = (g & 31) + 1; j < 32; ++j) s += cnts[g * 32 + j]; nit[g] = 1 + ((s + 255) >> 8); }
    __syncthreads();
    if (tid < 32) { int s = 0; for (int i = 0; i < 32; ++i) s += nit[tid * 32 + i]; part[tid] = s; }
    __syncthreads();
    if (tid == 0) { int s = 0; for (int i = 0; i < 32; ++i) { const int t = part[i]; part[i] = s; s += t; } part[32] = s; }
    __syncthreads();
    for (int g = tid; g < 1024; g += NTHR) { int s = part[g >> 5]; for (int i = (g & ~31); i < g; ++i) s += nit[i]; pex[g] = s; }
    if (tid == 0) pex[1024] = part[32];
    __syncthreads();
    const int total = pex[1024];
    int vbeg, vend, vstep;
    if (G % 8 == 0) { const int chunk = (total + 7) >> 3, x = c & 7; vbeg = x * chunk + (c >> 3); vend = (x + 1) * chunk < total ? (x + 1) * chunk : total; vstep = G >> 3; }
    else { vbeg = c; vend = total; vstep = G; }
    if (vbeg >= vend) return;
    int v = vbeg;
    SRef cur = mk_sref(v, pex, U0, lists, cnts, lane, wid);
    Seam S;
    sprime(cur, U0, lds, S);
#pragma unroll 1
    for (;;) {
        const bool last = v + vstep >= vend;
        const SRef nxt = last ? cur : mk_sref(v + vstep, pex, U0, lists, cnts, lane, wid);
        sblock(cur, nxt, U0, PO, PM, lds, S);
        if (last) break;
        cur = nxt; v += vstep;
    }
}
#undef ROW
#undef VMW
#undef VMWN
#undef SLOAD
#undef SWRITE_K
#undef SWRITE_V
__device__ __forceinline__ BlockRef mk_ref(int L, int pass, const bf16* U0, bf16* O) {
    const int xcd = L & 7, k = L >> 3, bh = xcd * 4 + (k >> 4), x = k & 15, qb = pass ? 31 - x : x, b = bh >> 3, h = bh & 7;
    BlockRef r; r.Q = U0 + ((size_t)b * SEQ + qb * QB) * LD + h * D; r.K = U0 + (size_t)b * SEQ * LD + 512 + h * D; r.V = U0 + (size_t)b * SEQ * LD + 1024 + h * D;
    r.O = O + ((size_t)b * SEQ + qb * QB) * OLD + h * D; r.P0 = qb * QB; r.bh = bh; return r;
}
__device__ __forceinline__ void phase(char* lds, const bf16* U0, const float* kmean, bf16* O, int G, int c) {
    constexpr int TOTAL = NB * NH * 16;
    int L = c; if (L >= TOTAL) return; int pass = 0;
    BlockRef cur = mk_ref(L, 0, U0, O);
    Seam S;
    prime(cur, lds, S);
#pragma unroll 1
    for (;;) {
        const bool more_pass = pass == 0, more_item = L + G < TOTAL, last = !more_pass && !more_item;
        int passn = pass + 1, Ln = L;
        if (!more_pass) { passn = 0; Ln = more_item ? L + G : L; }
        const BlockRef nxt = last ? cur : mk_ref(Ln, passn, U0, O);
        block(cur, nxt, kmean, lds, S);
        if (last) break;
        cur = nxt; pass = passn; L = Ln;
    }
}
#undef KSWZ64
#undef SBAR
}

__device__ __forceinline__ float conv_silu(const bf16* u1, size_t row, int t, int col, const float* cw) {
    float a = 0.f;
#pragma unroll
    for (int j = 0; j < 4; ++j) if (t - 3 + j >= 0) a += cw[j * 1024 + col] * bf2f(u1[(row - 3 + j) * U1W + col]);
    return silu_f(a);
}
__device__ __forceinline__ void mlstm_a(LAS unsigned char* lds, const bf16* u1, const float* cw, const float* b_i, const float* b_f, bf16* mU, float* mN, float* mD, int G, int c) {
    LAS float* kf = (LAS float*)lds; LAS float* vf = kf + 8192; LAS float* wg = vf + 8192; LAS float* tb = wg + 64;
    const int tid = tid_fresh();
    for (int u = c; u < 2048; u += G) {
        const int bh = u >> 7, ch = u & 127, b = bh >> 2, hh = bh & 3, t0 = ch * 64; const size_t r0 = (size_t)b * SEQ + t0;
        __syncthreads();
#pragma unroll 1
        for (int idx = tid; idx < 8192; idx += NTHR) { const int s = idx >> 7, d = idx & 127;
            kf[idx] = conv_silu(u1, r0 + s, t0 + s, 512 + hh * 128 + d, cw) * 0.08838834764831845f; vf[idx] = bf2f(u1[(r0 + s) * U1W + 1024 + hh * 128 + d]); }
        if (tid < 64) { const size_t row = r0 + tid; tb[tid] = logsig_f(bf2f(u1[row * U1W + 2304 + 164 + hh]) + b_f[hh]); tb[64 + tid] = bf2f(u1[row * U1W + 2304 + 160 + hh]) + b_i[hh]; }
        __syncthreads();
        if (tid == 0) { float bs = 0.f; for (int s = 0; s < 64; ++s) { bs += tb[s]; tb[128 + s] = bs; } }
        __syncthreads();
        if (tid < 64) wg[tid] = __expf(tb[128 + 63] - tb[128 + tid] + tb[64 + tid]);
        __syncthreads();
        { const int v = tid >> 2, kq = tid & 3; float acc[32];
#pragma unroll
          for (int i = 0; i < 32; ++i) acc[i] = 0.f;
#pragma unroll 1
          for (int s = 0; s < 64; ++s) { const float wv = wg[s] * vf[s * 128 + v];
#pragma unroll
              for (int i = 0; i < 32; ++i) acc[i] += wv * kf[s * 128 + 4 * i + kq]; }
          bf16* Uo = mU + ((size_t)u * 128 + v) * 128;
#pragma unroll
          for (int i = 0; i < 32; ++i) Uo[4 * i + kq] = (bf16)f2bf(acc[i]); }
        if (tid < 128) { float a = 0.f; for (int s = 0; s < 64; ++s) a += wg[s] * kf[s * 128 + tid]; mN[(size_t)u * 128 + tid] = a; }
        if (tid == 0) mD[u] = __expf(tb[128 + 63]);
    }
    __syncthreads();
}
__device__ __forceinline__ void mlstm_b(bf16* mU, float* mN, const float* mD, size_t gt, size_t GT) {
    for (size_t e = gt; e < (size_t)16 * 8192; e += GT) { const int bh = (int)(e >> 13), idx = (int)(e & 8191) * 2; float s0 = 0.f, s1 = 0.f;
#pragma unroll 16
        for (int ch = 0; ch < 128; ++ch) { unsigned* p = (unsigned*)(mU + ((size_t)(bh * 128 + ch) << 14) + idx); const unsigned uv = *p; *p = pk2(s0, s1); const float d = mD[bh * 128 + ch]; s0 = d * s0 + bflo(uv); s1 = d * s1 + bfhi(uv); } }
    for (size_t e = gt; e < (size_t)16 * 128; e += GT) { const int bh = (int)(e >> 7), k = (int)(e & 127); float st = 0.f;
#pragma unroll 1
        for (int c0 = 0; c0 < 128; c0 += 32) { float uv[32], dv[32];
#pragma unroll
            for (int i = 0; i < 32; ++i) { uv[i] = mN[(size_t)(bh * 128 + c0 + i) * 128 + k]; dv[i] = mD[bh * 128 + c0 + i]; }
#pragma unroll
            for (int i = 0; i < 32; ++i) { mN[(size_t)(bh * 128 + c0 + i) * 128 + k] = st; st = dv[i] * st + uv[i]; } } }
}
__device__ __forceinline__ void mlstm_c(LAS unsigned char* lds, const bf16* u1, const float* cw, const float* b_i, const float* b_f, const float* hn, const bf16* mU, const float* mN, bf16* mix1, int G, int c) {
    LAS unsigned short* qs = (LAS unsigned short*)lds; LAS unsigned short* ks = qs + 8192; LAS unsigned short* vs = ks + 8192; LAS unsigned short* Cs = vs + 8192;
    LAS unsigned short* hb16 = ks;
    LAS float* As = (LAS float*)(lds + 81920);
    LAS float* nv = (LAS float*)(lds + 98560); LAS float* tb = nv + 128; LAS float* den = tb + 192;
    const int tid = tid_fresh(), lane = tid & 63, wave = tid >> 6;
    for (int u = c; u < 2048; u += G) {
        const int bh = u >> 7, ch = u & 127, b = bh >> 2, hh = bh & 3, t0 = ch * 64; const size_t r0 = (size_t)b * SEQ + t0;
        __syncthreads();
#pragma unroll 1
        for (int idx = tid; idx < 8192; idx += NTHR) { const int s = idx >> 7, d = idx & 127;
            qs[idx] = (unsigned short)f2bf(conv_silu(u1, r0 + s, t0 + s, hh * 128 + d, cw));
            ks[idx] = (unsigned short)f2bf(conv_silu(u1, r0 + s, t0 + s, 512 + hh * 128 + d, cw) * 0.08838834764831845f);
            vs[idx] = u1[(r0 + s) * U1W + 1024 + hh * 128 + d]; }
        for (int idx = tid; idx < 2048; idx += NTHR) ((LAS v4u*)Cs)[idx] = ((const v4u*)(mU + (size_t)u * 16384))[idx];
        if (tid < 128) nv[tid] = mN[(size_t)u * 128 + tid];
        if (tid < 64) { const size_t row = r0 + tid; tb[tid] = logsig_f(bf2f(u1[row * U1W + 2304 + 164 + hh]) + b_f[hh]); tb[64 + tid] = bf2f(u1[row * U1W + 2304 + 160 + hh]) + b_i[hh]; }
        __syncthreads();
        if (tid == 0) { float bs = 0.f; for (int s = 0; s < 64; ++s) { bs += tb[s]; tb[128 + s] = bs; } }
        __syncthreads();
#pragma unroll 1
        for (int e = tid; e < 4096; e += NTHR) { const int t = e >> 6, s = e & 63; float a = 0.f;
            if (s <= t) { const LAS unsigned* qr = (const LAS unsigned*)(qs + t * 128); const LAS unsigned* kr = (const LAS unsigned*)(ks + s * 128); float dot = 0.f;
#pragma unroll 4
                for (int k2 = 0; k2 < 64; ++k2) { const unsigned a_ = qr[k2], b_ = kr[k2]; dot += bflo(a_) * bflo(b_) + bfhi(a_) * bfhi(b_); }
                a = __expf(tb[128 + t] - tb[128 + s] + tb[64 + s]) * dot; }
            As[t * 65 + s] = a; }
        __syncthreads();
        if (tid < 64) { const int t = tid; const LAS unsigned* qr = (const LAS unsigned*)(qs + t * 128); float dq = 0.f;
#pragma unroll 4
            for (int k2 = 0; k2 < 64; ++k2) { const unsigned a_ = qr[k2]; dq += nv[2 * k2] * bflo(a_) + nv[2 * k2 + 1] * bfhi(a_); }
            float sa = 0.f; for (int s = 0; s <= t; ++s) sa += As[t * 65 + s];
            den[t] = __expf(tb[128 + t]) * dq + sa; }
        __syncthreads();
        { const int v = tid & 127, tq = tid >> 7; const LAS unsigned* cr = (const LAS unsigned*)(Cs + v * 128);
#pragma unroll 1
          for (int pass = 0; pass < 4; ++pass) { float hv[4];
#pragma unroll
              for (int i = 0; i < 4; ++i) hv[i] = 0.f;
#pragma unroll 2
              for (int k2 = 0; k2 < 64; ++k2) { const unsigned b_ = cr[k2]; const float c0 = bflo(b_), c1 = bfhi(b_);
#pragma unroll
                  for (int i = 0; i < 4; ++i) { const unsigned a_ = ((const LAS unsigned*)(qs + (tq + 16 * pass + 4 * i) * 128))[k2]; hv[i] += bflo(a_) * c0 + bfhi(a_) * c1; } }
#pragma unroll
              for (int i = 0; i < 4; ++i) hv[i] *= __expf(tb[128 + tq + 16 * pass + 4 * i]);
#pragma unroll 2
              for (int s = 0; s < 64; ++s) { const float vv = bf2f(vs[s * 128 + v]);
#pragma unroll
                  for (int i = 0; i < 4; ++i) { const int t = tq + 16 * pass + 4 * i; if (s <= t) hv[i] += As[t * 65 + s] * vv; } }
#pragma unroll
              for (int i = 0; i < 4; ++i) { const int t = tq + 16 * pass + 4 * i; hb16[t * 128 + v] = (unsigned short)f2bf(hv[i] / fmaxf(fabsf(den[t]), 1.f)); } } }
        __syncthreads();
#pragma unroll 1
        for (int tt = 0; tt < 8; ++tt) { const int t = wave * 8 + tt; const float a0 = bf2f(hb16[t * 128 + lane]), a1 = bf2f(hb16[t * 128 + 64 + lane]);
            const float rstd = rsqrtf(wave_sum(a0 * a0 + a1 * a1) * (1.f / 128.f) + EPS); const size_t row = r0 + t;
            const float o0 = a0 * rstd * hn[hh * 128 + lane] * sigmoid_f(bf2f(u1[row * U1W + 1536 + hh * 128 + lane]));
            const float o1 = a1 * rstd * hn[hh * 128 + 64 + lane] * sigmoid_f(bf2f(u1[row * U1W + 1536 + hh * 128 + 64 + lane]));
            mix1[row * D + hh * 128 + lane] = (bf16)f2bf(o0); mix1[row * D + hh * 128 + 64 + lane] = (bf16)f2bf(o1); }
    }
    __syncthreads();
}

namespace mlm {
using mla_attn::bf16x8; using mla_attn::f32x16; using mla_attn::crow;
constexpr int PS = 72, PK = 136;
__device__ __forceinline__ bf16x8 frag(const LAS unsigned char* base, int row, int pitchB, int colB) { return *(const LAS bf16x8*)(base + row * pitchB + colB); }
__device__ __forceinline__ void gates(LAS float* tb, const bf16* u1, size_t r0, int hh, const float* b_i, const float* b_f, int tid) {
    if (tid < 64) { const size_t row = r0 + tid; float v = logsig_f(bf2f(u1[row * U1W + 2304 + 164 + hh]) + b_f[hh]); tb[tid] = v; tb[64 + tid] = bf2f(u1[row * U1W + 2304 + 160 + hh]) + b_i[hh];
#pragma unroll
        for (int o = 1; o < 64; o <<= 1) { const float t = __shfl_up(v, o); if (tid >= o) v += t; }
        tb[128 + tid] = v; }
    __syncthreads();
}
__device__ __forceinline__ void conv2(const bf16* u1, size_t row, int t, int col, const float* cw, float& y0, float& y1) {
    float x[5];
#pragma unroll
    for (int j = 0; j < 5; ++j) x[j] = (t - 3 + j >= 0) ? bf2f(u1[(row - 3 + j) * U1W + col]) : 0.f;
    const float w0 = cw[col], w1 = cw[1024 + col], w2 = cw[2048 + col], w3 = cw[3072 + col];
    y0 = silu_f(w0 * x[0] + w1 * x[1] + w2 * x[2] + w3 * x[3]); y1 = silu_f(w0 * x[1] + w1 * x[2] + w2 * x[3] + w3 * x[4]);
}
__device__ __forceinline__ void stage_a(LAS unsigned char* lds, const bf16* u1, const float* cw, const float* b_i, const float* b_f, bf16* mU, float* mN, float* mD, int G, int c) {
    LAS unsigned char* KT = lds; LAS unsigned char* VT = lds + 18432; LAS unsigned char* UT = lds + 36864; LAS float* tb = (LAS float*)(lds + 71680); LAS float* wg = tb + 192;
    const int tid = tid_fresh(), lane = tid & 63, wave = __builtin_amdgcn_readfirstlane(tid >> 6), l31 = lane & 31, hi = lane >> 5;
#pragma unroll 1
    for (int u = c; u < 2048; u += G) {
        const int bh = u >> 7, ch = u & 127, b = bh >> 2, hh = bh & 3, t0 = ch * 64; const size_t r0 = (size_t)b * SEQ + t0;
        __syncthreads();
        gates(tb, u1, r0, hh, b_i, b_f, tid);
        if (tid < 64) wg[tid] = __expf(tb[128 + 63] - tb[128 + tid] + tb[64 + tid]);
        if (tid == 0) mD[u] = __expf(tb[128 + 63]);
        __syncthreads();
        { const int d = tid & 127, sq = tid >> 7;
#pragma unroll
          for (int i = 0; i < 8; ++i) { const int s0 = 2 * (sq + 4 * i); float y0, y1;
              conv2(u1, r0 + s0, t0 + s0, 512 + hh * 128 + d, cw, y0, y1);
              *(LAS unsigned*)(KT + d * (PS * 2) + s0 * 2) = pk2(y0 * 0.08838834764831845f, y1 * 0.08838834764831845f); }
#pragma unroll
          for (int i = 0; i < 8; ++i) { const int s0 = 2 * (sq + 4 * i);
              const float v0 = bf2f(u1[(r0 + s0) * U1W + 1024 + hh * 128 + d]) * wg[s0], v1 = bf2f(u1[(r0 + s0 + 1) * U1W + 1024 + hh * 128 + d]) * wg[s0 + 1];
              *(LAS unsigned*)(VT + d * (PS * 2) + s0 * 2) = pk2(v0, v1); } }
        __syncthreads();
        { const int vt = wave & 3, kt0 = (wave >> 2) * 2; f32x16 acc[2] = {};
#pragma unroll
          for (int ks = 0; ks < 4; ++ks) { const bf16x8 Bf = frag(VT, vt * 32 + l31, PS * 2, ks * 32 + hi * 16);
#pragma unroll
              for (int a = 0; a < 2; ++a) acc[a] = __builtin_amdgcn_mfma_f32_32x32x16_bf16(frag(KT, (kt0 + a) * 32 + l31, PS * 2, ks * 32 + hi * 16), Bf, acc[a], 0, 0, 0); }
#pragma unroll
          for (int a = 0; a < 2; ++a)
#pragma unroll
              for (int g = 0; g < 4; ++g) { v2u w; w.x = cvt2(acc[a][4 * g], acc[a][4 * g + 1]); w.y = cvt2(acc[a][4 * g + 2], acc[a][4 * g + 3]);
                  *(LAS v2u*)(UT + (vt * 32 + l31) * (PK * 2) + ((kt0 + a) * 32 + 8 * g + 4 * hi) * 2) = w; } }
        if (tid < 128) { float a = 0.f; const LAS unsigned* kr = (const LAS unsigned*)(KT + tid * (PS * 2));
#pragma unroll 4
            for (int s2 = 0; s2 < 32; ++s2) { const unsigned w = kr[s2]; a += wg[2 * s2] * bflo(w) + wg[2 * s2 + 1] * bfhi(w); }
            mN[(size_t)u * 128 + tid] = a; }
        __syncthreads();
#pragma unroll
        for (int i = 0; i < 4; ++i) { const int idx = tid + NTHR * i, row = idx >> 4, c16 = idx & 15;
            *(v4u*)(mU + ((size_t)u * 128 + row) * 128 + c16 * 8) = *(const LAS v4u*)(UT + row * (PK * 2) + c16 * 16); }
    }
    __syncthreads();
}
__device__ __forceinline__ void stage_a2(LAS unsigned char* lds, const bf16* u1, const float* cw, const float* b_i, const float* b_f, bf16* mU, float* mN, float* mD, int G, int c) {
    LAS unsigned char* RK = lds; LAS unsigned char* RV = lds + 17408; LAS unsigned char* UT = lds;
    LAS unsigned char* KT = lds + 34816; LAS unsigned char* VT = lds + 53248; LAS float* wg = (LAS float*)(lds + 71680);
    const int tid = tid_fresh(), lane = tid & 63, wave = __builtin_amdgcn_readfirstlane(tid >> 6), l31 = lane & 31, hi = lane >> 5;
    v4u rk0, rk1, rk2, rv0, rv1; float bfv = 0.f, biv = 0.f; bf16 gfr = 0, gir = 0;
    rk0 = rk1 = rk2 = rv0 = rv1 = (v4u){0u, 0u, 0u, 0u};
#define A2_FETCH(uu) do { const int bh_ = (uu) >> 7, ch_ = (uu) & 127, b_ = bh_ >> 2, hh_ = bh_ & 3, t0_ = ch_ * 64; const size_t r0_ = (size_t)b_ * SEQ + t0_;                  \
        { const int p = tid, row = p >> 4, c16 = p & 15; rk0 = (t0_ - 3 + row >= 0) ? *(const v4u*)(u1 + (r0_ - 3 + row) * U1W + 512 + hh_ * 128 + c16 * 8) : (v4u){0u, 0u, 0u, 0u}; }   \
        { const int p = tid + 512, row = p >> 4, c16 = p & 15; rk1 = *(const v4u*)(u1 + (r0_ - 3 + row) * U1W + 512 + hh_ * 128 + c16 * 8); }                                           \
        if (tid < 48) { const int p = tid + 1024, row = p >> 4, c16 = p & 15; rk2 = *(const v4u*)(u1 + (r0_ - 3 + row) * U1W + 512 + hh_ * 128 + c16 * 8); }                            \
        { const int p = tid, row = p >> 4, c16 = p & 15; rv0 = *(const v4u*)(u1 + (r0_ + row) * U1W + 1024 + hh_ * 128 + c16 * 8); }                                                   \
        { const int p = tid + 512, row = p >> 4, c16 = p & 15; rv1 = *(const v4u*)(u1 + (r0_ + row) * U1W + 1024 + hh_ * 128 + c16 * 8); }                                             \
        if (tid < 64) { const size_t row = r0_ + tid; gfr = u1[row * U1W + 2304 + 164 + hh_]; gir = u1[row * U1W + 2304 + 160 + hh_]; bfv = b_f[hh_]; biv = b_i[hh_]; } } while (0)
    if (c < 2048) A2_FETCH(c);
#pragma unroll 1
    for (int u = c; u < 2048; u += G) {
        const int hh = (u >> 7) & 3; const int cd_ = tid & 127;
        const float w0 = cw[512 + hh * 128 + cd_], w1 = cw[1024 + 512 + hh * 128 + cd_], w2 = cw[2048 + 512 + hh * 128 + cd_], w3 = cw[3072 + 512 + hh * 128 + cd_];
        __syncthreads();
        ((LAS v4u*)RK)[tid] = rk0; ((LAS v4u*)RK)[tid + 512] = rk1; if (tid < 48) ((LAS v4u*)RK)[tid + 1024] = rk2;
        ((LAS v4u*)RV)[tid] = rv0; ((LAS v4u*)RV)[tid + 512] = rv1;
        if (tid < 64) { const float gi = bf2f(gir) + biv; float v = logsig_f(bf2f(gfr) + bfv);
            v = wave_scan_incl(v);
            const float bend = __builtin_bit_cast(float, __builtin_amdgcn_readlane(__builtin_bit_cast(int, v), 63)); wg[tid] = __expf(bend - v + gi); if (tid == 63) mD[u] = __expf(bend); }
        if (u + G < 2048) A2_FETCH(u + G);
        __syncthreads();
        { const int d = tid & 127, sq = tid >> 7;
#pragma unroll
          for (int i = 0; i < 8; ++i) { const int s0 = 2 * (sq + 4 * i); float x[5];
#pragma unroll
              for (int j = 0; j < 5; ++j) x[j] = bf2f(*(const LAS unsigned short*)(RK + (s0 + j) * 256 + d * 2));
              const float y0 = silu_f(w0 * x[0] + w1 * x[1] + w2 * x[2] + w3 * x[3]), y1 = silu_f(w0 * x[1] + w1 * x[2] + w2 * x[3] + w3 * x[4]);
              *(LAS unsigned*)(KT + d * (PS * 2) + s0 * 2) = pk2(y0 * 0.08838834764831845f, y1 * 0.08838834764831845f);
              const float v0 = bf2f(*(const LAS unsigned short*)(RV + s0 * 256 + d * 2)) * wg[s0], v1 = bf2f(*(const LAS unsigned short*)(RV + (s0 + 1) * 256 + d * 2)) * wg[s0 + 1];
              *(LAS unsigned*)(VT + d * (PS * 2) + s0 * 2) = pk2(v0, v1); } }
        __syncthreads();
        { const int vt = wave & 3, kt0 = (wave >> 2) * 2; f32x16 acc[2] = {};
#pragma unroll
          for (int ks = 0; ks < 4; ++ks) { const bf16x8 Bf = frag(VT, vt * 32 + l31, PS * 2, ks * 32 + hi * 16);
#pragma unroll
              for (int a = 0; a < 2; ++a) acc[a] = __builtin_amdgcn_mfma_f32_32x32x16_bf16(frag(KT, (kt0 + a) * 32 + l31, PS * 2, ks * 32 + hi * 16), Bf, acc[a], 0, 0, 0); }
#pragma unroll
          for (int a = 0; a < 2; ++a)
#pragma unroll
              for (int g = 0; g < 4; ++g) { v2u w; w.x = cvt2(acc[a][4 * g], acc[a][4 * g + 1]); w.y = cvt2(acc[a][4 * g + 2], acc[a][4 * g + 3]);
                  *(LAS v2u*)(UT + (vt * 32 + l31) * (PK * 2) + ((kt0 + a) * 32 + 8 * g + 4 * hi) * 2) = w; } }
        if (tid < 128) { float a = 0.f; const LAS unsigned* kr = (const LAS unsigned*)(KT + tid * (PS * 2));
#pragma unroll 4
            for (int s2 = 0; s2 < 32; ++s2) { const unsigned w = kr[s2]; a += wg[2 * s2] * bflo(w) + wg[2 * s2 + 1] * bfhi(w); }
            mN[(size_t)u * 128 + tid] = a; }
        __syncthreads();
#pragma unroll
        for (int i = 0; i < 4; ++i) { const int idx = tid + NTHR * i, row = idx >> 4, c16 = idx & 15;
            *(v4u*)(mU + ((size_t)u * 128 + row) * 128 + c16 * 8) = *(const LAS v4u*)(UT + row * (PK * 2) + c16 * 16); }
    }
#undef A2_FETCH
    __syncthreads();
}
__device__ __forceinline__ void stage_c(LAS unsigned char* lds, const bf16* u1, const float* cw, const float* b_i, const float* b_f, const float* hn, const bf16* mU, const float* mN, bf16* mix1, int G, int c) {
    LAS unsigned char* Qs = lds; LAS unsigned char* Ks = lds + 17408; LAS unsigned char* VT = lds + 34816; LAS unsigned char* Cs = lds + 53248; LAS unsigned char* As = lds + 88064;
    LAS float* hbuf = (LAS float*)Cs;
    LAS float* tb = (LAS float*)(lds + 97280); LAS float* ebt = tb + 192; LAS float* nv = ebt + 64; LAS float* den = nv + 128;
    const int tid = tid_fresh(), lane = tid & 63, wave = __builtin_amdgcn_readfirstlane(tid >> 6), l31 = lane & 31, hi = lane >> 5;
#pragma unroll 1
    for (int u = c; u < 2048; u += G) {
        const int bh = u >> 7, ch = u & 127, b = bh >> 2, hh = bh & 3, t0 = ch * 64; const size_t r0 = (size_t)b * SEQ + t0;
        __syncthreads();
        gates(tb, u1, r0, hh, b_i, b_f, tid);
        if (tid < 64) ebt[tid] = __expf(tb[128 + tid]);
        if (tid < 128) nv[tid] = mN[(size_t)u * 128 + tid];
        { const int d = tid & 127, sq = tid >> 7;
#pragma unroll
          for (int i = 0; i < 8; ++i) { const int s0 = 2 * (sq + 4 * i); float y0, y1;
              conv2(u1, r0 + s0, t0 + s0, hh * 128 + d, cw, y0, y1);
              *(LAS unsigned short*)(Qs + s0 * (PK * 2) + d * 2) = (unsigned short)f2bf(y0); *(LAS unsigned short*)(Qs + (s0 + 1) * (PK * 2) + d * 2) = (unsigned short)f2bf(y1); }
#pragma unroll
          for (int i = 0; i < 8; ++i) { const int s0 = 2 * (sq + 4 * i); float y0, y1;
              conv2(u1, r0 + s0, t0 + s0, 512 + hh * 128 + d, cw, y0, y1);
              *(LAS unsigned short*)(Ks + s0 * (PK * 2) + d * 2) = (unsigned short)f2bf(y0 * 0.08838834764831845f); *(LAS unsigned short*)(Ks + (s0 + 1) * (PK * 2) + d * 2) = (unsigned short)f2bf(y1 * 0.08838834764831845f); }
#pragma unroll
          for (int i = 0; i < 8; ++i) { const int s0 = 2 * (sq + 4 * i);
              *(LAS unsigned*)(VT + d * (PS * 2) + s0 * 2) = (unsigned)u1[(r0 + s0) * U1W + 1024 + hh * 128 + d] | ((unsigned)u1[(r0 + s0 + 1) * U1W + 1024 + hh * 128 + d] << 16); } }
#pragma unroll
        for (int i = 0; i < 4; ++i) { const int idx = tid + NTHR * i, row = idx >> 4, c16 = idx & 15;
            *(LAS v4u*)(Cs + row * (PK * 2) + c16 * 16) = *(const v4u*)(mU + ((size_t)u * 128 + row) * 128 + c16 * 8); }
        __syncthreads();
        if (wave < 3) { const int st = (wave == 2) ? 1 : 0, tt = (wave == 0) ? 0 : 1; f32x16 sacc = {};
#pragma unroll
            for (int ks = 0; ks < 8; ++ks) sacc = __builtin_amdgcn_mfma_f32_32x32x16_bf16(frag(Ks, st * 32 + l31, PK * 2, ks * 32 + hi * 16), frag(Qs, tt * 32 + l31, PK * 2, ks * 32 + hi * 16), sacc, 0, 0, 0);
            const int t = tt * 32 + l31; const float bt = tb[128 + t];
#pragma unroll
            for (int g = 0; g < 4; ++g) { float av[4];
#pragma unroll
                for (int j = 0; j < 4; ++j) { const int s = st * 32 + 8 * g + 4 * hi + j; av[j] = (s <= t) ? __expf(bt - tb[128 + s] + tb[64 + s]) * sacc[4 * g + j] : 0.f; }
                v2u w; w.x = cvt2(av[0], av[1]); w.y = cvt2(av[2], av[3]); *(LAS v2u*)(As + t * (PS * 2) + (st * 32 + 8 * g + 4 * hi) * 2) = w; } }
        else if (wave == 3) { for (int i = lane; i < 32 * 8; i += 64) { const int t = i >> 3, c8 = i & 7; *(LAS v2u*)(As + t * (PS * 2) + 64 + c8 * 8) = (v2u){0u, 0u}; } }
        __syncthreads();
        { const int t = tid >> 3, part = tid & 7; float dq = 0.f, sa = 0.f; const LAS unsigned* qr = (const LAS unsigned*)(Qs + t * (PK * 2) + part * 32); const LAS unsigned* ar = (const LAS unsigned*)(As + t * (PS * 2) + part * 16);
#pragma unroll
          for (int k2 = 0; k2 < 8; ++k2) { const unsigned w = qr[k2]; dq += nv[part * 16 + 2 * k2] * bflo(w) + nv[part * 16 + 2 * k2 + 1] * bfhi(w); }
#pragma unroll
          for (int s2 = 0; s2 < 4; ++s2) { const unsigned w = ar[s2]; sa += bflo(w) + bfhi(w); }
          float dv = ebt[t] * dq + sa; dv += __shfl_xor(dv, 1); dv += __shfl_xor(dv, 2); dv += __shfl_xor(dv, 4);
          if (part == 0) den[t] = dv; }
        f32x16 acc = {}; const int tt = wave & 1, vt = wave >> 1;
#pragma unroll
        for (int ks = 0; ks < 8; ++ks) acc = __builtin_amdgcn_mfma_f32_32x32x16_bf16(frag(Qs, tt * 32 + l31, PK * 2, ks * 32 + hi * 16), frag(Cs, vt * 32 + l31, PK * 2, ks * 32 + hi * 16), acc, 0, 0, 0);
#pragma unroll
        for (int r = 0; r < 16; ++r) acc[r] *= ebt[tt * 32 + crow(r, hi)];
#pragma unroll
        for (int ks = 0; ks < 4; ++ks) acc = __builtin_amdgcn_mfma_f32_32x32x16_bf16(frag(As, tt * 32 + l31, PS * 2, ks * 32 + hi * 16), frag(VT, vt * 32 + l31, PS * 2, ks * 32 + hi * 16), acc, 0, 0, 0);
        __syncthreads();
#pragma unroll
        for (int r = 0; r < 16; ++r) { const int t = tt * 32 + crow(r, hi); hbuf[t * 132 + vt * 32 + l31] = acc[r] * __builtin_amdgcn_rcpf(fmaxf(fabsf(den[t]), 1.f)); }
        __syncthreads();
#pragma unroll 1
        for (int q8 = 0; q8 < 8; ++q8) { const int t = wave * 8 + q8; const float a0 = hbuf[t * 132 + lane], a1 = hbuf[t * 132 + 64 + lane];
            const float rstd = rsqrtf(wave_sum(a0 * a0 + a1 * a1) * (1.f / 128.f) + EPS); const size_t row = r0 + t;
            const float o0 = a0 * rstd * hn[hh * 128 + lane] * sigmoid_f(bf2f(u1[row * U1W + 1536 + hh * 128 + lane]));
            const float o1 = a1 * rstd * hn[hh * 128 + 64 + lane] * sigmoid_f(bf2f(u1[row * U1W + 1536 + hh * 128 + 64 + lane]));
            mix1[row * D + hh * 128 + lane] = (bf16)f2bf(o0); mix1[row * D + hh * 128 + 64 + lane] = (bf16)f2bf(o1); }
    }
    __syncthreads();
}
__device__ __forceinline__ void stage_c2(LAS unsigned char* lds, const bf16* u1, const float* cw, const float* b_i, const float* b_f, const float* hn, const bf16* mU, const float* mN, bf16* mix1, int G, int c) {
    LAS unsigned char* Qs = lds; LAS unsigned char* Ks = lds + 17408; LAS unsigned char* VT = lds + 34816; LAS unsigned char* Cs = lds + 53248; LAS unsigned char* As = lds + 88064;
    LAS unsigned char* RQ = Cs; LAS unsigned char* RK = Cs + 17408;
    LAS float* hbuf = (LAS float*)Cs;
    LAS float* tb = (LAS float*)(lds + 97280); LAS float* ebt = tb + 192; LAS float* nv = ebt + 64; LAS float* den = nv + 128;
    const int tid = tid_fresh(), lane = tid & 63, wave = __builtin_amdgcn_readfirstlane(tid >> 6), l31 = lane & 31, hi = lane >> 5;
    v4u rq0, rq1, rq2, rk0, rk1, rk2, rv0, rv1; float nvr = 0.f, bfv = 0.f, biv = 0.f; bf16 gfr = 0, gir = 0;
    rq0 = rq1 = rq2 = rk0 = rk1 = rk2 = rv0 = rv1 = (v4u){0u, 0u, 0u, 0u};
#define C2_FETCH(uu) do { const int bh_ = (uu) >> 7, ch_ = (uu) & 127, b_ = bh_ >> 2, hh_ = bh_ & 3, t0_ = ch_ * 64; const size_t r0_ = (size_t)b_ * SEQ + t0_;                  \
        { const int p = tid, row = p >> 4, c16 = p & 15; const bool ok_ = t0_ - 3 + row >= 0; const bf16* s_ = u1 + (r0_ - 3 + row) * U1W + hh_ * 128 + c16 * 8;                          \
          rq0 = ok_ ? *(const v4u*)s_ : (v4u){0u, 0u, 0u, 0u}; rk0 = ok_ ? *(const v4u*)(s_ + 512) : (v4u){0u, 0u, 0u, 0u}; }                                                          \
        { const int p = tid + 512, row = p >> 4, c16 = p & 15; const bf16* s_ = u1 + (r0_ - 3 + row) * U1W + hh_ * 128 + c16 * 8; rq1 = *(const v4u*)s_; rk1 = *(const v4u*)(s_ + 512); } \
        if (tid < 48) { const int p = tid + 1024, row = p >> 4, c16 = p & 15; const bf16* s_ = u1 + (r0_ - 3 + row) * U1W + hh_ * 128 + c16 * 8; rq2 = *(const v4u*)s_; rk2 = *(const v4u*)(s_ + 512); } \
        { const int p = tid, row = p >> 4, c16 = p & 15; rv0 = *(const v4u*)(u1 + (r0_ + row) * U1W + 1024 + hh_ * 128 + c16 * 8); }                                                   \
        { const int p = tid + 512, row = p >> 4, c16 = p & 15; rv1 = *(const v4u*)(u1 + (r0_ + row) * U1W + 1024 + hh_ * 128 + c16 * 8); }                                             \
        if (tid < 128) nvr = mN[(size_t)(uu) * 128 + tid];                                                                                                                            \
        if (tid < 64) { const size_t row = r0_ + tid; gfr = u1[row * U1W + 2304 + 164 + hh_]; gir = u1[row * U1W + 2304 + 160 + hh_]; bfv = b_f[hh_]; biv = b_i[hh_]; } } while (0)
#define C2_VT(rv_, p_) do { const int s_ = (p_) >> 4, d_ = ((p_) & 15) * 8; LAS unsigned short* vt_ = (LAS unsigned short*)(VT + d_ * (PS * 2) + s_ * 2);                            \
        vt_[0 * PS] = (unsigned short)(rv_.x & 0xffffu); vt_[1 * PS] = (unsigned short)(rv_.x >> 16); vt_[2 * PS] = (unsigned short)(rv_.y & 0xffffu); vt_[3 * PS] = (unsigned short)(rv_.y >> 16); \
        vt_[4 * PS] = (unsigned short)(rv_.z & 0xffffu); vt_[5 * PS] = (unsigned short)(rv_.z >> 16); vt_[6 * PS] = (unsigned short)(rv_.w & 0xffffu); vt_[7 * PS] = (unsigned short)(rv_.w >> 16); } while (0)
    if (c < 2048) C2_FETCH(c);
#pragma unroll 1
    for (int u = c; u < 2048; u += G) {
        const int bh = u >> 7, ch = u & 127, b = bh >> 2, hh = bh & 3, t0 = ch * 64; const size_t r0 = (size_t)b * SEQ + t0;
        const int cd_ = tid & 127;
        const float q0 = cw[hh * 128 + cd_], q1 = cw[1024 + hh * 128 + cd_], q2 = cw[2048 + hh * 128 + cd_], q3 = cw[3072 + hh * 128 + cd_];
        const float k0 = cw[512 + hh * 128 + cd_], k1 = cw[1024 + 512 + hh * 128 + cd_], k2 = cw[2048 + 512 + hh * 128 + cd_], k3 = cw[3072 + 512 + hh * 128 + cd_];
        __syncthreads();
        ((LAS v4u*)RQ)[tid] = rq0; ((LAS v4u*)RQ)[tid + 512] = rq1; ((LAS v4u*)RK)[tid] = rk0; ((LAS v4u*)RK)[tid + 512] = rk1;
        if (tid < 48) { ((LAS v4u*)RQ)[tid + 1024] = rq2; ((LAS v4u*)RK)[tid + 1024] = rk2; }
        C2_VT(rv0, tid); C2_VT(rv1, tid + 512);
        if (tid < 64) { const float gi = bf2f(gir) + biv; float v = logsig_f(bf2f(gfr) + bfv);
            v = wave_scan_incl(v);
            tb[64 + tid] = gi; tb[128 + tid] = v; ebt[tid] = __expf(v); }
        if (tid < 128) nv[tid] = nvr;
        v4u cr[4];
#pragma unroll
        for (int i = 0; i < 4; ++i) { const int idx = tid + NTHR * i, row = idx >> 4, c16 = idx & 15; cr[i] = *(const v4u*)(mU + ((size_t)u * 128 + row) * 128 + c16 * 8); }
        unsigned og[8];
#pragma unroll
        for (int q8 = 0; q8 < 8; ++q8) og[q8] = *(const unsigned*)(u1 + (r0 + wave * 8 + q8) * U1W + 1536 + hh * 128 + 2 * lane);
        if (u + G < 2048) C2_FETCH(u + G);
        __syncthreads();
        { const int d = tid & 127, sq = tid >> 7;
#pragma unroll
          for (int i = 0; i < 8; ++i) { const int s0 = 2 * (sq + 4 * i); float x[5], y[5];
#pragma unroll
              for (int j = 0; j < 5; ++j) { x[j] = bf2f(*(const LAS unsigned short*)(RQ + (s0 + j) * 256 + d * 2)); y[j] = bf2f(*(const LAS unsigned short*)(RK + (s0 + j) * 256 + d * 2)); }
              *(LAS unsigned short*)(Qs + s0 * (PK * 2) + d * 2) = (unsigned short)f2bf(silu_f(q0 * x[0] + q1 * x[1] + q2 * x[2] + q3 * x[3]));
              *(LAS unsigned short*)(Qs + (s0 + 1) * (PK * 2) + d * 2) = (unsigned short)f2bf(silu_f(q0 * x[1] + q1 * x[2] + q2 * x[3] + q3 * x[4]));
              *(LAS unsigned short*)(Ks + s0 * (PK * 2) + d * 2) = (unsigned short)f2bf(silu_f(k0 * y[0] + k1 * y[1] + k2 * y[2] + k3 * y[3]) * 0.08838834764831845f);
              *(LAS unsigned short*)(Ks + (s0 + 1) * (PK * 2) + d * 2) = (unsigned short)f2bf(silu_f(k0 * y[1] + k1 * y[2] + k2 * y[3] + k3 * y[4]) * 0.08838834764831845f); } }
        __syncthreads();
#pragma unroll
        for (int i = 0; i < 4; ++i) { const int idx = tid + NTHR * i, row = idx >> 4, c16 = idx & 15; *(LAS v4u*)(Cs + row * (PK * 2) + c16 * 16) = cr[i]; }
        __syncthreads();
        if (wave < 3) { const int st = (wave == 2) ? 1 : 0, tt = (wave == 0) ? 0 : 1; f32x16 sacc = {};
#pragma unroll
            for (int ks = 0; ks < 8; ++ks) sacc = __builtin_amdgcn_mfma_f32_32x32x16_bf16(frag(Ks, st * 32 + l31, PK * 2, ks * 32 + hi * 16), frag(Qs, tt * 32 + l31, PK * 2, ks * 32 + hi * 16), sacc, 0, 0, 0);
            const int t = tt * 32 + l31; const float bt = tb[128 + t];
#pragma unroll
            for (int g = 0; g < 4; ++g) { float av[4];
#pragma unroll
                for (int j = 0; j < 4; ++j) { const int s = st * 32 + 8 * g + 4 * hi + j; av[j] = (s <= t) ? __expf(bt - tb[128 + s] + tb[64 + s]) * sacc[4 * g + j] : 0.f; }
                v2u w; w.x = cvt2(av[0], av[1]); w.y = cvt2(av[2], av[3]); *(LAS v2u*)(As + t * (PS * 2) + (st * 32 + 8 * g + 4 * hi) * 2) = w; } }
        else if (wave == 3) { for (int i = lane; i < 32 * 8; i += 64) { const int t = i >> 3, c8 = i & 7; *(LAS v2u*)(As + t * (PS * 2) + 64 + c8 * 8) = (v2u){0u, 0u}; } }
        __syncthreads();
        { const int t = tid >> 3, part = tid & 7; float dq = 0.f, sa = 0.f; const LAS unsigned* qr = (const LAS unsigned*)(Qs + t * (PK * 2) + part * 32); const LAS unsigned* ar = (const LAS unsigned*)(As + t * (PS * 2) + part * 16);
#pragma unroll
          for (int k2 = 0; k2 < 8; ++k2) { const unsigned w = qr[k2]; dq += nv[part * 16 + 2 * k2] * bflo(w) + nv[part * 16 + 2 * k2 + 1] * bfhi(w); }
#pragma unroll
          for (int s2 = 0; s2 < 4; ++s2) { const unsigned w = ar[s2]; sa += bflo(w) + bfhi(w); }
          float dv = ebt[t] * dq + sa; dv += __shfl_xor(dv, 1); dv += __shfl_xor(dv, 2); dv += __shfl_xor(dv, 4);
          if (part == 0) den[t] = dv; }
        f32x16 acc = {}; const int tt = wave & 1, vt = wave >> 1;
#pragma unroll
        for (int ks = 0; ks < 8; ++ks) acc = __builtin_amdgcn_mfma_f32_32x32x16_bf16(frag(Qs, tt * 32 + l31, PK * 2, ks * 32 + hi * 16), frag(Cs, vt * 32 + l31, PK * 2, ks * 32 + hi * 16), acc, 0, 0, 0);
#pragma unroll
        for (int r = 0; r < 16; ++r) acc[r] *= ebt[tt * 32 + crow(r, hi)];
#pragma unroll
        for (int ks = 0; ks < 4; ++ks) acc = __builtin_amdgcn_mfma_f32_32x32x16_bf16(frag(As, tt * 32 + l31, PS * 2, ks * 32 + hi * 16), frag(VT, vt * 32 + l31, PS * 2, ks * 32 + hi * 16), acc, 0, 0, 0);
        __syncthreads();
#pragma unroll
        for (int r = 0; r < 16; ++r) { const int t = tt * 32 + crow(r, hi); hbuf[t * 132 + vt * 32 + l31] = acc[r] * __builtin_amdgcn_rcpf(fmaxf(fabsf(den[t]), 1.f)); }
        __syncthreads();
        { const float hn0 = hn[hh * 128 + 2 * lane], hn1 = hn[hh * 128 + 2 * lane + 1];
#pragma unroll
          for (int q8 = 0; q8 < 8; ++q8) { const int t = wave * 8 + q8; typedef float f2_ __attribute__((ext_vector_type(2))); const f2_ av = *(const LAS f2_*)(hbuf + t * 132 + 2 * lane);
            const float rstd = rsqrtf(wave_sum(av[0] * av[0] + av[1] * av[1]) * (1.f / 128.f) + EPS); const size_t row = r0 + t;
            const float o0 = av[0] * rstd * hn0 * sigmoid_f(bflo(og[q8])), o1 = av[1] * rstd * hn1 * sigmoid_f(bfhi(og[q8]));
            *(unsigned*)(mix1 + row * D + hh * 128 + 2 * lane) = pk2(o0, o1); } }
    }
    __syncthreads();
}
#undef C2_FETCH
#undef C2_VT
}

struct Args { const float* in[32]; float* out; unsigned char* ws; int ph_lo, ph_hi, li, pad; };
__global__ void __launch_bounds__(NTHR, 2) fwd_kernel(Args args) {
    extern __shared__ __attribute__((aligned(16))) unsigned char lds_raw[];
    LAS unsigned char* lds = (LAS unsigned char*)lds_raw;
    volatile LAS unsigned* MISC = (volatile LAS unsigned*)(lds + MISC_OFF);
    const int G = gridDim.x, c = blockIdx.x, NGW = G * NWAVES; const size_t GT = (size_t)G * NTHR;
#define PHASE_IDS const int tid = tid_fresh(), lane = tid & 63, wave = __builtin_amdgcn_readfirstlane(tid >> 6), gw = c * NWAVES + wave; const size_t gt = (size_t)c * NTHR + tid; \
    LAS float* scr = (LAS float*)(lds + wave * 16384); (void)lane; (void)gw; (void)gt; (void)scr
    unsigned char* ws = args.ws; float* hout = args.out;
    bf16* hb2 = (bf16*)args.out;
    gu32* ctl = (gu32*)(ws + WS_CTL);
    float* ssqb = (float*)(ws + WS_SSQ);
    for (int u = tid_fresh(); u < (LDS_BYTES - RING_BYTES) / 4; u += NTHR) ((LAS unsigned*)(lds + RING_BYTES))[u] = 0u;
    __syncthreads();
    const int lo = args.ph_lo, hi = args.ph_hi;
    int k256 = 256; asm volatile("" : "+s"(k256)); int k512 = 512; asm volatile("" : "+s"(k512)); int k1792 = EXD / 2; asm volatile("" : "+s"(k1792)); int k1408 = FFN / 2; asm volatile("" : "+s"(k1408));
    XcdBarrier bar; bar.bar = (unsigned*)(ctl + CW_BAR) + args.li * XCD_BAR_WORDS; bar.x = 0; bar.st = nullptr;
    if (hi - lo > 1) bar = xcd_barrier_post((unsigned*)(ctl + CW_BAR) + args.li * XCD_BAR_WORDS, MISC + 8);
#ifndef PH_MASK
#define PH_MASK 0x7fffff
#endif
#define IN(k) ((((PH_MASK) >> (k)) & 1) && lo <= (k) && (k) < hi)
#ifndef DUP_MASK
#define DUP_MASK 0
#endif
#define REPEAT(k) _Pragma("unroll") for (int rep_ = 0; rep_ < ((((DUP_MASK) >> (k)) & 1) ? 2 : 1); ++rep_)
#define SEAM(k) do { if (IN(k) && IN((k) + 1)) xcd_barrier(bar); } while (0)
    const float* x = args.in[0]; const float* p_in = args.in[1];
    bf16* hb = (bf16*)(ws + WS_HB);
    bf16* U0 = (bf16*)hout;

    if (IN(0)) REPEAT(0) {
        PHASE_IDS;
        int rot = 0;
        cvt_pipe<MAP_ID>(args.in[3], nullptr, nullptr, (bf16*)(ws + W_IN0), 2048, 2048, 1024, 1024, 0, scr, gw, NGW, rot, lane);
        cvt_pipe<MAP_ID>(args.in[6], nullptr, nullptr, (bf16*)(ws + W_OUT0), 1024, 1024, 1024, 512, 0, scr, gw, NGW, rot, lane);
        cvt_fold(args.in[4], args.in[5], args.in[6], (bf16*)(ws + W_OUT0), scr, gw, NGW, rot, lane);
        cvt_pipe<MAP_IL, true>(args.in[8], args.in[9], args.in[7], (bf16*)(ws + W_FFNGU), FFN, 256 * FFN8T, 1024, 1024, 0, scr, gw, NGW, rot, lane, FFN_WSC_UP);
        cvt_pipe<MAP_IL>(args.in[8] + 128 * FFN8T, args.in[9] + 128 * FFN8T, args.in[7], (bf16*)(ws + W_FFNGU + (size_t)256 * FFN8T * 1024), FFN, 2 * FFN - 256 * FFN8T, 1024, 1024, 0, scr, gw, NGW, rot, lane);
        cvt_pipe<MAP_ID, true>(args.in[10], nullptr, nullptr, (bf16*)(ws + W_FFND), 1024, 1024, FFN, FFN, 0, scr, gw, NGW, rot, lane, FFN_WSC_DN);
        cvt_pipe<MAP_ID>(args.in[29], nullptr, args.in[28], (bf16*)(ws + W_PLEG0), 1024, 1024, 1024, 1024, 0, scr, gw, NGW, rot, lane);
        cvt_pipe<MAP_ID>(args.in[30], nullptr, nullptr, (bf16*)(ws + W_PLEP0), 1024, 1024, 256, 256, 0, scr, gw, NGW, rot, lane);
        cvt_job<MAP_U1>(args.in[12], nullptr, args.in[11], (bf16*)(ws + W_IN1), 1024, 2472, U1W, 1024, 1024, 0, scr, gw, NGW, rot, lane);
        cvt_job<MAP_UQ>(args.in[18], nullptr, args.in[17], (bf16*)(ws + W_UQ), 256, 384, 512, 256, 256, 0, scr, gw, NGW, rot, lane);
        cvt_job<MAP_UKV>(args.in[20], nullptr, args.in[19], (bf16*)(ws + W_UKV), 128, 768, 768, 256, 256, 0, scr, gw, NGW, rot, lane);
        cvt_pipe<MAP_ID>(args.in[21], nullptr, nullptr, (bf16*)(ws + W_OUT1), 1024, 1024, 1024, 1024, 0, scr, gw, NGW, rot, lane);
        { const float* g0 = args.in[2]; bf16* xn0 = (bf16*)(ws + WS_XN0);
          f32x4 gg0[4];
#pragma unroll
          for (int j = 0; j < 4; ++j) gg0[j] = ((const f32x4*)g0)[lane + 64 * j];
          f32x4 cv[4]; { const int m0 = gw < M ? gw : 0; const f32x4* xr = (const f32x4*)(x + (size_t)m0 * D) + lane;
#pragma unroll
              for (int j = 0; j < 4; ++j) cv[j] = xr[64 * j]; }
          for (int m = gw; m < M; m += NGW) { f32x4 v[4], nv_[4]; float s = 0.f;
              { const int mn = m + NGW < M ? m + NGW : m; const f32x4* xr = (const f32x4*)(x + (size_t)mn * D) + lane;
#pragma unroll
                for (int j = 0; j < 4; ++j) nv_[j] = xr[64 * j]; }
#pragma unroll
              for (int j = 0; j < 4; ++j) { v[j] = cv[j]; cv[j] = nv_[j]; s += (v[j][0] * v[j][0] + v[j][1] * v[j][1]) + (v[j][2] * v[j][2] + v[j][3] * v[j][3]); }
              const float rstd = rsqrtf(wave_sum(s) * (1.f / D) + EPS); v2u* o8 = (v2u*)(xn0 + (size_t)m * D) + lane;
#pragma unroll
              for (int j = 0; j < 4; ++j) { const f32x4 gg = gg0[j]; v2u w; w.x = pk2(v[j][0] * rstd * gg[0], v[j][1] * rstd * gg[1]); w.y = pk2(v[j][2] * rstd * gg[2], v[j][3] * rstd * gg[3]); o8[64 * j] = w; } } }
        cvt_flat(p_in, (bf16*)(ws + WS_PB0), (size_t)M * 64, gt, GT);
        if (DUP_MASK) { int* idn = (int*)(ws + T_IDENT); for (size_t i = gt; i < (size_t)M; i += GT) idn[i] = (int)i; }
        { float* rc = (float*)(ws + T_ROPEC); float* rsn = (float*)(ws + T_ROPES);
          for (size_t i = gt; i < (size_t)SEQ * 16; i += GT) { const int t = (int)(i >> 4), j = (int)(i & 15);
              const float invf = exp2f(-(float)j * (13.287712379549449f / 16.f)); const float ang = (float)t * invf;
              const double rev = (double)ang * 0.15915494309189533577; const float fr = (float)(rev - floor(rev));
              rc[i] = __builtin_amdgcn_cosf(fr); rsn[i] = __builtin_amdgcn_sinf(fr); } }
    }
    SEAM(0);
    if (IN(1)) REPEAT(1) {
        PHASE_IDS;
        { pg8::Gemm g{(const bf16*)(ws + WS_XN0), (const bf16*)(ws + W_IN0), M, U0W, 1024, 1024}; pg8::StaticOrder S; S.init(M, U0W, G, c);
          epi::Store E{U0, U0W, nullptr, 0.f}; pg8::gemm_phase<epi::Store, pg8::StaticOrder, true, true>(lds, g, S, E); }
        { pg8::Gemm g{(const bf16*)(ws + WS_PB0), (const bf16*)(ws + W_PLEP0), M, 1024, k256, 256}; pg8::StaticOrder S; S.init(M, 1024, G, c);
          epi::Store E{(bf16*)(ws + WS_P0G), 1024, nullptr, 0.f}; pg8::gemm_phase<epi::Store, pg8::StaticOrder, true, true>(lds, g, S, E); }
    }
    SEAM(1);
    if (IN(2)) REPEAT(2) {
        PHASE_IDS;
        float* kmean = (float*)(ws + T_KMEAN); bf16* mix0 = (bf16*)(ws + WS_MIX0);
        { LAS float* red = (LAS float*)lds;
          for (int u = c; u < NB * 32 * 2; u += G) { const int b = u >> 6, n = (u >> 1) & 31, half = u & 1, rg = tid >> 5, c8 = tid & 31;
              const bf16* kp = U0 + ((size_t)b * SEQ + n * 256 + rg * 16) * U0W + 512 + half * 256 + c8 * 8; float a[8];
#pragma unroll
              for (int q = 0; q < 8; ++q) a[q] = 0.f;
#pragma unroll
              for (int r = 0; r < 16; ++r) { const v4u w = *(const v4u*)(kp + (size_t)r * U0W); a[0] += bflo(w.x); a[1] += bfhi(w.x); a[2] += bflo(w.y); a[3] += bfhi(w.y); a[4] += bflo(w.z); a[5] += bfhi(w.z); a[6] += bflo(w.w); a[7] += bfhi(w.w); }
              __syncthreads();
#pragma unroll
              for (int q = 0; q < 8; ++q) red[rg * 256 + c8 * 8 + q] = a[q];
              __syncthreads();
              if (tid < 256) { float s = 0.f;
#pragma unroll
                  for (int g2 = 0; g2 < 16; ++g2) s += red[g2 * 256 + tid];
                  const int col = half * 256 + tid; kmean[((size_t)(b * 8 + (col >> 6)) * 32 + n) * 64 + (col & 63)] = s * (1.f / 256.f); } }
          __syncthreads(); }
        for (int rb = c; rb < M / 128; rb += G) { const int g = (wave + (wave >> 2)) & 3, w = 2 << g, c8 = g * 16 + (lane & 15); const size_t row0 = ((size_t)rb * 8 + (wave >> 2) * 4 + (lane >> 4)) * 16; const int t0 = (int)(row0 & (SEQ - 1));
            const bf16* up = U0 + row0 * U0W + 1536 + c8 * 8; float a[8];
#pragma unroll
            for (int j = 0; j < 8; ++j) a[j] = 0.f;
            if (t0 > 0) {
#pragma unroll 4
                for (int r = 1; r < w; ++r) { const v4u wv = *(const v4u*)(up - (size_t)r * U0W);
                    a[0] += bflo(wv.x); a[1] += bfhi(wv.x); a[2] += bflo(wv.y); a[3] += bfhi(wv.y); a[4] += bflo(wv.z); a[5] += bfhi(wv.z); a[6] += bflo(wv.w); a[7] += bfhi(wv.w); } }
#pragma unroll 4
            for (int o = 0; o < 16; ++o) { const int t = t0 + o; const v4u x0 = *(const v4u*)(up + (size_t)o * U0W);
                a[0] += bflo(x0.x); a[1] += bfhi(x0.x); a[2] += bflo(x0.y); a[3] += bfhi(x0.y); a[4] += bflo(x0.z); a[5] += bfhi(x0.z); a[6] += bflo(x0.w); a[7] += bfhi(x0.w);
                const int cnt = (t + 1 < w) ? t + 1 : w; const float ic = 1.f / (float)cnt; v4u ov;
                ov.x = pk2(a[0] * ic - bflo(x0.x), a[1] * ic - bfhi(x0.x)); ov.y = pk2(a[2] * ic - bflo(x0.y), a[3] * ic - bfhi(x0.y));
                ov.z = pk2(a[4] * ic - bflo(x0.z), a[5] * ic - bfhi(x0.z)); ov.w = pk2(a[6] * ic - bflo(x0.w), a[7] * ic - bfhi(x0.w));
                *(v4u*)(mix0 + (row0 + o) * D + 512 + c8 * 8) = ov;
                if (t + 1 >= w) { const v4u wv = *(const v4u*)(up + ((long)o - (w - 1)) * U0W);
                    a[0] -= bflo(wv.x); a[1] -= bfhi(wv.x); a[2] -= bflo(wv.y); a[3] -= bfhi(wv.y); a[4] -= bflo(wv.z); a[5] -= bfhi(wv.z); a[6] -= bflo(wv.w); a[7] -= bfhi(wv.w); } } }
    }
    SEAM(2);
    if (IN(3)) REPEAT(3) {
        PHASE_IDS;
        LAS float* km = (LAS float*)lds; const float* kmean = (const float*)(ws + T_KMEAN); int* lists = (int*)(ws + WS_LISTS); int* cntj = (int*)(ws + T_CNTJ);
        for (int u = c, it_ = 0; u < NB * 8 * 32; u += G, ++it_) { const int bh = u >> 5, j = ((u & 31) + 8 * it_) & 31, b = bh >> 3, h = bh & 7;
            __syncthreads();
            for (int i = tid; i < j * 64; i += NTHR) km[i] = kmean[(size_t)bh * 2048 + i];
            __syncthreads();
            int i0 = -1, i1 = -1, i2 = -1; float t0 = -3e38f, t1 = -3e38f, t2 = -3e38f;
            const int qi = tid & 255, hf = tid >> 8, jh = (j + 1) >> 1;
            if (j > 0) { float qf[64]; const v4u* qp = (const v4u*)(U0 + ((size_t)b * SEQ + j * 256 + qi) * U0W + h * 64);
#pragma unroll
                for (int i = 0; i < 8; ++i) { const v4u w = qp[i]; qf[8 * i] = bflo(w.x); qf[8 * i + 1] = bfhi(w.x); qf[8 * i + 2] = bflo(w.y); qf[8 * i + 3] = bfhi(w.y); qf[8 * i + 4] = bflo(w.z); qf[8 * i + 5] = bfhi(w.z); qf[8 * i + 6] = bflo(w.w); qf[8 * i + 7] = bfhi(w.w); }
#pragma unroll 1
                for (int n = hf ? jh : 0; n < (hf ? j : jh); ++n) { const LAS f32x4* kr = (const LAS f32x4*)(km + n * 64); float g = 0.f;
#pragma unroll
                    for (int i = 0; i < 16; ++i) { const f32x4 kv = kr[i]; g += qf[4 * i] * kv[0] + qf[4 * i + 1] * kv[1] + qf[4 * i + 2] * kv[2] + qf[4 * i + 3] * kv[3]; }
                    if (g > t0) { t2 = t1; i2 = i1; t1 = t0; i1 = i0; t0 = g; i0 = n; } else if (g > t1) { t2 = t1; i2 = i1; t1 = g; i1 = n; } else if (g > t2) { t2 = g; i2 = n; } } }
            { LAS float* exv = (LAS float*)(lds + 12288); LAS int* exi = (LAS int*)(lds + 12288 + 3072);
              if (hf) { exv[qi * 3] = t0; exv[qi * 3 + 1] = t1; exv[qi * 3 + 2] = t2; exi[qi * 3] = i0; exi[qi * 3 + 1] = i1; exi[qi * 3 + 2] = i2; }
              __syncthreads();
              if (!hf) {
#pragma unroll
                  for (int k = 0; k < 3; ++k) { const float g = exv[qi * 3 + k]; const int n = exi[qi * 3 + k];
                      if (n >= 0) { if (g > t0) { t2 = t1; i2 = i1; t1 = t0; i1 = i0; t0 = g; i0 = n; } else if (g > t1) { t2 = t1; i2 = i1; t1 = g; i1 = n; } else if (g > t2) { t2 = g; i2 = n; } } } }
              else { i0 = -1; i1 = -1; i2 = -1; } }
            LAS int* wc = (LAS int*)(lds + 8192);
            int r0 = 0, r1 = 0, r2 = 0; const unsigned long long lt = (1ull << lane) - 1ull;
            if (wave < 4) {
#pragma unroll 1
                for (int n = 0; n < j; ++n) { const bool m_ = (i0 == n) || (i1 == n) || (i2 == n); const unsigned long long bl = __ballot(m_); const int below = __popcll(bl & lt);
                    if (i0 == n) r0 = below; if (i1 == n) r1 = below; if (i2 == n) r2 = below; if (lane == 0) wc[n * 4 + wave] = __popcll(bl); } }
            __syncthreads();
            if (tid < 256 && j > 0) { const int me = j * 256 + tid;
                if (i0 >= 0) { int off = r0; for (int w = 0; w < wave; ++w) off += wc[i0 * 4 + w]; lists[((size_t)(bh * 32 + i0) * 32 + j) * 256 + off] = me; }
                if (i1 >= 0) { int off = r1; for (int w = 0; w < wave; ++w) off += wc[i1 * 4 + w]; lists[((size_t)(bh * 32 + i1) * 32 + j) * 256 + off] = me | (1 << 16); }
                if (i2 >= 0) { int off = r2; for (int w = 0; w < wave; ++w) off += wc[i2 * 4 + w]; lists[((size_t)(bh * 32 + i2) * 32 + j) * 256 + off] = me | (2 << 16); } }
            if (tid < j) cntj[(bh * 32 + tid) * 32 + j] = wc[tid * 4] + wc[tid * 4 + 1] + wc[tid * 4 + 2] + wc[tid * 4 + 3];
        }
        __syncthreads();
    }
    SEAM(3);
    if (IN(4)) REPEAT(4) {
        __syncthreads();
        moba_attn::sphase((char*)lds_raw, U0, (const int*)(ws + WS_LISTS), (const int*)(ws + T_CNTJ), (bf16*)(ws + WS_PO), (float*)(ws + WS_PM), G, c);
    }
    SEAM(4);
    if (IN(5)) REPEAT(5) {
        PHASE_IDS;
        const bf16* PO = (const bf16*)(ws + WS_PO); const float* PM = (const float*)(ws + WS_PM); bf16* mix0 = (bf16*)(ws + WS_MIX0);
        typedef float f2m_ __attribute__((ext_vector_type(2)));
        f2m_ cpm[4]; v4u cpo[4];
        { const size_t i0 = gt < (size_t)M * 64 ? gt : 0; const size_t pair = i0 >> 3; const int ch = (int)(i0 & 7);
#pragma unroll
          for (int s = 0; s < 4; ++s) { cpm[s] = *(const f2m_*)(PM + (pair * 4 + s) * 2); cpo[s] = *(const v4u*)(PO + (pair * 4 + s) * 64 + ch * 8); } }
        for (size_t i = gt; i < (size_t)M * 64; i += GT) { const size_t pair = i >> 3; const int ch = (int)(i & 7), h = (int)(pair & 7); const size_t token = pair >> 3; const int j = (int)(token & (SEQ - 1)) >> 8, nv = j < 3 ? j : 3;
            f2m_ npm[4]; v4u npo[4];
            { const size_t in_ = i + GT < (size_t)M * 64 ? i + GT : i; const size_t pr = in_ >> 3; const int c2 = (int)(in_ & 7);
#pragma unroll
              for (int s = 0; s < 4; ++s) { npm[s] = *(const f2m_*)(PM + (pr * 4 + s) * 2); npo[s] = *(const v4u*)(PO + (pr * 4 + s) * 64 + c2 * 8); } }
            float mm[4], ll[4]; float mx = -3e38f;
#pragma unroll
            for (int s = 0; s < 4; ++s) { const bool ok = (s == 3) || (s < nv); mm[s] = ok ? cpm[s][0] : -3e38f; ll[s] = ok ? cpm[s][1] : 0.f; mx = fmaxf(mx, mm[s]); }
            float acc[8], den = 0.f;
#pragma unroll
            for (int d = 0; d < 8; ++d) acc[d] = 0.f;
#pragma unroll
            for (int s = 0; s < 4; ++s) { const bool ok = (s == 3) || (s < nv); if (ok) { const float a = ll[s] * exp2f(mm[s] - mx); den += a; const v4u w = cpo[s];
                acc[0] += a * bflo(w.x); acc[1] += a * bfhi(w.x); acc[2] += a * bflo(w.y); acc[3] += a * bfhi(w.y); acc[4] += a * bflo(w.z); acc[5] += a * bfhi(w.z); acc[6] += a * bflo(w.w); acc[7] += a * bfhi(w.w); } }
            const float inv = 1.f / den; v4u o; o.x = pk2(acc[0] * inv, acc[1] * inv); o.y = pk2(acc[2] * inv, acc[3] * inv); o.z = pk2(acc[4] * inv, acc[5] * inv); o.w = pk2(acc[6] * inv, acc[7] * inv);
            *(v4u*)(mix0 + token * D + h * 64 + ch * 8) = o;
#pragma unroll
            for (int s = 0; s < 4; ++s) { cpm[s] = npm[s]; cpo[s] = npo[s]; } }
    }
    SEAM(5);
    if (IN(6)) REPEAT(6) {
        PHASE_IDS;
        pg8::Gemm g{(const bf16*)(ws + WS_MIX0), (const bf16*)(ws + W_OUT0), M, 1024, 1024, 1024}; pg8::StaticOrder S; S.init(M, 1024, G, c);
        epi::Res<0, true, true, true> E{x, nullptr, hb, ssqb + SSQ_H1, nullptr, nullptr, nullptr, nullptr, 1.f, (unsigned char*)(ws + WS_HB8), (LAS float*)(lds + RING_BYTES + 4096)};
        pg8::gemm_phase<epi::Res<0, true, true, true>, pg8::StaticOrder, true, true>(lds, g, S, E);
    }
    SEAM(6);
    if (IN(7)) REPEAT(7) {
        PHASE_IDS;
        { pg8::Gemm g{(const bf16*)(ws + WS_HB8), (const bf16*)(ws + W_FFNGU), M, 256 * FFN8T, k512, 512}; pg8::StaticOrder S; S.init(M, 256 * FFN8T, G, c);
          epi::SwiGLU8<0> E{(unsigned char*)(ws + WS_HMID0), FFN, ssqb + SSQ_H1, 1.f / FFN_WSC_UP, FFN_HSC};
          pg8::gemm_phase<epi::SwiGLU8<0>, pg8::StaticOrder, true, true, true>(lds, g, S, E); }
        { pg8::Gemm g{hb, (const bf16*)(ws + W_FFNGU + (size_t)256 * FFN8T * 1024), M, 2 * FFN - 256 * FFN8T, 1024, 1024}; pg8::StaticOrder S; S.init(M, 2 * FFN - 256 * FFN8T, G, c);
          epi::SwiGLU8<0> E{(unsigned char*)(ws + WS_HMID0) + 128 * FFN8T, FFN, ssqb + SSQ_H1, 1.f, FFN_HSC};
          pg8::gemm_phase<epi::SwiGLU8<0>, pg8::StaticOrder, true, true>(lds, g, S, E); }
    }
    SEAM(7);
    if (IN(8)) REPEAT(8) {
        PHASE_IDS;
        pg8::Gemm g{(const bf16*)(ws + WS_HMID0), (const bf16*)(ws + W_FFND), M, 1024, k1408, FFN / 2}; pg8::StaticOrder S; S.init(M, 1024, G, c);
        epi::Res<0, false, true> E{nullptr, hb, hb, ssqb + SSQ_H2, nullptr, nullptr, nullptr, nullptr, 1.f / (FFN_WSC_DN * FFN_HSC), nullptr, (LAS float*)(lds + RING_BYTES + 4096)};
        pg8::gemm_phase<epi::Res<0, false, true>, pg8::StaticOrder, true, true, true>(lds, g, S, E);
    }
    SEAM(8);
    if (IN(9)) REPEAT(9) {
        PHASE_IDS;
        pg8::Gemm g{hb, (const bf16*)(ws + W_PLEG0), M, 1024, 1024, 1024}; pg8::StaticOrder S; S.init(M, 1024, G, c);
        epi::Res<1, false, true> E{nullptr, hb, hb2, ssqb + SSQ_H3, ssqb + SSQ_H2, (const bf16*)(ws + WS_P0G), nullptr, nullptr, 1.f, nullptr, (LAS float*)(lds + RING_BYTES + 4096)};
        pg8::gemm_phase<epi::Res<1, false, true>, pg8::StaticOrder, true, true>(lds, g, S, E);
    }
    SEAM(9);
    bf16* u1 = (bf16*)(ws + WS_U1);
    if (IN(10)) REPEAT(10) {
        PHASE_IDS;
        pg8::Gemm g{hb2, (const bf16*)(ws + W_IN1), M, U1W, 1024, 1024}; pg8::StaticOrder S; S.init(M, U1W, G, c);
        epi::U1 E{u1, ssqb + SSQ_H3, ssqb + SSQ_CQ, ssqb + SSQ_CKV, (bf16*)(ws + WS_KM), (const float*)(ws + T_ROPEC), (const float*)(ws + T_ROPES)};
        pg8::gemm_phase<epi::U1, pg8::StaticOrder, true, true>(lds, g, S, E);
    }
    SEAM(10);
    bf16* mU = (bf16*)(ws + WS_MU); float* mN = (float*)(ws + WS_MN); float* mD = (float*)(ws + T_MD);
    bf16* Qm = (bf16*)(ws + WS_QM); bf16* Km = (bf16*)(ws + WS_KM); bf16* Vm = (bf16*)(ws + WS_VM);
    const float* ropec = (const float*)(ws + T_ROPEC); const float* ropes = (const float*)(ws + T_ROPES);
    if (IN(11)) REPEAT(11) {
        PHASE_IDS;
#ifdef MLSTM_A_NAIVE
        mlstm_a(lds, u1, args.in[13], args.in[14], args.in[15], mU, mN, mD, G, c);
#else
        mlm::stage_a2(lds, u1, args.in[13], args.in[14], args.in[15], mU, mN, mD, G, c);
#endif
        { pg8::Gemm g{u1 + 2048, (const bf16*)(ws + W_UQ), M, 512, k256, U1W}; pg8::StaticOrder S; S.init(M, 512, G, c);
          epi::MlaQ E{Qm, ssqb + SSQ_CQ, ropec, ropes}; pg8::gemm_phase<epi::MlaQ, pg8::StaticOrder, true, true>(lds, g, S, E); }
        { pg8::Gemm g{u1 + 2304, (const bf16*)(ws + W_UKV), M, 768, k256, U1W}; pg8::StaticOrder S; S.init(M, 768, G, c);
          epi::MlaKV E{Km, Vm, ssqb + SSQ_CKV}; pg8::gemm_phase<epi::MlaKV, pg8::StaticOrder, true, true>(lds, g, S, E); }
    }
    SEAM(11);
    bf16* mix1 = (bf16*)(ws + WS_MIX1);
    if (IN(12)) REPEAT(12) {
        PHASE_IDS;
        mlstm_b(mU, mN, mD, gt, GT);
#ifdef MLA_NAIVE
        attn_naive<96, 128, 4, 4, false>(lds, Qm, 512, 128, Km, 512, 128, Vm, 512, 128, mix1 + 512, D, 128, 4, 0.10206207261596575f, nullptr, G, c);
#else
        REPEAT(28) {
        __syncthreads();
        mla_attn::phase((char*)lds_raw, Qm, Km, Vm, mix1 + 512, G, c);
        }
#endif
    }
    SEAM(12);
#ifdef MLSTM_C_NAIVE
    if (IN(13)) mlstm_c(lds, u1, args.in[13], args.in[14], args.in[15], args.in[16], mU, mN, mix1, G, c);
#else
    if (IN(13)) mlm::stage_c2(lds, u1, args.in[13], args.in[14], args.in[15], args.in[16], mU, mN, mix1, G, c);
#endif
    SEAM(13);
    if (IN(14)) REPEAT(14) {
        PHASE_IDS;
        pg8::Gemm g{mix1, (const bf16*)(ws + W_OUT1), M, 1024, 1024, 1024}; pg8::StaticOrder S; S.init(M, 1024, G, c);
        epi::Res<0, false, false> E{nullptr, hb2, hb2, nullptr, nullptr, nullptr, nullptr, nullptr, 1.f, nullptr};
        pg8::gemm_phase<epi::Res<0, false, false>, pg8::StaticOrder, true, true>(lds, g, S, E);
    }
    SEAM(14);
    float* rstd4 = (float*)(ws + T_RSTD4); int* tok_e = (int*)(ws + T_TOKE); int* tok_p = (int*)(ws + T_TOKP); float* tok_w = (float*)(ws + T_TOKW);
    if (IN(15)) REPEAT(15) {
        PHASE_IDS;
        { LAS float* gW = (LAS float*)lds; const float* g4 = args.in[22]; const float* rw = args.in[23]; const float* rb = args.in[24];
          for (int i = tid; i < 8192; i += NTHR) gW[i] = g4[i >> 3] * rw[i];
          __syncthreads();
          float rbv[8];
#pragma unroll
          for (int e = 0; e < 8; ++e) rbv[e] = rb[e];
          v2u crw[4]; { const int m0 = gw < M ? gw : 0; const v2u* hr = (const v2u*)(hb2 + (size_t)m0 * D) + lane;
#pragma unroll
              for (int j = 0; j < 4; ++j) crw[j] = hr[64 * j]; }
          for (int m = gw; m < M; m += NGW) { float lg[8]; float s = 0.f; v2u nrw[4];
              { const int mn = m + NGW < M ? m + NGW : m; const v2u* hr = (const v2u*)(hb2 + (size_t)mn * D) + lane;
#pragma unroll
                for (int j = 0; j < 4; ++j) nrw[j] = hr[64 * j]; }
#pragma unroll
              for (int e = 0; e < 8; ++e) lg[e] = 0.f;
#pragma unroll
              for (int j = 0; j < 4; ++j) { const v2u hw = crw[j]; crw[j] = nrw[j]; const f32x4 v = (f32x4){bflo(hw.x), bfhi(hw.x), bflo(hw.y), bfhi(hw.y)}; s += (v[0] * v[0] + v[1] * v[1]) + (v[2] * v[2] + v[3] * v[3]);
#pragma unroll
                  for (int q = 0; q < 4; ++q) { const LAS f32x4* wp = (const LAS f32x4*)(gW + (size_t)(4 * (lane + 64 * j) + q) * 8); const f32x4 w0 = wp[0], w1 = wp[1];
                      lg[0] += v[q] * w0[0]; lg[1] += v[q] * w0[1]; lg[2] += v[q] * w0[2]; lg[3] += v[q] * w0[3]; lg[4] += v[q] * w1[0]; lg[5] += v[q] * w1[1]; lg[6] += v[q] * w1[2]; lg[7] += v[q] * w1[3]; } }
              const float rstd = rsqrtf(wave_sum(s) * (1.f / D) + EPS);
              { const bool b5 = (lane & 32) != 0, b4 = (lane & 16) != 0, b3 = (lane & 8) != 0; float k4[4], k2[2], k1;
#pragma unroll
                for (int k = 0; k < 4; ++k) { const float snd = b5 ? lg[k] : lg[k + 4], kp = b5 ? lg[k + 4] : lg[k]; k4[k] = kp + __shfl_xor(snd, 32); }
#pragma unroll
                for (int k = 0; k < 2; ++k) { const float snd = b4 ? k4[k] : k4[k + 2], kp = b4 ? k4[k + 2] : k4[k]; k2[k] = kp + __shfl_xor(snd, 16); }
                { const float snd = b3 ? k2[0] : k2[1], kp = b3 ? k2[1] : k2[0]; k1 = kp + __shfl_xor(snd, 8); }
                k1 += __shfl_xor(k1, 4); k1 += __shfl_xor(k1, 2); k1 += __shfl_xor(k1, 1);
#pragma unroll
                for (int e = 0; e < 8; ++e) lg[e] = __builtin_bit_cast(float, __builtin_amdgcn_readlane(__builtin_bit_cast(int, k1), 8 * e)) * rstd + rbv[e]; }
              float v1 = -3e38f, v2 = -3e38f; int e1 = 0, e2 = 0;
#pragma unroll
              for (int e = 0; e < 8; ++e) { const float xv = lg[e]; if (xv > v1) { v2 = v1; e2 = e1; v1 = xv; e1 = e; } else if (xv > v2) { v2 = xv; e2 = e; } }
              if (lane == 0) { const float w1 = 1.f / (1.f + __expf(v2 - v1));
                  const int p1 = (int)__hip_atomic_fetch_add(ctl + CW_CNT + e1 * 64, 1u, RLX_AGENT), p2 = (int)__hip_atomic_fetch_add(ctl + CW_CNT + (8 + e2) * 64, 1u, RLX_AGENT);
                  rstd4[m] = rstd; tok_e[2 * m] = e1; tok_e[2 * m + 1] = e2; tok_p[2 * m] = p1; tok_p[2 * m + 1] = p2; tok_w[2 * m] = w1; tok_w[2 * m + 1] = 1.f - w1; } }
          __syncthreads(); }
        REPEAT(27) {
        int rot = 0;
        for (int e = 0; e < NEXP; ++e)
            cvt_pipe<MAP_IL, true>(args.in[25] + (size_t)e * 1024 * EXD, args.in[26] + (size_t)e * 1024 * EXD, args.in[22], (bf16*)(ws + W_MOEGU + (size_t)e * 2 * EXD * 1024), EXD, 2 * EXD, 1024, 1024, 0, scr, gw, NGW, rot, lane, MOE_WSC_UP);
        for (int e = 0; e < NEXP; ++e)
            cvt_pipe<MAP_ID, true>(args.in[27] + (size_t)e * EXD * 1024, nullptr, nullptr, (bf16*)(ws + W_MOED + (size_t)e * 1024 * EXD), 1024, 1024, EXD, EXD, 0, scr, gw, NGW, rot, lane, MOE_WSC_DN);
        }
    }
    SEAM(15);
    int* slot_t = (int*)(ws + T_SLOTT); float* slot_w = (float*)(ws + T_SLOTW); float* slot_r = (float*)(ws + T_SLOTR); int* tile_e = (int*)(ws + T_TILEE);
    bf16* xg = (bf16*)(ws + WS_XG); bf16* hmidg = (bf16*)(ws + WS_HMIDG);
    if (IN(16)) REPEAT(16) {
        PHASE_IDS; LAS int* sb = (LAS int*)lds;
        __syncthreads();
        if (tid < 2) { int bs = 0; for (int e = 0; e < 8; ++e) { const int cn = (int)__hip_atomic_load(ctl + CW_CNT + (tid * 8 + e) * 64, RLX_AGENT); sb[32 * tid + e] = bs; sb[32 * tid + 16 + e] = cn; bs += (cn + 255) & ~255; } sb[32 * tid + 8] = bs; }
        __syncthreads();
        if (c == 0) { const int nt0 = sb[8] >> 8, nt1 = sb[40] >> 8;
            for (int T = tid; T < nt0 + nt1; T += NTHR) { const int kk = T < nt0 ? 0 : 1, Tl = T - kk * nt0; int e = 0; for (int q = 1; q < 8; ++q) if (Tl * 256 >= sb[32 * kk + q]) e = q;
                tile_e[kk * 256 + Tl] = e; tile_e[512 + T] = (kk * (SLOTCAP / 256) + Tl) | (e << 16); }
            if (tid == 0) { tile_e[255] = nt0; tile_e[256 + 255] = nt1; tile_e[512 + 300] = nt0 + nt1; } }
        for (size_t i = gt; i < 4096; i += GT) { const int kk = (int)(i >> 11), e = (int)(i >> 8) & 7, off = (int)(i & 255); const int cn = sb[32 * kk + 16 + e]; if (cn + off < ((cn + 255) & ~255)) slot_t[kk * SLOTCAP + sb[32 * kk + e] + cn + off] = -1; }
        typedef int i2g_ __attribute__((ext_vector_type(2))); typedef float f2g_ __attribute__((ext_vector_type(2)));
        v4u c0v, c1v; float crs; i2g_ cte, ctp; f2g_ ctw;
        { const int m0 = gw < M ? gw : 0; const v4u* src = (const v4u*)(hb2 + (size_t)m0 * D) + 2 * lane; c0v = src[0]; c1v = src[1]; crs = rstd4[m0]; cte = *(const i2g_*)(tok_e + 2 * m0); ctp = *(const i2g_*)(tok_p + 2 * m0); ctw = *(const f2g_*)(tok_w + 2 * m0); }
        for (int m = gw; m < M; m += NGW) {
            const v4u s0 = c0v, s1 = c1v; const float rs = crs; const i2g_ te = cte, tp = ctp; const f2g_ tw = ctw; int w0 = 0, w1 = 0, w2 = 0, w3 = 0;
            { const int mn = m + NGW < M ? m + NGW : m; const v4u* src = (const v4u*)(hb2 + (size_t)mn * D) + 2 * lane; c0v = src[0]; c1v = src[1]; crs = rstd4[mn]; cte = *(const i2g_*)(tok_e + 2 * mn); ctp = *(const i2g_*)(tok_p + 2 * mn); ctw = *(const f2g_*)(tok_w + 2 * mn); }
            w0 = __builtin_amdgcn_cvt_pk_fp8_f32(bflo(s0.x) * rs, bfhi(s0.x) * rs, w0, false); w0 = __builtin_amdgcn_cvt_pk_fp8_f32(bflo(s0.y) * rs, bfhi(s0.y) * rs, w0, true); w1 = __builtin_amdgcn_cvt_pk_fp8_f32(bflo(s0.z) * rs, bfhi(s0.z) * rs, w1, false); w1 = __builtin_amdgcn_cvt_pk_fp8_f32(bflo(s0.w) * rs, bfhi(s0.w) * rs, w1, true);
            w2 = __builtin_amdgcn_cvt_pk_fp8_f32(bflo(s1.x) * rs, bfhi(s1.x) * rs, w2, false); w2 = __builtin_amdgcn_cvt_pk_fp8_f32(bflo(s1.y) * rs, bfhi(s1.y) * rs, w2, true); w3 = __builtin_amdgcn_cvt_pk_fp8_f32(bflo(s1.z) * rs, bfhi(s1.z) * rs, w3, false); w3 = __builtin_amdgcn_cvt_pk_fp8_f32(bflo(s1.w) * rs, bfhi(s1.w) * rs, w3, true);
            const v4u row8 = (v4u){(unsigned)w0, (unsigned)w1, (unsigned)w2, (unsigned)w3};
#pragma unroll
            for (int kk = 0; kk < 2; ++kk) { const int slot = kk * SLOTCAP + sb[32 * kk + te[kk]] + tp[kk];
                ((v4u*)((unsigned char*)xg + (size_t)slot * D))[lane] = row8;
                if (lane == 0) { slot_t[slot] = m; slot_w[slot] = tw[kk]; } } }
        __syncthreads();
    }
    SEAM(16);
    if (IN(17)) REPEAT(17) {
        const int nt0_ = tile_e[255], nt1_ = tile_e[256 + 255]; LightDeal d0; d0.init(nt0_, G, c); int nlt = (G == 256 && nt0_ > 128) ? (3 * d0.nl) / 28 : 0; if (nlt > nt1_) nlt = nt1_;
        pg8::Gemm g{xg, (const bf16*)(ws + W_MOEGU), 2 * SLOTCAP, 2 * EXD, k512, 512}; MoeOrderC S; S.init(tile_e + 512, nt0_ + nt1_ - nlt, 2 * EXD / 256, G, c);
        epi::SwiGLU8<2> E{(unsigned char*)hmidg, EXD, nullptr, 1.f / MOE_WSC_UP, MOE_HSC}; pg8::gemm_phase<epi::SwiGLU8<2>, MoeOrderC, true, true, true>(lds, g, S, E);
        { PHASE_IDS; LAS int* li = (LAS int*)(lds + RING_BYTES + 8192); const int ntl = nt0_ + nt1_ - nlt; int lightme = 1, lr = c, nl = G;
          if (G == 256) { int maxu = 0;
#pragma unroll
              for (int x = 0; x < 8; ++x) { const int cnt = ntl > x ? (ntl - x + 7) >> 3 : 0; const int uu = (cnt * 28 + 31) >> 5; maxu = uu > maxu ? uu : maxu; }
              bool lt = false;
              if (tid < 256) { const int x = tid & 7, r = tid >> 3, cnt = ntl > x ? (ntl - x + 7) >> 3 : 0, units = cnt * 28, n = units > r ? (units - r + 31) >> 5 : 0; lt = n < maxu; }
              const unsigned long long bl = __ballot(lt);
              __syncthreads();
              if (lane == 0 && wave < 4) { li[wave] = __popcll(bl); li[4 + 2 * wave] = (int)(unsigned)bl; li[5 + 2 * wave] = (int)(unsigned)(bl >> 32); }
              __syncthreads();
              const int wv = c >> 6, ln = c & 63; const unsigned long long bw = (unsigned long long)(unsigned)li[4 + 2 * wv] | ((unsigned long long)(unsigned)li[5 + 2 * wv] << 32);
              int before = __popcll(bw & ((1ull << ln) - 1ull)); for (int w = 0; w < wv; ++w) before += li[w];
              const int tot = li[0] + li[1] + li[2] + li[3];
              if (tot > 0) { lightme = (int)((bw >> ln) & 1ull); lr = before; nl = tot; } }
          if (lightme) { int rot2 = 0; const int gws = lr * NWAVES + wave, ngws = nl * NWAVES;
              cvt_pipe<MAP_ID>(args.in[29] + (size_t)1024 * 1024, nullptr, args.in[28] + 1024, (bf16*)(ws + W_PLEG1), 1024, 1024, 1024, 1024, 0, scr, gws, ngws, rot2, lane);
              cvt_pipe<MAP_ID>(args.in[30] + (size_t)256 * 1024, nullptr, nullptr, (bf16*)(ws + W_PLEP1), 1024, 1024, 256, 256, 0, scr, gws, ngws, rot2, lane);
              cvt_flat(p_in + (size_t)M * 256, (bf16*)(ws + WS_PB1), (size_t)M * 64, (size_t)lr * NTHR + tid, (size_t)nl * NTHR); } }
    }
    SEAM(17);
    if (IN(18)) {
        pg8::Gemm g{hmidg, (const bf16*)(ws + W_MOED), SLOTCAP, 1024, k1792, EXD / 2}; MoeOrder S; S.init(tile_e, tile_e[255], 4, G, c);
        epi::Res<2, false, false> E{nullptr, hb2, hb, nullptr, nullptr, nullptr, slot_t, slot_w, 1.f / (MOE_WSC_DN * MOE_HSC), nullptr, nullptr, (bf16*)(ws + WS_DUMP)};
        pg8::gemm_phase<epi::Res<2, false, false>, MoeOrder, true, true, true>(lds, g, S, E);
        { const int nt0_ = tile_e[255], nt1_ = tile_e[256 + 255]; LightDeal d0; d0.init(nt0_, G, c); int nlt = (G == 256 && nt0_ > 128) ? (3 * d0.nl) / 28 : 0; if (nlt > nt1_) nlt = nt1_;
          pg8::Gemm gu{xg, (const bf16*)(ws + W_MOEGU), 2 * SLOTCAP, 2 * EXD, k512, 512}; LeftOrder L; L.init(tile_e + 512 + nt0_ + nt1_ - nlt, nlt, 2 * EXD / 256, d0);
          epi::SwiGLU8<2> Eu{(unsigned char*)hmidg, EXD, nullptr, 1.f / MOE_WSC_UP, MOE_HSC}; pg8::gemm_phase<epi::SwiGLU8<2>, LeftOrder, true, true, true>(lds, gu, L, Eu); }
    }
    SEAM(18);
    if (IN(19)) {
        { pg8::Gemm g{(const bf16*)((const unsigned char*)hmidg + (size_t)SLOTCAP * EXD), (const bf16*)(ws + W_MOED), SLOTCAP, 1024, k1792, EXD / 2}; MoeOrder S; S.init(tile_e + 256, tile_e[256 + 255], 4, G, c);
          epi::Res<2, false, true> E{nullptr, hb, hb2, ssqb + SSQ_H5, nullptr, nullptr, slot_t + SLOTCAP, slot_w + SLOTCAP, 1.f / (MOE_WSC_DN * MOE_HSC), nullptr, (LAS float*)(lds + RING_BYTES + 4096), (bf16*)(ws + WS_DUMP)};
          pg8::gemm_phase<epi::Res<2, false, true>, MoeOrder, true, true, true>(lds, g, S, E); }
        { LightDeal d1; d1.init(tile_e[256 + 255], G, c);
          pg8::Gemm g{(const bf16*)(ws + WS_PB1), (const bf16*)(ws + W_PLEP1), M, 1024, k256, 256}; LightStatic S; S.init(M, 1024, d1);
          epi::Store E{(bf16*)(ws + WS_P1G), 1024, nullptr, 0.f}; pg8::gemm_phase<epi::Store, LightStatic, true, true>(lds, g, S, E); }
    }
    SEAM(19);
    if (IN(20)) REPEAT(20) {
        PHASE_IDS;
        pg8::Gemm g{hb2, (const bf16*)(ws + W_PLEG1), M, 1024, 1024, 1024}; pg8::StaticOrder S; S.init(M, 1024, G, c);
        epi::Res<1, false, false> E{nullptr, hb2, hb, nullptr, ssqb + SSQ_H5, (const bf16*)(ws + WS_P1G), nullptr, nullptr, 1.f, nullptr};
        pg8::gemm_phase<epi::Res<1, false, false>, pg8::StaticOrder, true, true>(lds, g, S, E);
    }
    SEAM(20);
    if (IN(21)) REPEAT(21) {
        PHASE_IDS;
        const float* gf = args.in[31];
        f32x4 ggf[4];
#pragma unroll
        for (int j = 0; j < 4; ++j) ggf[j] = ((const f32x4*)gf)[lane + 64 * j];
        v2u cw[4]; { const int m0 = gw < M ? gw : 0; const v2u* hr = (const v2u*)(hb + (size_t)m0 * D) + lane;
#pragma unroll
            for (int j = 0; j < 4; ++j) cw[j] = hr[64 * j]; }
        for (int m = gw; m < M; m += NGW) { f32x4* orw = (f32x4*)(hout + (size_t)m * D) + lane; f32x4 v[4]; float s = 0.f; v2u nw[4];
            { const int mn = m + NGW < M ? m + NGW : m; const v2u* hr = (const v2u*)(hb + (size_t)mn * D) + lane;
#pragma unroll
              for (int j = 0; j < 4; ++j) nw[j] = hr[64 * j]; }
#pragma unroll
            for (int j = 0; j < 4; ++j) { const v2u hw = cw[j]; v[j] = (f32x4){bflo(hw.x), bfhi(hw.x), bflo(hw.y), bfhi(hw.y)}; s += (v[j][0] * v[j][0] + v[j][1] * v[j][1]) + (v[j][2] * v[j][2] + v[j][3] * v[j][3]); }
            const float rstd = rsqrtf(wave_sum(s) * (1.f / D) + EPS);
#pragma unroll
            for (int j = 0; j < 4; ++j) orw[64 * j] = v[j] * rstd * ggf[j];
#pragma unroll
            for (int j = 0; j < 4; ++j) cw[j] = nw[j]; }
    }
#undef IN
#undef SEAM
}

#ifndef N_CUTS
#define N_CUTS 1
#endif
extern "C" void kernel_launch(void* const* d_in, const int* in_sizes, int n_in, void* d_out, int out_size, void* d_ws, size_t ws_size, hipStream_t stream) {
    static int grid = 0;
    if (grid == 0) {
        if (n_in != 32 || in_sizes[0] != M * D || out_size != M * D || ws_size < WS_END) { fprintf(stderr, "kernel_launch: unexpected problem shape (n_in %d, in0 %d, out %d, ws %zu); nothing launched\n", n_in, n_in > 0 ? in_sizes[0] : -1, out_size, ws_size); grid = -1; return; }
        int dev = 0, cus = 0, per_cu = 0;
        if (hipGetDevice(&dev) != hipSuccess || hipDeviceGetAttribute(&cus, hipDeviceAttributeMultiprocessorCount, dev) != hipSuccess) { grid = -1; return; }
        if (hipFuncSetAttribute((const void*)fwd_kernel, hipFuncAttributeMaxDynamicSharedMemorySize, LDS_BYTES) != hipSuccess) { fprintf(stderr, "kernel_launch: hipFuncSetAttribute failed\n"); grid = -1; return; }
        if (hipOccupancyMaxActiveBlocksPerMultiprocessor(&per_cu, (const void*)fwd_kernel, NTHR, LDS_BYTES) != hipSuccess || per_cu < 1) fprintf(stderr, "kernel_launch: occupancy query reports %d\n", per_cu);
        (void)hipGetLastError();
        grid = cus;
    }
    if (grid < 0) return;
    if (hipMemsetAsync((char*)d_ws + WS_CTL, 0, CTL_ZERO_BYTES, stream) != hipSuccess) return;
    Args a{};
    for (int i = 0; i < 32; ++i) a.in[i] = (const float*)d_in[i];
    a.out = (float*)d_out; a.ws = (unsigned char*)d_ws;
    for (int li = 0; li < N_CUTS; ++li) {
        a.ph_lo = (int)((long)NPHASE * li / N_CUTS); a.ph_hi = (int)((long)NPHASE * (li + 1) / N_CUTS); a.li = li < 8 ? li : 0; a.pad = 0;
        hipLaunchKernelGGL(fwd_kernel, dim3(grid), dim3(NTHR), LDS_BYTES, stream, a);
    }
}
```
